# Optimizing an MI355X kernel written in HIP

```python
import math
import numpy as np
import jax
import jax.numpy as jnp
from jax import lax

D_MODEL = 1024
BATCH = 2
SEQ = 8192
DEPTH = 1

GRID_W = 64
CTX_LEN = 256
EPS = 1e-6
GDN_HEADS = 8
GDN_DK = 128
GDN_DV = 128
GDN_WIDTH = GDN_HEADS * GDN_DV
CONV_K = 5
CHUNK = 64
DIFF_HEADS = 8
DIFF_DQK = D_MODEL // DIFF_HEADS // 2
DIFF_DV = 2 * DIFF_DQK
DIFF_QK_WIDTH = 2 * DIFF_HEADS * DIFF_DQK
DIFF_V_WIDTH = DIFF_HEADS * DIFF_DV
Q_BLOCK = 128
ROPE_THETA = 10000.0
IN_SIZES = (3 * GDN_WIDTH, GDN_WIDTH, 2 * GDN_HEADS, 2 * GDN_HEADS,
            DIFF_QK_WIDTH, DIFF_QK_WIDTH, DIFF_V_WIDTH, DIFF_V_WIDTH, 2 * D_MODEL)
IN_COLS = 4 * GDN_WIDTH + 4 * GDN_HEADS + 2 * DIFF_QK_WIDTH + 2 * DIFF_V_WIDTH + 2 * D_MODEL

kernel_name = 'hybrid_gdn_diffattn_prefix_block'


def rms_norm(x, gain=None):
    xf = x.astype(jnp.float32)
    y = xf * lax.rsqrt(jnp.mean(xf * xf, axis=-1, keepdims=True) + EPS)
    if gain is not None:
        y = y * gain.astype(jnp.float32)
    return y.astype(x.dtype)


def l2_norm(x):
    return x * lax.rsqrt(jnp.sum(x * x, axis=-1, keepdims=True) + EPS)


def split_cols(cols):
    return jnp.split(cols, np.cumsum(IN_SIZES)[:-1].tolist(), axis=-1)


def centred_conv(x, w):
    pad = CONV_K // 2
    length = x.shape[1]
    xp = jnp.pad(x, ((0, 0), (pad, pad), (0, 0)))
    return sum(xp[:, j:j + length] * w[j] for j in range(CONV_K))


def axial_rope_tables(length):
    rows = length // GRID_W
    row = jnp.broadcast_to(jnp.arange(rows)[:, None], (rows, GRID_W)).reshape(-1).astype(jnp.float32)
    col = jnp.broadcast_to(jnp.arange(GRID_W)[None, :], (rows, GRID_W)).reshape(-1).astype(jnp.float32)
    n_freq = DIFF_DQK // 4
    inv_freq = ROPE_THETA ** (-jnp.arange(n_freq, dtype=jnp.float32) / n_freq)
    ang_r = row[:, None] * inv_freq
    ang_c = col[:, None] * inv_freq
    return (jnp.cos(ang_r), jnp.sin(ang_r), jnp.cos(ang_c), jnp.sin(ang_c))


def rotate(x, cos, sin):
    x1, x2 = jnp.split(x, 2, axis=-1)
    return jnp.concatenate([x1 * cos - x2 * sin, x2 * cos + x1 * sin], axis=-1)


def axial_rope(x, tables):
    cos_r, sin_r, cos_c, sin_c = [t[None, :, None, None, :].astype(x.dtype) for t in tables]
    xr, xc = jnp.split(x, 2, axis=-1)
    return jnp.concatenate([rotate(xr, cos_r, sin_r), rotate(xc, cos_c, sin_c)], axis=-1)


def gdn_prepare(qkv, a_raw, b_raw, conv_w, a_log, dt_bias):
    b, length, _ = qkv.shape
    qkv = jax.nn.silu(centred_conv(qkv, conv_w)).astype(jnp.float32)
    q, k, v = jnp.split(qkv, 3, axis=-1)
    q = l2_norm(q.reshape(b, length, GDN_HEADS, GDN_DK)) * (GDN_DK ** -0.5)
    k = l2_norm(k.reshape(b, length, GDN_HEADS, GDN_DK))
    v = v.reshape(b, length, GDN_HEADS, GDN_DV)
    g = -jnp.exp(a_log.astype(jnp.float32)) * jax.nn.softplus(
        a_raw.astype(jnp.float32).reshape(b, length, 2, GDN_HEADS) + dt_bias.astype(jnp.float32))
    beta = jax.nn.sigmoid(b_raw.astype(jnp.float32).reshape(b, length, 2, GDN_HEADS))
    return q, k, v, g, beta


def gdn_chunk_scan(q, k, v, g, beta, s0, with_out):
    b, length, h, _ = q.shape
    n = length // CHUNK

    def chunks(t):
        t = t.reshape((b, n, CHUNK, h) + t.shape[3:])
        return jnp.moveaxis(t, (1, 3), (0, 2))

    kc, vc, bc = chunks(k), chunks(v), chunks(beta)
    gc = jnp.cumsum(chunks(g), axis=-1)
    idx = jnp.arange(CHUNK)
    incl = idx[:, None] >= idx[None, :]
    strict = idx[:, None] > idx[None, :]
    decay = jnp.where(incl, jnp.exp(jnp.where(incl, gc[..., :, None] - gc[..., None, :], 0.0)), 0.0)
    a_mat = jnp.where(strict, jnp.einsum('nbhid,nbhjd->nbhij', kc * bc[..., None], kc) * decay, 0.0)
    eye = jnp.eye(CHUNK, dtype=a_mat.dtype)
    t_mat = lax.linalg.triangular_solve(eye + a_mat, jnp.broadcast_to(eye, a_mat.shape),
                                        left_side=True, lower=True)
    u = t_mat @ (vc * bc[..., None])
    w = t_mat @ (kc * (bc * jnp.exp(gc))[..., None])
    g_last = gc[..., -1]
    k_dec = kc * jnp.exp(g_last[..., None] - gc)[..., None]
    xs = (u, w, k_dec, g_last)
    if with_out:
        qc = chunks(q)
        qk = jnp.where(incl, jnp.einsum('nbhid,nbhjd->nbhij', qc, kc) * decay, 0.0)
        xs = xs + (qc * jnp.exp(gc)[..., None], qk)

    def step(s, xs_i):
        u_i, w_i, kd_i, gl_i = xs_i[:4]
        v_new = u_i - jnp.einsum('bhck,bhkv->bhcv', w_i, s)
        s_next = s * jnp.exp(gl_i)[..., None, None] + jnp.einsum('bhck,bhcv->bhkv', kd_i, v_new)
        if with_out:
            qd_i, qk_i = xs_i[4:]
            o = jnp.einsum('bhck,bhkv->bhcv', qd_i, s) + jnp.einsum('bhij,bhjv->bhiv', qk_i, v_new)
            return s_next, o
        return s_next, None

    s_final, o = lax.scan(step, s0, xs)
    if with_out:
        o = jnp.moveaxis(o, (0, 2), (1, 3)).reshape(b, length, h, v.shape[-1])
    return s_final, o


def flip_if(t, rev):
    return t[:, ::-1] if rev else t


def gdn_bidirectional(ctx_in, lat_in, with_ctx_out):
    q_c, k_c, v_c, g_c, beta_c = ctx_in
    q_l, k_l, v_l, g_l, beta_l = lat_in
    b = q_l.shape[0]
    o_lat = 0.0
    o_ctx = 0.0
    for d in range(2):
        rev = d == 1
        s0 = jnp.zeros((b, GDN_HEADS, GDN_DK, GDN_DV), jnp.float32)
        s_ctx, oc = gdn_chunk_scan(flip_if(q_c, rev), flip_if(k_c, rev), flip_if(v_c, rev),
                                   flip_if(g_c[:, :, d], rev), flip_if(beta_c[:, :, d], rev), s0, with_ctx_out)
        _, ol = gdn_chunk_scan(flip_if(q_l, rev), flip_if(k_l, rev), flip_if(v_l, rev),
                               flip_if(g_l[:, :, d], rev), flip_if(beta_l[:, :, d], rev), s_ctx, True)
        o_lat = o_lat + flip_if(ol, rev)
        if with_ctx_out:
            o_ctx = o_ctx + flip_if(oc, rev)
    return o_lat, (o_ctx if with_ctx_out else None)


def diff_heads(raw, gain, rope):
    b, length, _ = raw.shape
    t = rms_norm(raw.reshape(b, length, DIFF_HEADS, 2, DIFF_DQK), gain)
    if rope is not None:
        t = axial_rope(t, rope)
    return t


def diff_attend(q, k, v, lam):
    b, lq = q.shape[:2]
    nb = lq // Q_BLOCK
    qb = jnp.moveaxis(q.reshape((b, nb, Q_BLOCK) + q.shape[2:]), 1, 0)
    scale = DIFF_DQK ** -0.5

    def block(qi):
        s = jnp.einsum('bqhcd,bkhcd->bhcqk', qi, k).astype(jnp.float32) * scale
        p = jax.nn.softmax(s, axis=-1)
        attn = p[:, :, 0] - lam * p[:, :, 1]
        return jnp.einsum('bhqk,bkhv->bqhv', attn.astype(v.dtype), v)

    o = lax.map(block, qb)
    return jnp.moveaxis(o, 0, 1).reshape((b, lq) + v.shape[2:])


def mixer_output(o_a, z_a, o_b, z_b, gate_cols, gdn_norm_w, diff_norm_w, lambda_init, w_oa, w_ob, w_out):
    b, length = z_a.shape[:2]
    y_a = rms_norm(o_a.astype(z_a.dtype), gdn_norm_w) * jax.nn.silu(z_a.reshape(b, length, GDN_HEADS, GDN_DV))
    y_b = rms_norm(o_b, diff_norm_w) * (1.0 - lambda_init) * jax.nn.silu(z_b.reshape(b, length, DIFF_HEADS, DIFF_DV))
    g_a, g_b = jnp.split(jax.nn.sigmoid(gate_cols), 2, axis=-1)
    merged = g_a * (y_a.reshape(b, length, GDN_WIDTH) @ w_oa) + g_b * (y_b.reshape(b, length, DIFF_V_WIDTH) @ w_ob)
    return merged @ w_out


def hybrid_layer(x, ctx, c, c_ctx, layer, w_ada, b_ada, w_in, conv_w, a_log, dt_bias, gdn_norm_w,
                 q_norm_w, k_norm_w, lambda_q1, lambda_k1, lambda_q2, lambda_k2, diff_norm_w,
                 w_oa, w_ob, w_out, rope, update_ctx):
    b, length, _ = x.shape
    n_ctx = ctx.shape[1]
    shift, scale, gate = jnp.split(jax.nn.silu(c) @ w_ada + b_ada, 3, axis=-1)
    shift_c, scale_c, gate_c = jnp.split(jax.nn.silu(c_ctx) @ w_ada + b_ada, 3, axis=-1)
    h = rms_norm(x) * (1.0 + scale[:, None]) + shift[:, None]
    hc = rms_norm(ctx) * (1.0 + scale_c) + shift_c
    qkv_a, z_a, a_raw, b_raw, q_b, k_b, v_b, z_b, gates = split_cols(h @ w_in)
    qkv_ac, z_ac, a_rawc, b_rawc, q_bc, k_bc, v_bc, z_bc, gates_c = split_cols(hc @ w_in)

    o_a, o_ac = gdn_bidirectional(gdn_prepare(qkv_ac, a_rawc, b_rawc, conv_w, a_log, dt_bias),
                                  gdn_prepare(qkv_a, a_raw, b_raw, conv_w, a_log, dt_bias), update_ctx)

    lambda_init = 0.8 - 0.6 * math.exp(-0.3 * layer)
    lam = (jnp.exp(jnp.sum(lambda_q1.astype(jnp.float32) * lambda_k1.astype(jnp.float32)))
           - jnp.exp(jnp.sum(lambda_q2.astype(jnp.float32) * lambda_k2.astype(jnp.float32))) + lambda_init)
    q_l = diff_heads(q_b, q_norm_w, rope)
    k_l = diff_heads(k_b, k_norm_w, rope)
    k_c = diff_heads(k_bc, k_norm_w, None)
    v_l = v_b.reshape(b, length, DIFF_HEADS, DIFF_DV)
    v_c = v_bc.reshape(b, n_ctx, DIFF_HEADS, DIFF_DV)
    o_b = diff_attend(q_l, jnp.concatenate([k_c, k_l], axis=1), jnp.concatenate([v_c, v_l], axis=1), lam)

    x = x + gate[:, None] * mixer_output(o_a, z_a, o_b, z_b, gates, gdn_norm_w, diff_norm_w,
                                         lambda_init, w_oa, w_ob, w_out)
    if update_ctx:
        q_c = diff_heads(q_bc, q_norm_w, None)
        o_bc = diff_attend(q_c, k_c, v_c, lam)
        ctx = ctx + gate_c * mixer_output(o_ac, z_ac, o_bc, z_bc, gates_c, gdn_norm_w, diff_norm_w,
                                          lambda_init, w_oa, w_ob, w_out)
    return x, ctx


def setup_inputs(seed: int = 0) -> dict:
    key = jax.random.key(seed)
    ks = jax.random.split(key, 21)

    def nrm(k, shape, s):
        return jax.random.normal(k, shape, jnp.float32) * s

    dt = jnp.exp(jax.random.uniform(ks[8], (DEPTH, 2, GDN_HEADS), jnp.float32,
                                    minval=math.log(1e-3), maxval=math.log(1e-1)))
    return {
        'x': nrm(ks[0], (BATCH, SEQ, D_MODEL), 1.0),
        'c': nrm(ks[1], (BATCH, D_MODEL), 1.0),
        'ctx': nrm(ks[2], (BATCH, CTX_LEN, D_MODEL), 1.0),
        'c_ctx': nrm(ks[3], (D_MODEL,), 1.0),
        'w_ada': nrm(ks[4], (DEPTH, D_MODEL, 3 * D_MODEL), D_MODEL ** -0.5),
        'b_ada': nrm(ks[5], (DEPTH, 3 * D_MODEL), 0.01),
        'w_in': nrm(ks[6], (DEPTH, D_MODEL, IN_COLS), D_MODEL ** -0.5),
        'conv_w': nrm(ks[7], (DEPTH, CONV_K, 3 * GDN_WIDTH), CONV_K ** -0.5),
        'a_log': jnp.log(jax.random.uniform(ks[9], (DEPTH, 2, GDN_HEADS), jnp.float32, minval=1.0, maxval=16.0)),
        'dt_bias': dt + jnp.log(-jnp.expm1(-dt)),
        'gdn_norm_w': 1.0 + nrm(ks[10], (DEPTH, GDN_DV), 0.02),
        'q_norm_w': 1.0 + nrm(ks[11], (DEPTH, DIFF_DQK), 0.02),
        'k_norm_w': 1.0 + nrm(ks[12], (DEPTH, DIFF_DQK), 0.02),
        'lambda_q1': nrm(ks[13], (DEPTH, DIFF_DQK), 0.1),
        'lambda_k1': nrm(ks[14], (DEPTH, DIFF_DQK), 0.1),
        'lambda_q2': nrm(ks[15], (DEPTH, DIFF_DQK), 0.1),
        'lambda_k2': nrm(ks[16], (DEPTH, DIFF_DQK), 0.1),
        'diff_norm_w': 1.0 + nrm(ks[17], (DEPTH, DIFF_DV), 0.02),
        'w_oa': nrm(ks[18], (DEPTH, GDN_WIDTH, D_MODEL), GDN_WIDTH ** -0.5),
        'w_ob': nrm(ks[19], (DEPTH, DIFF_V_WIDTH, D_MODEL), DIFF_V_WIDTH ** -0.5),
        'w_out': nrm(ks[20], (DEPTH, D_MODEL, D_MODEL), D_MODEL ** -0.5),
    }


def reference(x, c, ctx, c_ctx, w_ada, b_ada, w_in, conv_w, a_log, dt_bias, gdn_norm_w,
              q_norm_w, k_norm_w, lambda_q1, lambda_k1, lambda_q2, lambda_k2, diff_norm_w,
              w_oa, w_ob, w_out):
    rope = axial_rope_tables(x.shape[1])
    for layer in range(DEPTH):
        x, ctx = hybrid_layer(x, ctx, c, c_ctx, layer, w_ada[layer], b_ada[layer], w_in[layer],
                              conv_w[layer], a_log[layer], dt_bias[layer], gdn_norm_w[layer],
                              q_norm_w[layer], k_norm_w[layer], lambda_q1[layer], lambda_k1[layer],
                              lambda_q2[layer], lambda_k2[layer], diff_norm_w[layer],
                              w_oa[layer], w_ob[layer], w_out[layer], rope, layer < DEPTH - 1)
    return x
```

```cpp
#include <hip/hip_runtime.h>
#include <cstdio>
#include <cstdint>

#define GAS __attribute__((address_space(1)))
#define LAS __attribute__((address_space(3)))
typedef unsigned short bf16;
typedef unsigned v4u __attribute__((ext_vector_type(4)));
typedef unsigned v2u __attribute__((ext_vector_type(2)));
typedef float f32x4 __attribute__((ext_vector_type(4)));

constexpr int NB = 2, SEQ = 8192, DM = 1024, LCTX = 256, NH = 8;
constexpr int MLAT = NB * SEQ, MCTX = NB * LCTX, MTOT = MLAT + MCTX;
constexpr int IN_COLS = 10272;
constexpr int N1 = 6400, N2ALL = 7168;
constexpr float EPS = 1e-6f;
constexpr float QSCALE = 0.125f * 1.4426950408889634f;

constexpr size_t MiB = 1u << 20;
constexpr size_t WS_CTL = 0, CTL_BYTES = 1 * MiB;
constexpr size_t WS_MODP = 1 * MiB;
constexpr size_t WS_MOD = 2 * MiB;
constexpr size_t WS_W2T = 3 * MiB;
constexpr size_t WS_AB = 17 * MiB;
constexpr size_t WS_T = 20 * MiB;
constexpr size_t WS_QKV = 53 * MiB;
constexpr size_t WS_QB = 152 * MiB;
constexpr size_t WS_KB = 184 * MiB;
constexpr size_t WS_VB = 217 * MiB;
constexpr size_t WS_END = 250 * MiB;
constexpr size_t WS_MERGED = 20 * MiB;
constexpr size_t WS_H2 = 53 * MiB;
constexpr size_t WS_NA = 85 * MiB;
constexpr size_t WS_T1 = 117 * MiB;
constexpr size_t WS_GATES = 184 * MiB;
constexpr size_t DO_H = 0;
constexpr size_t DO_W1T = 33 * MiB;

constexpr int LDS_BYTES = 147456;
constexpr int MISC_OFF = 131072 + 320;

__device__ __forceinline__ unsigned f2bf(float f) { unsigned u = __builtin_bit_cast(unsigned, f); return (u + 0x7fffu + ((u >> 16) & 1u)) >> 16; }
__device__ __forceinline__ unsigned pk2(float lo, float hi) { return f2bf(lo) | (f2bf(hi) << 16); }
__device__ __forceinline__ float bf2f(unsigned short h) { return __builtin_bit_cast(float, (unsigned)h << 16); }
__device__ __forceinline__ float bflo(unsigned w) { return __builtin_bit_cast(float, w << 16); }
__device__ __forceinline__ float bfhi(unsigned w) { return __builtin_bit_cast(float, w & 0xffff0000u); }
__device__ __forceinline__ float silu_f(float x) { return x / (1.f + __expf(-x)); }
__device__ __forceinline__ float sigmoid_f(float x) { return 1.f / (1.f + __expf(-x)); }
__device__ __forceinline__ float softplus_f(float x) { return fmaxf(x, 0.f) + log1pf(__expf(-fabsf(x))); }

#define XB_TMO      128
#define XB_XCNT(j)  (256  + 64 * (j))
#define XB_XSUB(j)  (1280 + 64 * (j))
#define XB_XGEN(j)  (2304 + 64 * (j))
#define XB_TOP      3328
#define XB_TOPGEN   3392
#define XCD_BAR_WORDS 3456
#define XB_SPIN_CAP (1u << 22)
__device__ __forceinline__ unsigned xb_ld(unsigned* p)              { return __hip_atomic_load(p, __ATOMIC_RELAXED, __HIP_MEMORY_SCOPE_AGENT); }
__device__ __forceinline__ unsigned xb_add(unsigned* p, unsigned v) { return __hip_atomic_fetch_add(p, v, __ATOMIC_RELAXED, __HIP_MEMORY_SCOPE_AGENT); }
__device__ __forceinline__ unsigned xb_xcc_id() { return (unsigned)__builtin_amdgcn_s_getreg((3 << 11) | 20) & 0xFu; }
#define XB_SPIN(cond, bar) do { unsigned _sp = 0; while (cond) { __builtin_amdgcn_s_sleep(1); \
    if ((++_sp & 255u) == 0u) { if (xb_ld(&(bar)[XB_TMO])) break; if (_sp > XB_SPIN_CAP) { atomicAdd(&(bar)[XB_TMO], 1u); break; } } } } while (0)
struct XcdBarrier { unsigned* bar; unsigned x; volatile LAS unsigned* st; };
__device__ __forceinline__ XcdBarrier xcd_barrier_post(unsigned* bar, volatile LAS unsigned* st) {
    XcdBarrier b; b.bar = bar; b.x = xb_xcc_id(); b.st = st;
    if (threadIdx.x == 0) (void)xb_add(&bar[XB_XCNT(b.x)], 1u);
    return b;
}
__device__ __forceinline__ void xcd_barrier_complete(unsigned* bar, unsigned x, unsigned& nloc, unsigned& nx) {
    const unsigned G = gridDim.x * gridDim.y * gridDim.z;
    unsigned sum, cnt, mine, sp = 0u;
    for (;;) {
        sum = 0u; cnt = 0u; mine = 0u;
#pragma unroll
        for (unsigned j = 0; j < 16; ++j) { const unsigned c = xb_ld(&bar[XB_XCNT(j)]); sum += c; cnt += (c > 0u) ? 1u : 0u; mine = (j == x) ? c : mine; }
        if (sum == G) break;
        __builtin_amdgcn_s_sleep(1);
        if ((++sp & 255u) == 0u) { if (xb_ld(&bar[XB_TMO])) break; if (sp > XB_SPIN_CAP) { atomicAdd(&bar[XB_TMO], 1u); break; } }
    }
    nloc = mine > 0u ? mine : 1u; nx = cnt > 0u ? cnt : 1u;
}
__device__ __forceinline__ void xcd_barrier(const XcdBarrier& b) {
    asm volatile("s_waitcnt vmcnt(0)" ::: "memory");
    __syncthreads();
    if (threadIdx.x == 0) {
        unsigned* bar = b.bar;
        __builtin_amdgcn_s_waitcnt(0);
        unsigned nloc = b.st[0], nx = b.st[1];
        if (nloc == 0u) { xcd_barrier_complete(bar, b.x, nloc, nx); b.st[0] = nloc; b.st[1] = nx; }
        const unsigned old = xb_add(&bar[XB_XSUB(b.x)], 1u);
        const unsigned gen = old / nloc;
        if (old + 1u == (gen + 1u) * nloc) {
            __builtin_amdgcn_fence(__ATOMIC_RELEASE, "agent");
            asm volatile("s_waitcnt vmcnt(0)" ::: "memory");
            const unsigned og = xb_add(&bar[XB_TOP], 1u);
            const unsigned tg = og / nx;
            if (og + 1u == (tg + 1u) * nx) xb_add(&bar[XB_TOPGEN], 1u);
            else XB_SPIN(xb_ld(&bar[XB_TOPGEN]) == tg, bar);
            __builtin_amdgcn_fence(__ATOMIC_ACQUIRE, "agent");
            xb_add(&bar[XB_XGEN(b.x)], 1u);
            asm volatile("s_waitcnt vmcnt(0)" ::: "memory");
        } else {
            XB_SPIN(xb_ld(&bar[XB_XGEN(b.x)]) == gen, bar);
            __builtin_amdgcn_fence(__ATOMIC_ACQUIRE, "agent");
            asm volatile("s_waitcnt vmcnt(0)" ::: "memory");
        }
    }
    __syncthreads();
}

struct Args {
    const float* x; const float* c; const float* ctx; const float* c_ctx; const float* w_ada; const float* b_ada; const float* w_in; const float* conv_w;
    const float* a_log; const float* dt_bias; const float* gdn_norm_w; const float* q_norm_w; const float* k_norm_w;
    const float* lq1; const float* lk1; const float* lq2; const float* lk2; const float* diff_norm_w; const float* w_oa; const float* w_ob; const float* w_out;
    float* out; unsigned char* ws;
};

__device__ __forceinline__ float wave_sum(float v) {
#pragma unroll
    for (int o = 1; o < 64; o <<= 1) v += __shfl_xor(v, o);
    return v;
}

__device__ __forceinline__ int w1_src(int n) { if (n < 3072) return n; if (n < 4096) return 4128 + (n - 3072); if (n < 5120) return 5152 + (n - 4096); if (n < 6144) return 6176 + (n - 5120);
    if (n < 6176) return 4096 + (n - 6144); return -1; }
__device__ __forceinline__ int w2_src(int n) { if (n < 1024) return 3072 + n; if (n < 2048) return 7200 + (n - 1024); return 8224 + (n - 2048); }
__device__ __forceinline__ void transpose_item(const float* W, int ldw, int c0, bf16* WT, int n0, int k0, LAS float* scr, int lane) {
#pragma unroll 8
    for (int i = 0; i < 32; ++i) { const int kk = 2 * i + (lane >> 5); scr[kk * 33 + (lane & 31)] = (c0 >= 0) ? W[(size_t)(k0 + kk) * ldw + c0 + (lane & 31)] : 0.f; }
    asm volatile("s_waitcnt lgkmcnt(0)" ::: "memory");
    const int c = lane & 7;
#pragma unroll
    for (int j = 0; j < 4; ++j) { const int n = (lane >> 3) + 8 * j; const LAS float* s = scr + (8 * c) * 33 + n;
        v4u o; o.x = pk2(s[0 * 33], s[1 * 33]); o.y = pk2(s[2 * 33], s[3 * 33]); o.z = pk2(s[4 * 33], s[5 * 33]); o.w = pk2(s[6 * 33], s[7 * 33]);
        *(v4u*)(WT + (size_t)(n0 + n) * 1024 + k0 + 8 * c) = o; }
    asm volatile("s_waitcnt lgkmcnt(0)" ::: "memory");
}

template <class Epi>
__device__ __forceinline__ void gemm_naive(unsigned char* ldsg, const bf16* A, const bf16* Bt, int M, int N, int K, const Epi& epi) {
    float* As = (float*)ldsg; float* Bs = As + 32 * 132;
    const int tid = threadIdx.x, ty = tid >> 4, tx = tid & 15;
    const int nM = M / 128, nN = N / 128;
    for (int unit = blockIdx.x; unit < nM * nN; unit += gridDim.x) {
        const int pm = unit / nN, pn = unit % nN;
        float acc[4][8];
#pragma unroll
        for (int i = 0; i < 4; ++i)
#pragma unroll
            for (int j = 0; j < 8; ++j) acc[i][j] = 0.f;
        const int srow = tid >> 2, skc = (tid & 3) * 8;
        for (int k0 = 0; k0 < K; k0 += 32) {
            const v4u av = *(const v4u*)(A + (size_t)(pm * 128 + srow) * K + k0 + skc);
            const v4u bv = *(const v4u*)(Bt + (size_t)(pn * 128 + srow) * K + k0 + skc);
            As[(skc + 0) * 132 + srow] = bflo(av.x); As[(skc + 1) * 132 + srow] = bfhi(av.x); As[(skc + 2) * 132 + srow] = bflo(av.y); As[(skc + 3) * 132 + srow] = bfhi(av.y);
            As[(skc + 4) * 132 + srow] = bflo(av.z); As[(skc + 5) * 132 + srow] = bfhi(av.z); As[(skc + 6) * 132 + srow] = bflo(av.w); As[(skc + 7) * 132 + srow] = bfhi(av.w);
            Bs[(skc + 0) * 132 + srow] = bflo(bv.x); Bs[(skc + 1) * 132 + srow] = bfhi(bv.x); Bs[(skc + 2) * 132 + srow] = bflo(bv.y); Bs[(skc + 3) * 132 + srow] = bfhi(bv.y);
            Bs[(skc + 4) * 132 + srow] = bflo(bv.z); Bs[(skc + 5) * 132 + srow] = bfhi(bv.z); Bs[(skc + 6) * 132 + srow] = bflo(bv.w); Bs[(skc + 7) * 132 + srow] = bfhi(bv.w);
            __syncthreads();
#pragma unroll 8
            for (int kk = 0; kk < 32; ++kk) {
                const f32x4 a = *(const f32x4*)(As + kk * 132 + ty * 4);
                const f32x4 b0 = *(const f32x4*)(Bs + kk * 132 + tx * 8), b1 = *(const f32x4*)(Bs + kk * 132 + tx * 8 + 4);
#pragma unroll
                for (int i = 0; i < 4; ++i) { acc[i][0] += a[i] * b0[0]; acc[i][1] += a[i] * b0[1]; acc[i][2] += a[i] * b0[2]; acc[i][3] += a[i] * b0[3];
                    acc[i][4] += a[i] * b1[0]; acc[i][5] += a[i] * b1[1]; acc[i][6] += a[i] * b1[2]; acc[i][7] += a[i] * b1[3]; }
            }
            __syncthreads();
        }
#pragma unroll
        for (int i = 0; i < 4; ++i)
#pragma unroll
            for (int j = 0; j < 8; ++j) epi(pm * 128 + ty * 4 + i, pn * 128 + tx * 8 + j, acc[i][j]);
    }
}

struct EpiR1 { bf16* QKV; bf16* QB; bf16* KB; bf16* VB; float* AB;
    __device__ __forceinline__ void operator()(int r, int c, float v) const {
        if (c < 3072) QKV[(size_t)r * 3072 + c] = (bf16)f2bf(v);
        else if (c < 4096) { if (r < MLAT) QB[(size_t)r * 1024 + (c - 3072)] = (bf16)f2bf(v); }
        else if (c < 5120) KB[(size_t)r * 1024 + (c - 4096)] = (bf16)f2bf(v);
        else if (c < 6144) VB[(size_t)r * 1024 + (c - 5120)] = (bf16)f2bf(v);
        else if (c < 6176) AB[(size_t)r * 32 + (c - 6144)] = v;
    } };
struct EpiR2 { bf16* NA; bf16* QB; bf16* GATES;
    __device__ __forceinline__ void operator()(int r, int c, float v) const {
        if (c < 1024) { bf16* p = NA + (size_t)r * 1024 + c; *p = (bf16)f2bf(silu_f(v) * bf2f(*p)); }
        else if (c < 2048) { bf16* p = QB + (size_t)r * 1024 + (c - 1024); *p = (bf16)f2bf(0.8f * silu_f(v) * bf2f(*p)); }
        else GATES[(size_t)r * 2048 + (c - 2048)] = (bf16)f2bf(sigmoid_f(v));
    } };
struct EpiF1 { bf16* T1; const bf16* GATES;
    __device__ __forceinline__ void operator()(int r, int c, float v) const { T1[(size_t)r * 1024 + c] = (bf16)f2bf(v * bf2f(GATES[(size_t)r * 2048 + c])); } };
struct EpiF2 { bf16* MERGED; const bf16* T1; const bf16* GATES;
    __device__ __forceinline__ void operator()(int r, int c, float v) const { MERGED[(size_t)r * 1024 + c] = (bf16)f2bf(bf2f(T1[(size_t)r * 1024 + c]) + v * bf2f(GATES[(size_t)r * 2048 + 1024 + c])); } };
struct EpiG { float* out; const float* x; const float* mod;
    __device__ __forceinline__ void operator()(int r, int c, float v) const { const int b = r / SEQ; out[(size_t)r * 1024 + c] = x[(size_t)r * 1024 + c] + mod[b * 3072 + 2048 + c] * v; } };

__global__ void __launch_bounds__(512, 2) hybrid_fwd(Args a) {
    extern __shared__ __attribute__((aligned(16))) unsigned char lds[];
    const int tid = threadIdx.x, lane = tid & 63, wave = __builtin_amdgcn_readfirstlane(tid >> 6);
    const int G = gridDim.x, bid = blockIdx.x;
    const int gw = bid * 8 + wave, NGW = G * 8;
    unsigned char* ws = a.ws;
    unsigned* ctl = (unsigned*)(ws + WS_CTL);
    volatile LAS unsigned* MISC = (volatile LAS unsigned*)((LAS unsigned char*)lds + MISC_OFF);
    for (int u = tid; u < (LDS_BYTES - 131072) / 4; u += 512) ((LAS unsigned*)((LAS unsigned char*)lds + 131072))[u] = 0u;
    __syncthreads();
    XcdBarrier bar = xcd_barrier_post(ctl + 4096, MISC + 8);

    float* MODP = (float*)(ws + WS_MODP); float* MOD = (float*)(ws + WS_MOD);
    bf16* W2T = (bf16*)(ws + WS_W2T); float* AB = (float*)(ws + WS_AB);
    bf16* QKV = (bf16*)(ws + WS_QKV); bf16* QB = (bf16*)(ws + WS_QB); bf16* KB = (bf16*)(ws + WS_KB); bf16* VB = (bf16*)(ws + WS_VB);
    bf16* MERGED = (bf16*)(ws + WS_MERGED); bf16* H2 = (bf16*)(ws + WS_H2); bf16* NA = (bf16*)(ws + WS_NA); bf16* T1 = (bf16*)(ws + WS_T1); bf16* GATES = (bf16*)(ws + WS_GATES);
    bf16* H = (bf16*)((unsigned char*)a.out + DO_H); bf16* W1T = (bf16*)((unsigned char*)a.out + DO_W1T);

    {
        for (int u = bid; u < 48; u += G) {
            const int ks = u / 6, nb = u % 6, n = nb * 512 + tid;
            float s0 = 0.f, s1 = 0.f, s2 = 0.f;
            for (int k = ks * 128; k < ks * 128 + 128; ++k) {
                const float w = a.w_ada[(size_t)k * 3072 + n];
                s0 += silu_f(a.c[k]) * w; s1 += silu_f(a.c[1024 + k]) * w; s2 += silu_f(a.c_ctx[k]) * w;
            }
            MODP[(ks * 3 + 0) * 3072 + n] = s0; MODP[(ks * 3 + 1) * 3072 + n] = s1; MODP[(ks * 3 + 2) * 3072 + n] = s2;
        }
        LAS float* scr = (LAS float*)((LAS unsigned char*)lds + wave * 16384);
        constexpr int NB1 = N1 / 32, NB2 = N2ALL / 32, NIT = 16 * (NB1 + NB2);
        for (int it = gw; it < NIT; it += NGW) {
            const int kb = it & 15, nbi = it >> 4;
            if (nbi < NB1) { const int n0 = nbi * 32; transpose_item(a.w_in, IN_COLS, w1_src(n0), W1T, n0, kb * 64, scr, lane); }
            else { const int n0 = (nbi - NB1) * 32;
                if (n0 < 4096) transpose_item(a.w_in, IN_COLS, w2_src(n0), W2T, n0, kb * 64, scr, lane);
                else if (n0 < 5120) transpose_item(a.w_oa, 1024, n0 - 4096, W2T, n0, kb * 64, scr, lane);
                else if (n0 < 6144) transpose_item(a.w_ob, 1024, n0 - 5120, W2T, n0, kb * 64, scr, lane);
                else transpose_item(a.w_out, 1024, n0 - 6144, W2T, n0, kb * 64, scr, lane); }
        }
    }
    xcd_barrier(bar);

    {
        float* modl = (float*)lds;
        for (int i = tid; i < 9216; i += 512) { const int n = i % 3072; float s = a.b_ada[n];
#pragma unroll
            for (int ks = 0; ks < 8; ++ks) s += MODP[ks * 9216 + i];
            modl[i] = s; if (bid == 0) MOD[i] = s; }
        __syncthreads();
        for (int r = gw; r < MTOT; r += NGW) {
            const float* xr; int v;
            if (r < MLAT) { xr = a.x + (size_t)r * 1024; v = r / SEQ; } else { xr = a.ctx + (size_t)(r - MLAT) * 1024; v = 2; }
            f32x4 xv[4]; float ss = 0.f;
#pragma unroll
            for (int j = 0; j < 4; ++j) { xv[j] = ((const f32x4*)xr)[64 * j + lane]; ss += (xv[j].x * xv[j].x + xv[j].y * xv[j].y) + (xv[j].z * xv[j].z + xv[j].w * xv[j].w); }
            const float rstd = 1.f / sqrtf(wave_sum(ss) * (1.f / 1024.f) + EPS);
            const float* sh = modl + v * 3072; const float* sc = sh + 1024;
#pragma unroll
            for (int j = 0; j < 4; ++j) { const int c0 = (64 * j + lane) * 4;
                const float h0 = xv[j].x * rstd * (1.f + sc[c0]) + sh[c0], h1 = xv[j].y * rstd * (1.f + sc[c0 + 1]) + sh[c0 + 1];
                const float h2 = xv[j].z * rstd * (1.f + sc[c0 + 2]) + sh[c0 + 2], h3 = xv[j].w * rstd * (1.f + sc[c0 + 3]) + sh[c0 + 3];
                v2u o; o.x = pk2(h0, h1); o.y = pk2(h2, h3); *(v2u*)(H + (size_t)r * 1024 + c0) = o; }
        }
    }
    xcd_barrier(bar);

    { EpiR1 e{QKV, QB, KB, VB, AB}; gemm_naive(lds, H, W1T, MTOT, N1, 1024, e); }
    xcd_barrier(bar);

    {
        for (size_t i = (size_t)bid * 512 + tid; i < (size_t)MLAT * 1024 / 4; i += (size_t)G * 512) ((f32x4*)a.out)[i] = (f32x4){0.f, 0.f, 0.f, 0.f};
        for (int it = gw; it < MLAT + MTOT; it += NGW) {
            const bool isq = it < MLAT; const int r = isq ? it : it - MLAT;
            bf16* p = (isq ? QB : KB) + (size_t)r * 1024 + lane * 16;
            const float* gw_ = isq ? a.q_norm_w : a.k_norm_w;
            const v4u w0 = *(const v4u*)p, w1 = *(const v4u*)(p + 8);
            float v[16] = {bflo(w0.x), bfhi(w0.x), bflo(w0.y), bfhi(w0.y), bflo(w0.z), bfhi(w0.z), bflo(w0.w), bfhi(w0.w),
                           bflo(w1.x), bfhi(w1.x), bflo(w1.y), bfhi(w1.y), bflo(w1.z), bfhi(w1.z), bflo(w1.w), bfhi(w1.w)};
            float ss = 0.f;
#pragma unroll
            for (int i = 0; i < 16; ++i) ss += v[i] * v[i];
            ss += __shfl_xor(ss, 1); ss += __shfl_xor(ss, 2);
            const float rstd = 1.f / sqrtf(ss * (1.f / 64.f) + EPS);
            const int sub = lane & 3;
#pragma unroll
            for (int i = 0; i < 16; ++i) v[i] = v[i] * rstd * gw_[sub * 16 + i];
            if (r < MLAT) {
                const int t = r % SEQ; const float pos = (float)((sub < 2) ? (t >> 6) : (t & 63));
#pragma unroll
                for (int i = 0; i < 16; ++i) {
                    const float other = __shfl_xor(v[i], 1);
                    const float invf = exp2f(-(float)i * (13.287712379549449f / 16.f));
                    const float ang = pos * invf; const float cs = cosf(ang), sn = sinf(ang);
                    v[i] = (sub & 1) ? (v[i] * cs + other * sn) : (v[i] * cs - other * sn);
                }
            }
            const float sc = isq ? QSCALE : 1.f;
            v4u o0, o1; o0.x = pk2(v[0] * sc, v[1] * sc); o0.y = pk2(v[2] * sc, v[3] * sc); o0.z = pk2(v[4] * sc, v[5] * sc); o0.w = pk2(v[6] * sc, v[7] * sc);
            o1.x = pk2(v[8] * sc, v[9] * sc); o1.y = pk2(v[10] * sc, v[11] * sc); o1.z = pk2(v[12] * sc, v[13] * sc); o1.w = pk2(v[14] * sc, v[15] * sc);
            *(v4u*)p = o0; *(v4u*)(p + 8) = o1;
        }
    }
    xcd_barrier(bar);

    {
        for (int wu = gw; wu < 1024; wu += NGW) {
            const int chain = wu >> 5, sl = wu & 31; const int b = chain >> 4, h = (chain >> 1) & 7, d = chain & 1;
            const int g = lane >> 2, dv = sl * 4 + (lane & 3);
            const float Aexp = __expf(a.a_log[d * 8 + h]), dtb = a.dt_bias[d * 8 + h];
            float wq[5][8], wk[5][8], wv[5];
#pragma unroll
            for (int j = 0; j < 5; ++j) { wv[j] = a.conv_w[j * 3072 + 2048 + h * 128 + dv];
#pragma unroll
                for (int i = 0; i < 8; ++i) { wq[j][i] = a.conv_w[j * 3072 + h * 128 + g * 8 + i]; wk[j][i] = a.conv_w[j * 3072 + 1024 + h * 128 + g * 8 + i]; } }
            float S[8];
#pragma unroll
            for (int i = 0; i < 8; ++i) S[i] = 0.f;
            for (int seg = 0; seg < 2; ++seg) {
                const int Ls = seg == 0 ? LCTX : SEQ; const int r0 = seg == 0 ? MLAT + b * LCTX : b * SEQ;
                for (int step = 0; step < Ls; ++step) {
                    const int t = d ? (Ls - 1 - step) : step;
                    float q[8], k[8], v = 0.f;
#pragma unroll
                    for (int i = 0; i < 8; ++i) { q[i] = 0.f; k[i] = 0.f; }
#pragma unroll
                    for (int j = 0; j < 5; ++j) { const int tt = t + j - 2;
                        if (tt >= 0 && tt < Ls) { const bf16* rp = QKV + (size_t)(r0 + tt) * 3072 + h * 128;
                            const v4u qv = *(const v4u*)(rp + g * 8), kv = *(const v4u*)(rp + 1024 + g * 8);
                            v += bf2f(rp[2048 + dv]) * wv[j];
                            q[0] += bflo(qv.x) * wq[j][0]; q[1] += bfhi(qv.x) * wq[j][1]; q[2] += bflo(qv.y) * wq[j][2]; q[3] += bfhi(qv.y) * wq[j][3];
                            q[4] += bflo(qv.z) * wq[j][4]; q[5] += bfhi(qv.z) * wq[j][5]; q[6] += bflo(qv.w) * wq[j][6]; q[7] += bfhi(qv.w) * wq[j][7];
                            k[0] += bflo(kv.x) * wk[j][0]; k[1] += bfhi(kv.x) * wk[j][1]; k[2] += bflo(kv.y) * wk[j][2]; k[3] += bfhi(kv.y) * wk[j][3];
                            k[4] += bflo(kv.z) * wk[j][4]; k[5] += bfhi(kv.z) * wk[j][5]; k[6] += bflo(kv.w) * wk[j][6]; k[7] += bfhi(kv.w) * wk[j][7]; } }
                    v = silu_f(v); float sq = 0.f, sk = 0.f;
#pragma unroll
                    for (int i = 0; i < 8; ++i) { q[i] = silu_f(q[i]); k[i] = silu_f(k[i]); sq += q[i] * q[i]; sk += k[i] * k[i]; }
#pragma unroll
                    for (int o = 4; o < 64; o <<= 1) { sq += __shfl_xor(sq, o); sk += __shfl_xor(sk, o); }
                    const float rq = (1.f / sqrtf(sq + EPS)) * 0.08838834764831845f, rk = 1.f / sqrtf(sk + EPS);
                    const float araw = AB[(size_t)(r0 + t) * 32 + d * 8 + h], braw = AB[(size_t)(r0 + t) * 32 + 16 + d * 8 + h];
                    const float dec = __expf(-Aexp * softplus_f(araw + dtb)), beta = sigmoid_f(braw);
                    float kS = 0.f;
#pragma unroll
                    for (int i = 0; i < 8; ++i) { k[i] *= rk; S[i] *= dec; kS += k[i] * S[i]; }
#pragma unroll
                    for (int o = 4; o < 64; o <<= 1) kS += __shfl_xor(kS, o);
                    const float vn = beta * (v - kS); float oo = 0.f;
#pragma unroll
                    for (int i = 0; i < 8; ++i) { S[i] += k[i] * vn; oo += q[i] * rq * S[i]; }
#pragma unroll
                    for (int o = 4; o < 64; o <<= 1) oo += __shfl_xor(oo, o);
                    if (seg == 1 && lane < 4) atomicAdd(a.out + (size_t)(r0 + t) * 1024 + h * 128 + dv, oo);
                }
            }
        }
        __syncthreads();
        float lam;
        { float s1 = 0.f, s2 = 0.f; for (int i = 0; i < 64; ++i) { s1 += a.lq1[i] * a.lk1[i]; s2 += a.lq2[i] * a.lk2[i]; } lam = __expf(s1) - __expf(s2) + 0.2f; }
        float* Ks = (float*)lds; float* Vs = Ks + 64 * 128;
        const int qi = (tid >> 2) & 63, comp = tid >> 8, quarter = tid & 3;
        for (int unit = bid; unit < 2048; unit += G) {
            const int b = unit >> 10, h = (unit >> 7) & 7, qb = unit & 127;
            const int qrow = b * SEQ + qb * 64 + qi;
            float q[16], o[32], l = 0.f;
            { const bf16* qp = QB + (size_t)qrow * 1024 + h * 128 + comp * 64 + quarter * 16;
              const v4u w0 = *(const v4u*)qp, w1 = *(const v4u*)(qp + 8);
              q[0] = bflo(w0.x); q[1] = bfhi(w0.x); q[2] = bflo(w0.y); q[3] = bfhi(w0.y); q[4] = bflo(w0.z); q[5] = bfhi(w0.z); q[6] = bflo(w0.w); q[7] = bfhi(w0.w);
              q[8] = bflo(w1.x); q[9] = bfhi(w1.x); q[10] = bflo(w1.y); q[11] = bfhi(w1.y); q[12] = bflo(w1.z); q[13] = bfhi(w1.z); q[14] = bflo(w1.w); q[15] = bfhi(w1.w); }
#pragma unroll
            for (int i = 0; i < 32; ++i) o[i] = 0.f;
            for (int kt = 0; kt < (LCTX + SEQ) / 64; ++kt) {
                __syncthreads();
                { const int key = tid >> 3, c8 = (tid & 7) * 16; const int j = kt * 64 + key;
                  const size_t row = (j < LCTX) ? (size_t)(MLAT + b * LCTX + j) : (size_t)(b * SEQ + j - LCTX);
                  const bf16* kp = KB + row * 1024 + h * 128 + c8; const bf16* vp = VB + row * 1024 + h * 128 + c8;
                  const v4u k0 = *(const v4u*)kp, k1 = *(const v4u*)(kp + 8), v0 = *(const v4u*)vp, v1 = *(const v4u*)(vp + 8);
                  float* kd = Ks + key * 128 + c8; float* vd = Vs + key * 128 + c8;
                  kd[0] = bflo(k0.x); kd[1] = bfhi(k0.x); kd[2] = bflo(k0.y); kd[3] = bfhi(k0.y); kd[4] = bflo(k0.z); kd[5] = bfhi(k0.z); kd[6] = bflo(k0.w); kd[7] = bfhi(k0.w);
                  kd[8] = bflo(k1.x); kd[9] = bfhi(k1.x); kd[10] = bflo(k1.y); kd[11] = bfhi(k1.y); kd[12] = bflo(k1.z); kd[13] = bfhi(k1.z); kd[14] = bflo(k1.w); kd[15] = bfhi(k1.w);
                  vd[0] = bflo(v0.x); vd[1] = bfhi(v0.x); vd[2] = bflo(v0.y); vd[3] = bfhi(v0.y); vd[4] = bflo(v0.z); vd[5] = bfhi(v0.z); vd[6] = bflo(v0.w); vd[7] = bfhi(v0.w);
                  vd[8] = bflo(v1.x); vd[9] = bfhi(v1.x); vd[10] = bflo(v1.y); vd[11] = bfhi(v1.y); vd[12] = bflo(v1.z); vd[13] = bfhi(v1.z); vd[14] = bflo(v1.w); vd[15] = bfhi(v1.w); }
                __syncthreads();
                for (int key = 0; key < 64; ++key) {
                    const float* kr = Ks + key * 128 + comp * 64 + quarter * 16; float s = 0.f;
#pragma unroll
                    for (int i = 0; i < 16; ++i) s += q[i] * kr[i];
                    s += __shfl_xor(s, 1); s += __shfl_xor(s, 2);
                    const float p = exp2f(s); l += p;
                    const float* vr = Vs + key * 128 + quarter * 32;
#pragma unroll
                    for (int i = 0; i < 32; ++i) o[i] += p * vr[i];
                }
            }
            __syncthreads();
            const float il = 1.f / l;
            float* X = Ks;
            if (comp == 1) {
#pragma unroll
                for (int i = 0; i < 32; ++i) X[qi * 128 + quarter * 32 + i] = lam * o[i] * il;
            }
            __syncthreads();
            if (comp == 0) {
                float ss = 0.f;
#pragma unroll
                for (int i = 0; i < 32; ++i) { o[i] = o[i] * il - X[qi * 128 + quarter * 32 + i]; ss += o[i] * o[i]; }
                ss += __shfl_xor(ss, 1); ss += __shfl_xor(ss, 2);
                const float rstd = 1.f / sqrtf(ss * (1.f / 128.f) + EPS);
                bf16* op = QB + (size_t)qrow * 1024 + h * 128 + quarter * 32;
#pragma unroll
                for (int i = 0; i < 32; i += 2) *(unsigned*)(op + i) = pk2(o[i] * rstd * a.diff_norm_w[quarter * 32 + i], o[i + 1] * rstd * a.diff_norm_w[quarter * 32 + i + 1]);
            }
            __syncthreads();
        }
    }
    xcd_barrier(bar);

    {
        for (int r = gw; r < MLAT; r += NGW) {
            const float* xr = a.x + (size_t)r * 1024; const int v = r / SEQ;
            f32x4 xv[4]; float ss = 0.f;
#pragma unroll
            for (int j = 0; j < 4; ++j) { xv[j] = ((const f32x4*)xr)[64 * j + lane]; ss += (xv[j].x * xv[j].x + xv[j].y * xv[j].y) + (xv[j].z * xv[j].z + xv[j].w * xv[j].w); }
            const float rstd = 1.f / sqrtf(wave_sum(ss) * (1.f / 1024.f) + EPS);
            const float* sh = MOD + v * 3072; const float* sc = sh + 1024;
#pragma unroll
            for (int j = 0; j < 4; ++j) { const int c0 = (64 * j + lane) * 4;
                const float h0 = xv[j].x * rstd * (1.f + sc[c0]) + sh[c0], h1 = xv[j].y * rstd * (1.f + sc[c0 + 1]) + sh[c0 + 1];
                const float h2 = xv[j].z * rstd * (1.f + sc[c0 + 2]) + sh[c0 + 2], h3 = xv[j].w * rstd * (1.f + sc[c0 + 3]) + sh[c0 + 3];
                v2u o; o.x = pk2(h0, h1); o.y = pk2(h2, h3); *(v2u*)(H2 + (size_t)r * 1024 + c0) = o; }
            const float* orow = a.out + (size_t)r * 1024 + lane * 16;
            f32x4 ov[4]; float s2 = 0.f;
#pragma unroll
            for (int j = 0; j < 4; ++j) { ov[j] = ((const f32x4*)orow)[j]; s2 += (ov[j].x * ov[j].x + ov[j].y * ov[j].y) + (ov[j].z * ov[j].z + ov[j].w * ov[j].w); }
            s2 += __shfl_xor(s2, 1); s2 += __shfl_xor(s2, 2); s2 += __shfl_xor(s2, 4);
            const float r2 = 1.f / sqrtf(s2 * (1.f / 128.f) + EPS);
            const float* gwp = a.gdn_norm_w + (lane & 7) * 16;
            v4u o0, o1;
            o0.x = pk2(ov[0].x * r2 * gwp[0], ov[0].y * r2 * gwp[1]); o0.y = pk2(ov[0].z * r2 * gwp[2], ov[0].w * r2 * gwp[3]);
            o0.z = pk2(ov[1].x * r2 * gwp[4], ov[1].y * r2 * gwp[5]); o0.w = pk2(ov[1].z * r2 * gwp[6], ov[1].w * r2 * gwp[7]);
            o1.x = pk2(ov[2].x * r2 * gwp[8], ov[2].y * r2 * gwp[9]); o1.y = pk2(ov[2].z * r2 * gwp[10], ov[2].w * r2 * gwp[11]);
            o1.z = pk2(ov[3].x * r2 * gwp[12], ov[3].y * r2 * gwp[13]); o1.w = pk2(ov[3].z * r2 * gwp[14], ov[3].w * r2 * gwp[15]);
            *(v4u*)(NA + (size_t)r * 1024 + lane * 16) = o0; *(v4u*)(NA + (size_t)r * 1024 + lane * 16 + 8) = o1;
        }
    }
    xcd_barrier(bar);

    { EpiR2 e{NA, QB, GATES}; gemm_naive(lds, H2, W2T, MLAT, 4096, 1024, e); }
    xcd_barrier(bar);

    { EpiF1 e{T1, GATES}; gemm_naive(lds, NA, W2T + (size_t)4096 * 1024, MLAT, 1024, 1024, e); }
    { EpiF2 e{MERGED, T1, GATES}; gemm_naive(lds, QB, W2T + (size_t)5120 * 1024, MLAT, 1024, 1024, e); }
    xcd_barrier(bar);

    { EpiG e{a.out, a.x, MOD}; gemm_naive(lds, MERGED, W2T + (size_t)6144 * 1024, MLAT, 1024, 1024, e); }
}

extern "C" void kernel_launch(void* const* d_in, const int* in_sizes, int n_in, void* d_out, int out_size, void* d_ws, size_t ws_size, hipStream_t stream) {
    static int grid = 0;
    if (grid == 0) {
        if (n_in != 21 || in_sizes[0] != MLAT * DM || out_size != MLAT * DM || ws_size < WS_END) { fprintf(stderr, "kernel_launch: unexpected shapes n_in %d in0 %d out %d ws %zu\n", n_in, n_in > 0 ? in_sizes[0] : -1, out_size, ws_size); grid = -1; return; }
        int dev = 0, cus = 0, per_cu = 0;
        if (hipGetDevice(&dev) != hipSuccess || hipDeviceGetAttribute(&cus, hipDeviceAttributeMultiprocessorCount, dev) != hipSuccess) { grid = -1; return; }
        if (hipFuncSetAttribute((const void*)hybrid_fwd, hipFuncAttributeMaxDynamicSharedMemorySize, LDS_BYTES) != hipSuccess) { fprintf(stderr, "kernel_launch: hipFuncSetAttribute failed\n"); grid = -1; return; }
        if (hipOccupancyMaxActiveBlocksPerMultiprocessor(&per_cu, (const void*)hybrid_fwd, 512, LDS_BYTES) != hipSuccess || per_cu < 1) { fprintf(stderr, "kernel_launch: occupancy query says %d\n", per_cu); per_cu = 1; }
        (void)hipGetLastError();
        grid = cus;
    }
    if (grid < 0) return;
    (void)hipMemsetAsync((char*)d_ws + WS_CTL, 0, CTL_BYTES, stream);
    Args a{};
    a.x = (const float*)d_in[0]; a.c = (const float*)d_in[1]; a.ctx = (const float*)d_in[2]; a.c_ctx = (const float*)d_in[3]; a.w_ada = (const float*)d_in[4]; a.b_ada = (const float*)d_in[5];
    a.w_in = (const float*)d_in[6]; a.conv_w = (const float*)d_in[7]; a.a_log = (const float*)d_in[8]; a.dt_bias = (const float*)d_in[9]; a.gdn_norm_w = (const float*)d_in[10];
    a.q_norm_w = (const float*)d_in[11]; a.k_norm_w = (const float*)d_in[12]; a.lq1 = (const float*)d_in[13]; a.lk1 = (const float*)d_in[14]; a.lq2 = (const float*)d_in[15]; a.lk2 = (const float*)d_in[16];
    a.diff_norm_w = (const float*)d_in[17]; a.w_oa = (const float*)d_in[18]; a.w_ob = (const float*)d_in[19]; a.w_out = (const float*)d_in[20];
    a.out = (float*)d_out; a.ws = (unsigned char*)d_ws;
    hipLaunchKernelGGL(hybrid_fwd, dim3(grid), dim3(512), LDS_BYTES, stream, a);
    const hipError_t le = hipPeekAtLastError();
    if (le != hipSuccess) fprintf(stderr, "kernel_launch: launch failed: %s\n", hipGetErrorName(le));
}
```

```cpp
#include <hip/hip_runtime.h>
#include <cstdio>
#include <cstdint>
#define PG8_R1 1
#define PG8_R2 1
#define PG8_F1 1
#define PG8_F2 1
#define PG8_G 1
#define DIAG_IDX 0
#define R2_SKIP_Z 0

#define GAS __attribute__((address_space(1)))
#define LAS __attribute__((address_space(3)))
typedef unsigned short bf16;
typedef unsigned v4u __attribute__((ext_vector_type(4)));
typedef unsigned v2u __attribute__((ext_vector_type(2)));
typedef float f32x4 __attribute__((ext_vector_type(4)));

constexpr int NB = 2, SEQ = 8192, DM = 1024, LCTX = 256, NH = 8;
constexpr int MLAT = NB * SEQ, MCTX = NB * LCTX, MTOT = MLAT + MCTX;
constexpr int IN_COLS = 10272;
constexpr int N1 = 6400, N2ALL = 7168;
constexpr float EPS = 1e-6f;
constexpr float QSCALE = 0.125f * 1.4426950408889634f;

constexpr size_t MiB = 1u << 20;
constexpr size_t WS_CTL = 0, CTL_BYTES = 1 * MiB;
constexpr size_t WS_MODP = 1 * MiB;
constexpr size_t WS_MOD = 2 * MiB;
constexpr size_t WS_W2T = 3 * MiB;
constexpr size_t WS_AB = 17 * MiB;
constexpr size_t WS_T = 20 * MiB;
constexpr size_t WS_QKV = 53 * MiB;
constexpr size_t WS_QB = 152 * MiB;
constexpr size_t WS_KB = 184 * MiB;
constexpr size_t WS_VB = 217 * MiB;
constexpr size_t WS_END = 250 * MiB;
constexpr size_t WS_MERGED = 20 * MiB;
constexpr size_t WS_H2 = 53 * MiB;
constexpr size_t WS_NA = 85 * MiB;
constexpr size_t WS_T1 = 117 * MiB;
constexpr size_t WS_GATES = 184 * MiB;
constexpr size_t DO_H = 0;
constexpr size_t DO_W1T = 33 * MiB;

constexpr int LDS_BYTES = 147456;
constexpr int MISC_OFF = 131072 + 320;

__device__ __forceinline__ unsigned f2bf(float f) { unsigned u = __builtin_bit_cast(unsigned, f); return (u + 0x7fffu + ((u >> 16) & 1u)) >> 16; }
__device__ __forceinline__ unsigned pk2(float lo, float hi) { return f2bf(lo) | (f2bf(hi) << 16); }
__device__ __forceinline__ float bf2f(unsigned short h) { return __builtin_bit_cast(float, (unsigned)h << 16); }
__device__ __forceinline__ float bflo(unsigned w) { return __builtin_bit_cast(float, w << 16); }
__device__ __forceinline__ float bfhi(unsigned w) { return __builtin_bit_cast(float, w & 0xffff0000u); }
__device__ __forceinline__ float silu_f(float x) { return x / (1.f + __expf(-x)); }
__device__ __forceinline__ float sigmoid_f(float x) { return 1.f / (1.f + __expf(-x)); }
__device__ __forceinline__ float softplus_f(float x) { return fmaxf(x, 0.f) + log1pf(__expf(-fabsf(x))); }

#define XB_TMO      128
#define XB_XCNT(j)  (256  + 64 * (j))
#define XB_XSUB(j)  (1280 + 64 * (j))
#define XB_XGEN(j)  (2304 + 64 * (j))
#define XB_TOP      3328
#define XB_TOPGEN   3392
#define XCD_BAR_WORDS 3456
#define XB_SPIN_CAP (1u << 22)
__device__ __forceinline__ unsigned xb_ld(unsigned* p)              { return __hip_atomic_load(p, __ATOMIC_RELAXED, __HIP_MEMORY_SCOPE_AGENT); }
__device__ __forceinline__ unsigned xb_add(unsigned* p, unsigned v) { return __hip_atomic_fetch_add(p, v, __ATOMIC_RELAXED, __HIP_MEMORY_SCOPE_AGENT); }
__device__ __forceinline__ unsigned xb_xcc_id() { return (unsigned)__builtin_amdgcn_s_getreg((3 << 11) | 20) & 0xFu; }
#define XB_SPIN(cond, bar) do { unsigned _sp = 0; while (cond) { __builtin_amdgcn_s_sleep(1); \
    if ((++_sp & 255u) == 0u) { if (xb_ld(&(bar)[XB_TMO])) break; if (_sp > XB_SPIN_CAP) { atomicAdd(&(bar)[XB_TMO], 1u); break; } } } } while (0)
struct XcdBarrier { unsigned* bar; unsigned x; volatile LAS unsigned* st; };
__device__ __forceinline__ XcdBarrier xcd_barrier_post(unsigned* bar, volatile LAS unsigned* st) {
    XcdBarrier b; b.bar = bar; b.x = xb_xcc_id(); b.st = st;
    if (threadIdx.x == 0) (void)xb_add(&bar[XB_XCNT(b.x)], 1u);
    return b;
}
__device__ __forceinline__ void xcd_barrier_complete(unsigned* bar, unsigned x, unsigned& nloc, unsigned& nx) {
    const unsigned G = gridDim.x * gridDim.y * gridDim.z;
    unsigned sum, cnt, mine, sp = 0u;
    for (;;) {
        sum = 0u; cnt = 0u; mine = 0u;
#pragma unroll
        for (unsigned j = 0; j < 16; ++j) { const unsigned c = xb_ld(&bar[XB_XCNT(j)]); sum += c; cnt += (c > 0u) ? 1u : 0u; mine = (j == x) ? c : mine; }
        if (sum == G) break;
        __builtin_amdgcn_s_sleep(1);
        if ((++sp & 255u) == 0u) { if (xb_ld(&bar[XB_TMO])) break; if (sp > XB_SPIN_CAP) { atomicAdd(&bar[XB_TMO], 1u); break; } }
    }
    nloc = mine > 0u ? mine : 1u; nx = cnt > 0u ? cnt : 1u;
}
__device__ __forceinline__ void xcd_barrier(const XcdBarrier& b) {
    asm volatile("s_waitcnt vmcnt(0)" ::: "memory");
    __syncthreads();
    if (threadIdx.x == 0) {
        unsigned* bar = b.bar;
        __builtin_amdgcn_s_waitcnt(0);
        unsigned nloc = b.st[0], nx = b.st[1];
        if (nloc == 0u) { xcd_barrier_complete(bar, b.x, nloc, nx); b.st[0] = nloc; b.st[1] = nx; }
        const unsigned old = xb_add(&bar[XB_XSUB(b.x)], 1u);
        const unsigned gen = old / nloc;
        if (old + 1u == (gen + 1u) * nloc) {
            __builtin_amdgcn_fence(__ATOMIC_RELEASE, "agent");
            asm volatile("s_waitcnt vmcnt(0)" ::: "memory");
            const unsigned og = xb_add(&bar[XB_TOP], 1u);
            const unsigned tg = og / nx;
            if (og + 1u == (tg + 1u) * nx) xb_add(&bar[XB_TOPGEN], 1u);
            else XB_SPIN(xb_ld(&bar[XB_TOPGEN]) == tg, bar);
            __builtin_amdgcn_fence(__ATOMIC_ACQUIRE, "agent");
            xb_add(&bar[XB_XGEN(b.x)], 1u);
            asm volatile("s_waitcnt vmcnt(0)" ::: "memory");
        } else {
            XB_SPIN(xb_ld(&bar[XB_XGEN(b.x)]) == gen, bar);
            __builtin_amdgcn_fence(__ATOMIC_ACQUIRE, "agent");
            asm volatile("s_waitcnt vmcnt(0)" ::: "memory");
        }
    }
    __syncthreads();
    __builtin_amdgcn_fence(__ATOMIC_ACQUIRE, "agent");
    asm volatile("s_waitcnt vmcnt(0)" ::: "memory");
}

struct Args {
    const float* x; const float* c; const float* ctx; const float* c_ctx; const float* w_ada; const float* b_ada; const float* w_in; const float* conv_w;
    const float* a_log; const float* dt_bias; const float* gdn_norm_w; const float* q_norm_w; const float* k_norm_w;
    const float* lq1; const float* lk1; const float* lq2; const float* lk2; const float* diff_norm_w; const float* w_oa; const float* w_ob; const float* w_out;
    float* out; unsigned char* ws;
};

__device__ __forceinline__ float wave_sum(float v) {
#pragma unroll
    for (int o = 1; o < 64; o <<= 1) v += __shfl_xor(v, o);
    return v;
}

__device__ __forceinline__ int w1_src(int n) { if (n < 3072) return n; if (n < 4096) return 4128 + (n - 3072); if (n < 5120) return 5152 + (n - 4096); if (n < 6144) return 6176 + (n - 5120);
    if (n < 6176) return 4096 + (n - 6144); return -1; }
__device__ __forceinline__ int w2_src(int n) { if (n < 1024) return 3072 + n; if (n < 2048) return 7200 + (n - 1024); return 8224 + (n - 2048); }
__device__ __forceinline__ void transpose_item(const float* W, int ldw, int c0, bf16* WT, int n0, int k0, LAS float* scr, int lane) {
#pragma unroll 8
    for (int i = 0; i < 32; ++i) { const int kk = 2 * i + (lane >> 5); scr[kk * 33 + (lane & 31)] = (c0 >= 0) ? W[(size_t)(k0 + kk) * ldw + c0 + (lane & 31)] : 0.f; }
    asm volatile("s_waitcnt lgkmcnt(0)" ::: "memory");
    const int c = lane & 7;
#pragma unroll
    for (int j = 0; j < 4; ++j) { const int n = (lane >> 3) + 8 * j; const LAS float* s = scr + (8 * c) * 33 + n;
        v4u o; o.x = pk2(s[0 * 33], s[1 * 33]); o.y = pk2(s[2 * 33], s[3 * 33]); o.z = pk2(s[4 * 33], s[5 * 33]); o.w = pk2(s[6 * 33], s[7 * 33]);
        *(v4u*)(WT + (size_t)(n0 + n) * 1024 + k0 + 8 * c) = o; }
    asm volatile("s_waitcnt lgkmcnt(0)" ::: "memory");
}

template <class Epi>
__device__ __forceinline__ void gemm_naive(unsigned char* ldsg, const bf16* A, const bf16* Bt, int M, int N, int K, const Epi& epi) {
    float* As = (float*)ldsg; float* Bs = As + 32 * 132;
    const int tid = threadIdx.x, ty = tid >> 4, tx = tid & 15;
    const int nM = M / 128, nN = N / 128;
    for (int unit = blockIdx.x; unit < nM * nN; unit += gridDim.x) {
        const int pm = unit / nN, pn = unit % nN;
        float acc[4][8];
#pragma unroll
        for (int i = 0; i < 4; ++i)
#pragma unroll
            for (int j = 0; j < 8; ++j) acc[i][j] = 0.f;
        const int srow = tid >> 2, skc = (tid & 3) * 8;
        for (int k0 = 0; k0 < K; k0 += 32) {
            const v4u av = *(const v4u*)(A + (size_t)(pm * 128 + srow) * K + k0 + skc);
            const v4u bv = *(const v4u*)(Bt + (size_t)(pn * 128 + srow) * K + k0 + skc);
            As[(skc + 0) * 132 + srow] = bflo(av.x); As[(skc + 1) * 132 + srow] = bfhi(av.x); As[(skc + 2) * 132 + srow] = bflo(av.y); As[(skc + 3) * 132 + srow] = bfhi(av.y);
            As[(skc + 4) * 132 + srow] = bflo(av.z); As[(skc + 5) * 132 + srow] = bfhi(av.z); As[(skc + 6) * 132 + srow] = bflo(av.w); As[(skc + 7) * 132 + srow] = bfhi(av.w);
            Bs[(skc + 0) * 132 + srow] = bflo(bv.x); Bs[(skc + 1) * 132 + srow] = bfhi(bv.x); Bs[(skc + 2) * 132 + srow] = bflo(bv.y); Bs[(skc + 3) * 132 + srow] = bfhi(bv.y);
            Bs[(skc + 4) * 132 + srow] = bflo(bv.z); Bs[(skc + 5) * 132 + srow] = bfhi(bv.z); Bs[(skc + 6) * 132 + srow] = bflo(bv.w); Bs[(skc + 7) * 132 + srow] = bfhi(bv.w);
            __syncthreads();
#pragma unroll 8
            for (int kk = 0; kk < 32; ++kk) {
                const f32x4 a = *(const f32x4*)(As + kk * 132 + ty * 4);
                const f32x4 b0 = *(const f32x4*)(Bs + kk * 132 + tx * 8), b1 = *(const f32x4*)(Bs + kk * 132 + tx * 8 + 4);
#pragma unroll
                for (int i = 0; i < 4; ++i) { acc[i][0] += a[i] * b0[0]; acc[i][1] += a[i] * b0[1]; acc[i][2] += a[i] * b0[2]; acc[i][3] += a[i] * b0[3];
                    acc[i][4] += a[i] * b1[0]; acc[i][5] += a[i] * b1[1]; acc[i][6] += a[i] * b1[2]; acc[i][7] += a[i] * b1[3]; }
            }
            __syncthreads();
        }
#pragma unroll
        for (int i = 0; i < 4; ++i)
#pragma unroll
            for (int j = 0; j < 8; ++j) epi(pm * 128 + ty * 4 + i, pn * 128 + tx * 8 + j, acc[i][j]);
    }
}

struct EpiR1 { bf16* QKV; bf16* QB; bf16* KB; bf16* VB; float* AB;
    __device__ __forceinline__ void operator()(int r, int c, float v) const {
        if (c < 3072) QKV[(size_t)r * 3072 + c] = (bf16)f2bf(v);
        else if (c < 4096) { if (r < MLAT) QB[(size_t)r * 1024 + (c - 3072)] = (bf16)f2bf(v); }
        else if (c < 5120) KB[(size_t)r * 1024 + (c - 4096)] = (bf16)f2bf(v);
        else if (c < 6144) VB[(size_t)r * 1024 + (c - 5120)] = (bf16)f2bf(v);
        else if (c < 6176) AB[(size_t)r * 32 + (c - 6144)] = v;
    } };
struct EpiR2 { bf16* NA; bf16* QB; bf16* GATES;
    __device__ __forceinline__ void operator()(int r, int c, float v) const {
        if (c < 1024) { bf16* p = NA + (size_t)r * 1024 + c; *p = (bf16)f2bf(silu_f(v) * bf2f(*p)); }
        else if (c < 2048) { bf16* p = QB + (size_t)r * 1024 + (c - 1024); *p = (bf16)f2bf(0.8f * silu_f(v) * bf2f(*p)); }
        else GATES[(size_t)r * 2048 + (c - 2048)] = (bf16)f2bf(sigmoid_f(v));
    } };
struct EpiR2Chk { bf16* NA; bf16* QB; bf16* GATES; const bf16* YA2; const bf16* YB2; unsigned* cnt;
    __device__ __forceinline__ void operator()(int r, int c, float v) const {
        float ref, got;
        if (c < 1024) { bf16* p = NA + (size_t)r * 1024 + c; ref = silu_f(v) * bf2f(YA2[(size_t)r * 1024 + c]); got = bf2f(*p); *p = (bf16)f2bf(ref); if (fabsf(ref - got) > 0.02f * fabsf(ref) + 0.01f) atomicAdd(cnt + 0, 1u); }
        else if (c < 2048) { bf16* p = QB + (size_t)r * 1024 + (c - 1024); ref = 0.8f * silu_f(v) * bf2f(YB2[(size_t)r * 1024 + (c - 1024)]); got = bf2f(*p); *p = (bf16)f2bf(ref); if (fabsf(ref - got) > 0.02f * fabsf(ref) + 0.01f) atomicAdd(cnt + 1, 1u); }
        else { bf16* p = GATES + (size_t)r * 2048 + (c - 2048); ref = sigmoid_f(v); got = bf2f(*p); *p = (bf16)f2bf(ref); if (fabsf(ref - got) > 0.02f) atomicAdd(cnt + 2, 1u); }
    } };
struct EpiF1 { bf16* T1; const bf16* GATES;
    __device__ __forceinline__ void operator()(int r, int c, float v) const { T1[(size_t)r * 1024 + c] = (bf16)f2bf(v * bf2f(GATES[(size_t)r * 2048 + c])); } };
struct EpiF2 { bf16* MERGED; const bf16* T1; const bf16* GATES;
    __device__ __forceinline__ void operator()(int r, int c, float v) const { MERGED[(size_t)r * 1024 + c] = (bf16)f2bf(bf2f(T1[(size_t)r * 1024 + c]) + v * bf2f(GATES[(size_t)r * 2048 + 1024 + c])); } };
struct EpiG { float* out; const float* x; const float* mod;
    __device__ __forceinline__ void operator()(int r, int c, float v) const { const int b = r / SEQ; out[(size_t)r * 1024 + c] = x[(size_t)r * 1024 + c] + mod[b * 3072 + 2048 + c] * v; } };

namespace pg8 {
#define PG8_LAS __attribute__((address_space(3)))
typedef unsigned short bf16_t;
typedef short bf16x8 __attribute__((ext_vector_type(8)));
typedef float f32x4 __attribute__((ext_vector_type(4)));
typedef unsigned u32x4 __attribute__((ext_vector_type(4)));
constexpr int BM = 256, BK = 64, HALF = 128, HTB = HALF * BK * 2  , STAGE_BYTES = 8 * HTB, NXCD = 8, WGM = 8;

__host__ __device__ __forceinline__ int lds_byte(int r, int c) { const int st = (r >> 4) * 2 + (c >> 5), rr = r & 15, cc = c & 31, ob = rr * 64 + cc * 2; return st * 1024 + (ob ^ (((ob >> 9) & 1) << 5)); }
__host__ __device__ __forceinline__ void stage_rc(int b, int& R, int& C) { const int st = b / 1024, sb = b % 1024, swz = sb ^ (((sb >> 9) & 1) << 5); R = (st >> 1) * 16 + swz / 64; C = (st & 1) * 32 + (swz % 64) / 2; }
__host__ __device__ __forceinline__ int perm32(int rho) { const int n = rho >> 4, i = rho & 15; return 8 * (i >> 2) + 4 * n + (i & 3); }

struct Unit { int pm, pn; };
struct Gemm { const bf16_t* A; const bf16_t* Bt; int M, N, K; };

struct StaticOrder {
    int nM, nN, nwg, G, c;
    __host__ __device__ void init(int M, int N, int G_, int c_) { nM = M / BM; nN = N / BM; nwg = nM * nN; G = G_; c = c_; }
    __host__ __device__ bool next(int i, Unit& u) const {
        const long L = (long)i * G + c; if (L >= nwg) return false;
        int wgid = (int)L; { const int q = nwg / NXCD, r = nwg % NXCD, xcd = wgid % NXCD, off = wgid / NXCD; wgid = (xcd < r ? xcd * (q + 1) : r * (q + 1) + (xcd - r) * q) + off; }
        const int nig = WGM * nN, gid = wgid / nig, fm = gid * WGM, gsz = (nM - fm) < WGM ? (nM - fm) : WGM;
        u.pm = fm + ((wgid % nig) % gsz); u.pn = (wgid % nig) / gsz; return true;
    }
    __device__ __forceinline__ void a_ready(const Unit&) const {}
    __device__ __forceinline__ void done(const Unit&) const {}
};

__device__ __forceinline__ unsigned cvt_pk_bf16(float lo, float hi) { unsigned r; asm volatile("v_cvt_pk_bf16_f32 %0, %1, %2" : "=v"(r) : "v"(lo), "v"(hi)); return r; }
__device__ __forceinline__ float silu_e(float x) { return x * __builtin_amdgcn_rcpf(1.f + __expf(-x)); }
__device__ __forceinline__ float sigm_e(float x) { return __builtin_amdgcn_rcpf(1.f + __expf(-x)); }
__device__ __forceinline__ float blo(unsigned w) { return __builtin_bit_cast(float, w << 16); }
__device__ __forceinline__ float bhi(unsigned w) { return __builtin_bit_cast(float, w & 0xffff0000u); }
__device__ __forceinline__ u32x4 pack8(const f32x4 v0, const f32x4 v1) { u32x4 w; w.x = cvt_pk_bf16(v0[0], v0[1]); w.y = cvt_pk_bf16(v0[2], v0[3]); w.z = cvt_pk_bf16(v1[0], v1[1]); w.w = cvt_pk_bf16(v1[2], v1[3]); return w; }
struct EpiR1 {
    static constexpr bool PERM = true, AFTER_DRAIN = false;
    bf16_t* QKV; bf16_t* QB; bf16_t* KB; bf16_t* VB; float* AB; int mlat_tiles;
    __device__ __forceinline__ void operator()(const f32x4 (&acc)[2][2][4][2], const Unit& u, int wr, int wc, int fr, int fq) const {
        const int row0 = u.pm * BM + wr * 64 + fr, cl = wc * 32 + 8 * fq;
        bf16_t* base; int ldc, colt;
        if (u.pn < 12) { base = QKV; ldc = 3072; colt = u.pn * 256; }
        else if (u.pn < 16) { if (u.pm >= mlat_tiles) return; base = QB; ldc = 1024; colt = (u.pn - 12) * 256; }
        else if (u.pn < 20) { base = KB; ldc = 1024; colt = (u.pn - 16) * 256; }
        else if (u.pn < 24) { base = VB; ldc = 1024; colt = (u.pn - 20) * 256; }
        else {
            if (wc == 0) {
#pragma unroll
                for (int ai = 0; ai < 2; ++ai)
#pragma unroll
                    for (int m = 0; m < 4; ++m) { float* p = AB + (size_t)(row0 + ai * HALF + m * 16) * 32 + 8 * fq; *(f32x4*)p = acc[ai][0][m][0]; *(f32x4*)(p + 4) = acc[ai][0][m][1]; }
            }
            return;
        }
#pragma unroll
        for (int ai = 0; ai < 2; ++ai)
#pragma unroll
            for (int m = 0; m < 4; ++m) { bf16_t* rowp = base + (size_t)(row0 + ai * HALF + m * 16) * ldc + colt + cl;
#pragma unroll
                for (int bj = 0; bj < 2; ++bj) *(u32x4*)(rowp + bj * HALF) = pack8(acc[ai][bj][m][0], acc[ai][bj][m][1]); }
    }
};
struct EpiR2 {
    static constexpr bool PERM = true, AFTER_DRAIN = false;
    bf16_t* NA; bf16_t* QB; bf16_t* GATES; bf16_t* YA2; bf16_t* YB2;
    __device__ __forceinline__ void operator()(const f32x4 (&acc)[2][2][4][2], const Unit& u, int wr, int wc, int fr, int fq) const {
        const int row0 = u.pm * BM + wr * 64 + fr, cl = wc * 32 + 8 * fq;
        if (u.pn >= 8) {
            const int colt = (u.pn - 8) * 256;
#pragma unroll
            for (int ai = 0; ai < 2; ++ai)
#pragma unroll
                for (int m = 0; m < 4; ++m) { bf16_t* rowp = GATES + (size_t)(row0 + ai * HALF + m * 16) * 2048 + colt + cl;
#pragma unroll
                    for (int bj = 0; bj < 2; ++bj) { f32x4 v0 = acc[ai][bj][m][0], v1 = acc[ai][bj][m][1];
#pragma unroll
                        for (int i = 0; i < 4; ++i) { v0[i] = sigm_e(v0[i]); v1[i] = sigm_e(v1[i]); }
                        *(u32x4*)(rowp + bj * HALF) = pack8(v0, v1); } }
            return;
        }
        if (R2_SKIP_Z) return;
        bf16_t* base = (u.pn < 4) ? NA : QB; bf16_t* dst = (u.pn < 4) ? YA2 : YB2; const float sc = (u.pn < 4) ? 1.0f : 0.8f; const int colt = (u.pn & 3) * 256;
#pragma unroll
        for (int ai = 0; ai < 2; ++ai)
#pragma unroll
            for (int m = 0; m < 4; ++m) { bf16_t* rowp = base + (size_t)(row0 + ai * HALF + m * 16) * 1024 + colt + cl; bf16_t* rowd = dst + (size_t)(row0 + ai * HALF + m * 16) * 1024 + colt + cl;
#pragma unroll
                for (int bj = 0; bj < 2; ++bj) { const u32x4 old = *(const u32x4*)(rowp + bj * HALF); f32x4 v0 = acc[ai][bj][m][0], v1 = acc[ai][bj][m][1];
                    v0[0] = silu_e(v0[0]) * sc * blo(old.x); v0[1] = silu_e(v0[1]) * sc * bhi(old.x); v0[2] = silu_e(v0[2]) * sc * blo(old.y); v0[3] = silu_e(v0[3]) * sc * bhi(old.y);
                    v1[0] = silu_e(v1[0]) * sc * blo(old.z); v1[1] = silu_e(v1[1]) * sc * bhi(old.z); v1[2] = silu_e(v1[2]) * sc * blo(old.w); v1[3] = silu_e(v1[3]) * sc * bhi(old.w);
                    *(u32x4*)(rowd + bj * HALF) = pack8(v0, v1); } }
    }
};
struct EpiF {
    static constexpr bool PERM = true, AFTER_DRAIN = false;
    bf16_t* OUT; const bf16_t* T1; const bf16_t* GATES; int mode;
    __device__ __forceinline__ void operator()(const f32x4 (&acc)[2][2][4][2], const Unit& u, int wr, int wc, int fr, int fq) const {
        const int row0 = u.pm * BM + wr * 64 + fr, col0 = u.pn * BM + wc * 32 + 8 * fq;
#pragma unroll
        for (int ai = 0; ai < 2; ++ai)
#pragma unroll
            for (int m = 0; m < 4; ++m) { const size_t r = (size_t)(row0 + ai * HALF + m * 16);
#pragma unroll
                for (int bj = 0; bj < 2; ++bj) { const int c = col0 + bj * HALF;
                    const u32x4 g = *(const u32x4*)(GATES + r * 2048 + mode * 1024 + c); f32x4 v0 = acc[ai][bj][m][0], v1 = acc[ai][bj][m][1];
                    v0[0] *= blo(g.x); v0[1] *= bhi(g.x); v0[2] *= blo(g.y); v0[3] *= bhi(g.y); v1[0] *= blo(g.z); v1[1] *= bhi(g.z); v1[2] *= blo(g.w); v1[3] *= bhi(g.w);
                    if (mode) { const u32x4 t = *(const u32x4*)(T1 + r * 1024 + c);
                        v0[0] += blo(t.x); v0[1] += bhi(t.x); v0[2] += blo(t.y); v0[3] += bhi(t.y); v1[0] += blo(t.z); v1[1] += bhi(t.z); v1[2] += blo(t.w); v1[3] += bhi(t.w); }
                    *(u32x4*)(OUT + r * 1024 + c) = pack8(v0, v1); } }
    }
};
struct EpiG {
    static constexpr bool PERM = true, AFTER_DRAIN = false;
    float* out; const float* x; const float* mod; int tiles_per_batch;
    __device__ __forceinline__ void operator()(const f32x4 (&acc)[2][2][4][2], const Unit& u, int wr, int wc, int fr, int fq) const {
        const int row0 = u.pm * BM + wr * 64 + fr, col0 = u.pn * BM + wc * 32 + 8 * fq; const int b = u.pm / tiles_per_batch;
        f32x4 gv[2][2];
#pragma unroll
        for (int bj = 0; bj < 2; ++bj) { gv[bj][0] = *(const f32x4*)(mod + b * 3072 + 2048 + col0 + bj * HALF); gv[bj][1] = *(const f32x4*)(mod + b * 3072 + 2048 + col0 + bj * HALF + 4); }
#pragma unroll
        for (int ai = 0; ai < 2; ++ai)
#pragma unroll
            for (int m = 0; m < 4; ++m) { const size_t off = (size_t)(row0 + ai * HALF + m * 16) * 1024 + col0;
#pragma unroll
                for (int bj = 0; bj < 2; ++bj) { const f32x4 x0 = *(const f32x4*)(x + off + bj * HALF), x1 = *(const f32x4*)(x + off + bj * HALF + 4);
                    *(f32x4*)(out + off + bj * HALF) = x0 + gv[bj][0] * acc[ai][bj][m][0]; *(f32x4*)(out + off + bj * HALF + 4) = x1 + gv[bj][1] * acc[ai][bj][m][1]; } }
    }
};
template <class Epi, class Sched, bool ALIGN_EPI = false, bool SP2 = false>
__device__ __forceinline__ void gemm_phase(PG8_LAS unsigned char* lds, const Gemm g, const Sched& S, const Epi& E) {
    const int tid = threadIdx.x, wid = __builtin_amdgcn_readfirstlane(tid >> 6), lane = tid & 63, wr = wid >> 2, wc = wid & 3, fr = lane & 15, fq = lane >> 4;
    const int K = g.K, nt = K / BK;
    unsigned voffA[2], voffB[2];
#pragma unroll
    for (int i = 0; i < 2; ++i) { int R, C; stage_rc(tid * 16 + i * 8192, R, C); const int Rb = Epi::PERM ? ((R & ~31) + perm32(R & 31)) : R;
        voffA[i] = (unsigned)(R * K + C) * 2u; voffB[i] = (unsigned)(Rb * K + C) * 2u; }
    const size_t kstep = (size_t)(BK * 2);
    const size_t hstep = (size_t)HALF * K * 2;
    const size_t tstep = 2 * hstep;
    const unsigned ldsw = (unsigned)wid * 1024u;
    const int aoff = lds_byte(wr * 64 + fr, fq * 8), boff = lds_byte(wc * 32 + fr, fq * 8);
#define PG8_SA(b, h) (((b) * 2 + (h)) * HTB)
#define PG8_SB(b, h) ((4 + (b) * 2 + (h)) * HTB)
#define PG8_STAGE(bufoff, gbase, voff) do { _Pragma("unroll") for (int _i = 0; _i < 2; ++_i) \
        __builtin_amdgcn_global_load_lds((const unsigned*)((const char*)(gbase) + (voff)[_i]), (PG8_LAS unsigned*)(lds + (bufoff) + ldsw + _i * 8192), 16, 0, 0); } while (0)
#define PG8_LDA(dst, b, h) do { _Pragma("unroll") for (int m = 0; m < 4; ++m) _Pragma("unroll") for (int k = 0; k < 2; ++k) dst[m][k] = *(const PG8_LAS bf16x8*)(lds + PG8_SA(b, h) + aoff + m * 2048 + k * 1024); } while (0)
#define PG8_LDB(dst, b, h) do { _Pragma("unroll") for (int n = 0; n < 2; ++n) _Pragma("unroll") for (int k = 0; k < 2; ++k) dst[n][k] = *(const PG8_LAS bf16x8*)(lds + PG8_SB(b, h) + boff + n * 2048 + k * 1024); } while (0)
#define PG8_MMA(ai, bj, At, Bt) do { __builtin_amdgcn_s_setprio(1); _Pragma("unroll") for (int m = 0; m < 4; ++m) _Pragma("unroll") for (int n = 0; n < 2; ++n) _Pragma("unroll") for (int k = 0; k < 2; ++k) \
        acc[ai][bj][m][n] = __builtin_amdgcn_mfma_f32_16x16x32_bf16(Bt[n][k], At[m][k], acc[ai][bj][m][n], 0, 0, 0); __builtin_amdgcn_s_setprio(0); } while (0)
#define PG8_WAIT_V(n) asm volatile("s_waitcnt vmcnt(" #n ")" ::: "memory")
#define PG8_WAIT_L(n) asm volatile("s_waitcnt lgkmcnt(" #n ")" ::: "memory")
#define PG8_BAR __builtin_amdgcn_s_barrier()
#define PG8_SCHED __builtin_amdgcn_sched_barrier(0)
    Unit cur, nxt; int ui = 0;
    if (!S.next(0, cur)) return;
    f32x4 acc[2][2][4][2];
#pragma unroll
    for (int a = 0; a < 2; ++a)
#pragma unroll
        for (int b = 0; b < 2; ++b)
#pragma unroll
            for (int m = 0; m < 4; ++m)
#pragma unroll
                for (int n = 0; n < 2; ++n) acc[a][b][m][n] = (f32x4){0.f, 0.f, 0.f, 0.f};
    bf16x8 At[4][2], B0[2][2], B1[2][2];
    const char* cA = (const char*)g.A + (size_t)cur.pm * tstep; const char* cB = (const char*)g.Bt + (size_t)cur.pn * tstep;
    S.a_ready(cur);
    if constexpr (SP2) {
        PG8_STAGE(PG8_SB(0, 0), cB, voffB); PG8_STAGE(PG8_SB(0, 1), cB + hstep, voffB); PG8_STAGE(PG8_SA(0, 0), cA, voffA); PG8_STAGE(PG8_SA(0, 1), cA + hstep, voffA);
        if (wr == 1) PG8_BAR;
        PG8_WAIT_V(2); PG8_BAR;
        PG8_STAGE(PG8_SB(1, 0), cB + kstep, voffB); PG8_STAGE(PG8_SA(1, 0), cA + kstep, voffA); PG8_STAGE(PG8_SB(1, 1), cB + hstep + kstep, voffB);
        PG8_WAIT_V(6); PG8_BAR;
    } else {
        PG8_STAGE(PG8_SB(0, 0), cB, voffB); PG8_STAGE(PG8_SA(0, 0), cA, voffA); PG8_STAGE(PG8_SB(0, 1), cB + hstep, voffB); PG8_STAGE(PG8_SA(0, 1), cA + hstep, voffA);
        if (wr == 1) PG8_BAR;
        PG8_WAIT_V(4); PG8_BAR;
        PG8_STAGE(PG8_SB(1, 0), cB + kstep, voffB); PG8_STAGE(PG8_SA(1, 0), cA + kstep, voffA); PG8_STAGE(PG8_SB(1, 1), cB + hstep + kstep, voffB);
        PG8_WAIT_V(6); PG8_BAR;
    }
    for (;;) {
        const bool has_next = S.next(ui + 1, nxt);
        const char* nA = has_next ? (const char*)g.A + (size_t)nxt.pm * tstep : cA; const char* nB = has_next ? (const char*)g.Bt + (size_t)nxt.pn * tstep : cB;
        for (int t = 0; t < nt; t += 2) {
            const bool last = (t == nt - 2);
            const char* a1 = cA + (size_t)(t + 1) * kstep;
            const char* a2 = last ? nA : cA + (size_t)(t + 2) * kstep; const char* b2 = last ? nB : cB + (size_t)(t + 2) * kstep;
            const char* a3 = a2 + kstep; const char* b3 = b2 + kstep;
            if (last && has_next) S.a_ready(nxt);
            if constexpr (SP2) {
            PG8_LDB(B0, 0, 0); PG8_LDB(B1, 0, 1); PG8_SCHED; PG8_LDA(At, 0, 0); PG8_STAGE(PG8_SA(1, 1), a1 + hstep, voffA);
            PG8_WAIT_V(8); PG8_WAIT_L(0); PG8_BAR; PG8_MMA(0, 0, At, B0); PG8_MMA(0, 1, At, B1); PG8_BAR; PG8_SCHED;
            PG8_LDA(At, 0, 1); PG8_STAGE(PG8_SB(0, 0), b2, voffB); PG8_STAGE(PG8_SB(0, 1), b2 + hstep, voffB); PG8_STAGE(PG8_SA(0, 0), a2, voffA);
            PG8_WAIT_V(8); PG8_WAIT_L(0); PG8_BAR; PG8_MMA(1, 0, At, B0); PG8_MMA(1, 1, At, B1); PG8_BAR; PG8_SCHED;
            PG8_LDB(B0, 1, 0); PG8_LDB(B1, 1, 1); PG8_SCHED; PG8_LDA(At, 1, 0); PG8_STAGE(PG8_SA(0, 1), a2 + hstep, voffA);
            PG8_WAIT_V(8); PG8_WAIT_L(0); PG8_BAR; PG8_MMA(0, 0, At, B0); PG8_MMA(0, 1, At, B1); PG8_BAR; PG8_SCHED;
            PG8_LDA(At, 1, 1); PG8_STAGE(PG8_SB(1, 0), b3, voffB); PG8_STAGE(PG8_SB(1, 1), b3 + hstep, voffB); PG8_STAGE(PG8_SA(1, 0), a3, voffA);
            PG8_WAIT_V(8); PG8_WAIT_L(0); PG8_BAR; PG8_MMA(1, 0, At, B0); PG8_MMA(1, 1, At, B1); PG8_BAR; PG8_SCHED;
            } else {
            PG8_LDB(B0, 0, 0); PG8_SCHED; PG8_LDA(At, 0, 0); PG8_STAGE(PG8_SA(1, 1), a1 + hstep, voffA);
            PG8_WAIT_L(8); PG8_BAR; PG8_WAIT_L(0); PG8_MMA(0, 0, At, B0); PG8_BAR; PG8_SCHED;
            PG8_LDB(B1, 0, 1); PG8_STAGE(PG8_SB(0, 0), b2, voffB);
            PG8_BAR; PG8_WAIT_L(0); PG8_MMA(0, 1, At, B1); PG8_BAR;
            PG8_LDA(At, 0, 1); PG8_STAGE(PG8_SA(0, 0), a2, voffA);
            PG8_BAR; PG8_WAIT_L(0); PG8_MMA(1, 0, At, B0); PG8_BAR; PG8_SCHED;
            PG8_STAGE(PG8_SB(0, 1), b2 + hstep, voffB);
            PG8_WAIT_V(6); PG8_BAR; PG8_MMA(1, 1, At, B1); PG8_BAR;
            PG8_LDB(B0, 1, 0); PG8_SCHED; PG8_LDA(At, 1, 0); PG8_STAGE(PG8_SA(0, 1), a2 + hstep, voffA);
            PG8_WAIT_L(8); PG8_BAR; PG8_WAIT_L(0); PG8_MMA(0, 0, At, B0); PG8_BAR; PG8_SCHED;
            PG8_LDB(B1, 1, 1); PG8_STAGE(PG8_SB(1, 0), b3, voffB);
            PG8_BAR; PG8_WAIT_L(0); PG8_MMA(0, 1, At, B1); PG8_BAR;
            PG8_LDA(At, 1, 1); PG8_STAGE(PG8_SA(1, 0), a3, voffA);
            PG8_BAR; PG8_WAIT_L(0); PG8_MMA(1, 0, At, B0); PG8_BAR; PG8_SCHED;
            PG8_STAGE(PG8_SB(1, 1), b3 + hstep, voffB);
            PG8_WAIT_V(6); PG8_BAR; PG8_MMA(1, 1, At, B1); PG8_BAR;
            }
        }
        if constexpr (ALIGN_EPI) { if (wr == 0) PG8_BAR; }
        if constexpr (!Epi::AFTER_DRAIN) { E(acc, cur, wr, wc, fr, fq); S.done(cur); }
        if (!has_next) break;
#pragma unroll
        for (int a = 0; a < 2; ++a)
#pragma unroll
            for (int b = 0; b < 2; ++b)
#pragma unroll
                for (int m = 0; m < 4; ++m)
#pragma unroll
                    for (int n = 0; n < 2; ++n) acc[a][b][m][n] = (f32x4){0.f, 0.f, 0.f, 0.f};
        cur = nxt; cA = nA; cB = nB; ++ui;
        if constexpr (ALIGN_EPI) { if (wr == 1) PG8_BAR; }
    }
    PG8_WAIT_V(0);
    if constexpr (!ALIGN_EPI) { if (wr == 0) PG8_BAR; }
    PG8_BAR;
    if constexpr (Epi::AFTER_DRAIN) { E.fused(acc, cur, wr, wc, fr, fq, lds, wid, lane); S.done(cur); }
#undef PG8_SA
#undef PG8_SB
#undef PG8_STAGE
#undef PG8_LDA
#undef PG8_LDB
#undef PG8_MMA
#undef PG8_WAIT_V
#undef PG8_WAIT_L
#undef PG8_BAR
#undef PG8_SCHED
}
}

__global__ void __launch_bounds__(512, 2) hybrid_fwd(Args a) {
    extern __shared__ __attribute__((aligned(16))) unsigned char lds[];
    const int tid = threadIdx.x, lane = tid & 63, wave = __builtin_amdgcn_readfirstlane(tid >> 6);
    const int G = gridDim.x, bid = blockIdx.x;
    const int gw = bid * 8 + wave, NGW = G * 8;
    unsigned char* ws = a.ws;
    unsigned* ctl = (unsigned*)(ws + WS_CTL);
    volatile LAS unsigned* MISC = (volatile LAS unsigned*)((LAS unsigned char*)lds + MISC_OFF);
    for (int u = tid; u < (LDS_BYTES - 131072) / 4; u += 512) ((LAS unsigned*)((LAS unsigned char*)lds + 131072))[u] = 0u;
    __syncthreads();
    XcdBarrier bar = xcd_barrier_post(ctl + 4096, MISC + 8);

    float* MODP = (float*)(ws + WS_MODP); float* MOD = (float*)(ws + WS_MOD);
    bf16* W2T = (bf16*)(ws + WS_W2T); float* AB = (float*)(ws + WS_AB);
    bf16* QKV = (bf16*)(ws + WS_QKV); bf16* QB = (bf16*)(ws + WS_QB); bf16* KB = (bf16*)(ws + WS_KB); bf16* VB = (bf16*)(ws + WS_VB);
    bf16* MERGED = (bf16*)(ws + WS_MERGED); bf16* H2 = (bf16*)(ws + WS_H2); bf16* NA = (bf16*)(ws + WS_NA); bf16* T1 = (bf16*)(ws + WS_T1); bf16* GATES = (bf16*)(ws + WS_GATES);
    bf16* H = (bf16*)((unsigned char*)a.out + DO_H); bf16* W1T = (bf16*)((unsigned char*)a.out + DO_W1T);


#define THRASH() do { f32x4 _s = {0.f,0.f,0.f,0.f}; for (size_t _i = (size_t)bid * 512 + tid; _i < (size_t)MLAT * 1024 / 4; _i += (size_t)G * 512) { const f32x4 _v = ((const f32x4*)a.x)[_i]; _s += _v; } \
    ((f32x4*)(ws + WS_END))[(size_t)bid * 512 + tid] = _s; } while (0)
    {
        for (int u = bid; u < 48; u += G) {
            const int ks = u / 6, nb = u % 6, n = nb * 512 + tid;
            float s0 = 0.f, s1 = 0.f, s2 = 0.f;
            for (int k = ks * 128; k < ks * 128 + 128; ++k) {
                const float w = a.w_ada[(size_t)k * 3072 + n];
                s0 += silu_f(a.c[k]) * w; s1 += silu_f(a.c[1024 + k]) * w; s2 += silu_f(a.c_ctx[k]) * w;
            }
            MODP[(ks * 3 + 0) * 3072 + n] = s0; MODP[(ks * 3 + 1) * 3072 + n] = s1; MODP[(ks * 3 + 2) * 3072 + n] = s2;
        }
        LAS float* scr = (LAS float*)((LAS unsigned char*)lds + wave * 16384);
        constexpr int NB1 = N1 / 32, NB2 = N2ALL / 32, NIT = 16 * (NB1 + NB2);
        for (int it = gw; it < NIT; it += NGW) {
            const int kb = it & 15, nbi = it >> 4;
            if (nbi < NB1) { const int n0 = nbi * 32; transpose_item(a.w_in, IN_COLS, w1_src(n0), W1T, n0, kb * 64, scr, lane); }
            else { const int n0 = (nbi - NB1) * 32;
                if (n0 < 4096) transpose_item(a.w_in, IN_COLS, w2_src(n0), W2T, n0, kb * 64, scr, lane);
                else if (n0 < 5120) transpose_item(a.w_oa, 1024, n0 - 4096, W2T, n0, kb * 64, scr, lane);
                else if (n0 < 6144) transpose_item(a.w_ob, 1024, n0 - 5120, W2T, n0, kb * 64, scr, lane);
                else transpose_item(a.w_out, 1024, n0 - 6144, W2T, n0, kb * 64, scr, lane); }
        }
    }
    xcd_barrier(bar);

    {
        float* modl = (float*)lds;
        for (int i = tid; i < 9216; i += 512) { const int n = i % 3072; float s = a.b_ada[n];
#pragma unroll
            for (int ks = 0; ks < 8; ++ks) s += MODP[ks * 9216 + i];
            modl[i] = s; if (bid == 0) MOD[i] = s; }
        __syncthreads();
        for (int r = gw; r < MTOT; r += NGW) {
            const float* xr; int v;
            if (r < MLAT) { xr = a.x + (size_t)r * 1024; v = r / SEQ; } else { xr = a.ctx + (size_t)(r - MLAT) * 1024; v = 2; }
            f32x4 xv[4]; float ss = 0.f;
#pragma unroll
            for (int j = 0; j < 4; ++j) { xv[j] = ((const f32x4*)xr)[64 * j + lane]; ss += (xv[j].x * xv[j].x + xv[j].y * xv[j].y) + (xv[j].z * xv[j].z + xv[j].w * xv[j].w); }
            const float rstd = 1.f / sqrtf(wave_sum(ss) * (1.f / 1024.f) + EPS);
            const float* sh = modl + v * 3072; const float* sc = sh + 1024;
#pragma unroll
            for (int j = 0; j < 4; ++j) { const int c0 = (64 * j + lane) * 4;
                const float h0 = xv[j].x * rstd * (1.f + sc[c0]) + sh[c0], h1 = xv[j].y * rstd * (1.f + sc[c0 + 1]) + sh[c0 + 1];
                const float h2 = xv[j].z * rstd * (1.f + sc[c0 + 2]) + sh[c0 + 2], h3 = xv[j].w * rstd * (1.f + sc[c0 + 3]) + sh[c0 + 3];
                v2u o; o.x = pk2(h0, h1); o.y = pk2(h2, h3); *(v2u*)(H + (size_t)r * 1024 + c0) = o; }
        }
    }
    xcd_barrier(bar);


#if PG8_R1
    { pg8::Gemm g{H, W1T, MTOT, N1, 1024}; pg8::StaticOrder S; S.init(MTOT, N1, G, bid); pg8::EpiR1 e{QKV, QB, KB, VB, AB, MLAT / 256};
      pg8::gemm_phase<pg8::EpiR1, pg8::StaticOrder, true, true>((LAS unsigned char*)lds, g, S, e); }
#else
    { EpiR1 e{QKV, QB, KB, VB, AB}; gemm_naive(lds, H, W1T, MTOT, N1, 1024, e); }
#endif

    xcd_barrier(bar);

    {
        for (size_t i = (size_t)bid * 512 + tid; i < (size_t)MLAT * 1024 / 4; i += (size_t)G * 512) ((f32x4*)a.out)[i] = (f32x4){0.f, 0.f, 0.f, 0.f};
        for (int it = gw; it < MLAT + MTOT; it += NGW) {
            const bool isq = it < MLAT; const int r = isq ? it : it - MLAT;
            bf16* p = (isq ? QB : KB) + (size_t)r * 1024 + lane * 16;
            const float* gw_ = isq ? a.q_norm_w : a.k_norm_w;
            const v4u w0 = *(const v4u*)p, w1 = *(const v4u*)(p + 8);
            float v[16] = {bflo(w0.x), bfhi(w0.x), bflo(w0.y), bfhi(w0.y), bflo(w0.z), bfhi(w0.z), bflo(w0.w), bfhi(w0.w),
                           bflo(w1.x), bfhi(w1.x), bflo(w1.y), bfhi(w1.y), bflo(w1.z), bfhi(w1.z), bflo(w1.w), bfhi(w1.w)};
            float ss = 0.f;
#pragma unroll
            for (int i = 0; i < 16; ++i) ss += v[i] * v[i];
            ss += __shfl_xor(ss, 1); ss += __shfl_xor(ss, 2);
            const float rstd = 1.f / sqrtf(ss * (1.f / 64.f) + EPS);
            const int sub = lane & 3;
#pragma unroll
            for (int i = 0; i < 16; ++i) v[i] = v[i] * rstd * gw_[sub * 16 + i];
            if (r < MLAT) {
                const int t = r % SEQ; const float pos = (float)((sub < 2) ? (t >> 6) : (t & 63));
#pragma unroll
                for (int i = 0; i < 16; ++i) {
                    const float other = __shfl_xor(v[i], 1);
                    const float invf = exp2f(-(float)i * (13.287712379549449f / 16.f));
                    const float ang = pos * invf; const float cs = cosf(ang), sn = sinf(ang);
                    v[i] = (sub & 1) ? (v[i] * cs + other * sn) : (v[i] * cs - other * sn);
                }
            }
            const float sc = isq ? QSCALE : 1.f;
            v4u o0, o1; o0.x = pk2(v[0] * sc, v[1] * sc); o0.y = pk2(v[2] * sc, v[3] * sc); o0.z = pk2(v[4] * sc, v[5] * sc); o0.w = pk2(v[6] * sc, v[7] * sc);
            o1.x = pk2(v[8] * sc, v[9] * sc); o1.y = pk2(v[10] * sc, v[11] * sc); o1.z = pk2(v[12] * sc, v[13] * sc); o1.w = pk2(v[14] * sc, v[15] * sc);
            *(v4u*)p = o0; *(v4u*)(p + 8) = o1;
        }
    }
    xcd_barrier(bar);

    {
        for (int wu = gw; wu < 1024; wu += NGW) {
            const int chain = wu >> 5, sl = wu & 31; const int b = chain >> 4, h = (chain >> 1) & 7, d = chain & 1;
            const int g = lane >> 2, dv = sl * 4 + (lane & 3);
            const float Aexp = __expf(a.a_log[d * 8 + h]), dtb = a.dt_bias[d * 8 + h];
            float wq[5][8], wk[5][8], wv[5];
#pragma unroll
            for (int j = 0; j < 5; ++j) { wv[j] = a.conv_w[j * 3072 + 2048 + h * 128 + dv];
#pragma unroll
                for (int i = 0; i < 8; ++i) { wq[j][i] = a.conv_w[j * 3072 + h * 128 + g * 8 + i]; wk[j][i] = a.conv_w[j * 3072 + 1024 + h * 128 + g * 8 + i]; } }
            float S[8];
#pragma unroll
            for (int i = 0; i < 8; ++i) S[i] = 0.f;
            for (int seg = 0; seg < 2; ++seg) {
                const int Ls = seg == 0 ? LCTX : SEQ; const int r0 = seg == 0 ? MLAT + b * LCTX : b * SEQ;
                for (int step = 0; step < Ls; ++step) {
                    const int t = d ? (Ls - 1 - step) : step;
                    float q[8], k[8], v = 0.f;
#pragma unroll
                    for (int i = 0; i < 8; ++i) { q[i] = 0.f; k[i] = 0.f; }
#pragma unroll
                    for (int j = 0; j < 5; ++j) { const int tt = t + j - 2;
                        if (tt >= 0 && tt < Ls) { const bf16* rp = QKV + (size_t)(r0 + tt) * 3072 + h * 128;
                            const v4u qv = *(const v4u*)(rp + g * 8), kv = *(const v4u*)(rp + 1024 + g * 8);
                            v += bf2f(rp[2048 + dv]) * wv[j];
                            q[0] += bflo(qv.x) * wq[j][0]; q[1] += bfhi(qv.x) * wq[j][1]; q[2] += bflo(qv.y) * wq[j][2]; q[3] += bfhi(qv.y) * wq[j][3];
                            q[4] += bflo(qv.z) * wq[j][4]; q[5] += bfhi(qv.z) * wq[j][5]; q[6] += bflo(qv.w) * wq[j][6]; q[7] += bfhi(qv.w) * wq[j][7];
                            k[0] += bflo(kv.x) * wk[j][0]; k[1] += bfhi(kv.x) * wk[j][1]; k[2] += bflo(kv.y) * wk[j][2]; k[3] += bfhi(kv.y) * wk[j][3];
                            k[4] += bflo(kv.z) * wk[j][4]; k[5] += bfhi(kv.z) * wk[j][5]; k[6] += bflo(kv.w) * wk[j][6]; k[7] += bfhi(kv.w) * wk[j][7]; } }
                    v = silu_f(v); float sq = 0.f, sk = 0.f;
#pragma unroll
                    for (int i = 0; i < 8; ++i) { q[i] = silu_f(q[i]); k[i] = silu_f(k[i]); sq += q[i] * q[i]; sk += k[i] * k[i]; }
#pragma unroll
                    for (int o = 4; o < 64; o <<= 1) { sq += __shfl_xor(sq, o); sk += __shfl_xor(sk, o); }
                    const float rq = (1.f / sqrtf(sq + EPS)) * 0.08838834764831845f, rk = 1.f / sqrtf(sk + EPS);
                    const float araw = AB[(size_t)(r0 + t) * 32 + d * 8 + h], braw = AB[(size_t)(r0 + t) * 32 + 16 + d * 8 + h];
                    const float dec = __expf(-Aexp * softplus_f(araw + dtb)), beta = sigmoid_f(braw);
                    float kS = 0.f;
#pragma unroll
                    for (int i = 0; i < 8; ++i) { k[i] *= rk; S[i] *= dec; kS += k[i] * S[i]; }
#pragma unroll
                    for (int o = 4; o < 64; o <<= 1) kS += __shfl_xor(kS, o);
                    const float vn = beta * (v - kS); float oo = 0.f;
#pragma unroll
                    for (int i = 0; i < 8; ++i) { S[i] += k[i] * vn; oo += q[i] * rq * S[i]; }
#pragma unroll
                    for (int o = 4; o < 64; o <<= 1) oo += __shfl_xor(oo, o);
                    if (seg == 1 && lane < 4) atomicAdd(a.out + (size_t)(r0 + t) * 1024 + h * 128 + dv, oo);
                }
            }
        }
        __syncthreads();
        float lam;
        { float s1 = 0.f, s2 = 0.f; for (int i = 0; i < 64; ++i) { s1 += a.lq1[i] * a.lk1[i]; s2 += a.lq2[i] * a.lk2[i]; } lam = __expf(s1) - __expf(s2) + 0.2f; }
        float* Ks = (float*)lds; float* Vs = Ks + 64 * 128;
        const int qi = (tid >> 2) & 63, comp = tid >> 8, quarter = tid & 3;
        for (int unit = bid; unit < 2048; unit += G) {
            const int b = unit >> 10, h = (unit >> 7) & 7, qb = unit & 127;
            const int qrow = b * SEQ + qb * 64 + qi;
            float q[16], o[32], l = 0.f;
            { const bf16* qp = QB + (size_t)qrow * 1024 + h * 128 + comp * 64 + quarter * 16;
              const v4u w0 = *(const v4u*)qp, w1 = *(const v4u*)(qp + 8);
              q[0] = bflo(w0.x); q[1] = bfhi(w0.x); q[2] = bflo(w0.y); q[3] = bfhi(w0.y); q[4] = bflo(w0.z); q[5] = bfhi(w0.z); q[6] = bflo(w0.w); q[7] = bfhi(w0.w);
              q[8] = bflo(w1.x); q[9] = bfhi(w1.x); q[10] = bflo(w1.y); q[11] = bfhi(w1.y); q[12] = bflo(w1.z); q[13] = bfhi(w1.z); q[14] = bflo(w1.w); q[15] = bfhi(w1.w); }
#pragma unroll
            for (int i = 0; i < 32; ++i) o[i] = 0.f;
            for (int kt = 0; kt < (LCTX + SEQ) / 64; ++kt) {
                __syncthreads();
                { const int key = tid >> 3, c8 = (tid & 7) * 16; const int j = kt * 64 + key;
                  const size_t row = (j < LCTX) ? (size_t)(MLAT + b * LCTX + j) : (size_t)(b * SEQ + j - LCTX);
                  const bf16* kp = KB + row * 1024 + h * 128 + c8; const bf16* vp = VB + row * 1024 + h * 128 + c8;
                  const v4u k0 = *(const v4u*)kp, k1 = *(const v4u*)(kp + 8), v0 = *(const v4u*)vp, v1 = *(const v4u*)(vp + 8);
                  float* kd = Ks + key * 128 + c8; float* vd = Vs + key * 128 + c8;
                  kd[0] = bflo(k0.x); kd[1] = bfhi(k0.x); kd[2] = bflo(k0.y); kd[3] = bfhi(k0.y); kd[4] = bflo(k0.z); kd[5] = bfhi(k0.z); kd[6] = bflo(k0.w); kd[7] = bfhi(k0.w);
                  kd[8] = bflo(k1.x); kd[9] = bfhi(k1.x); kd[10] = bflo(k1.y); kd[11] = bfhi(k1.y); kd[12] = bflo(k1.z); kd[13] = bfhi(k1.z); kd[14] = bflo(k1.w); kd[15] = bfhi(k1.w);
                  vd[0] = bflo(v0.x); vd[1] = bfhi(v0.x); vd[2] = bflo(v0.y); vd[3] = bfhi(v0.y); vd[4] = bflo(v0.z); vd[5] = bfhi(v0.z); vd[6] = bflo(v0.w); vd[7] = bfhi(v0.w);
                  vd[8] = bflo(v1.x); vd[9] = bfhi(v1.x); vd[10] = bflo(v1.y); vd[11] = bfhi(v1.y); vd[12] = bflo(v1.z); vd[13] = bfhi(v1.z); vd[14] = bflo(v1.w); vd[15] = bfhi(v1.w); }
                __syncthreads();
                for (int key = 0; key < 64; ++key) {
                    const float* kr = Ks + key * 128 + comp * 64 + quarter * 16; float s = 0.f;
#pragma unroll
                    for (int i = 0; i < 16; ++i) s += q[i] * kr[i];
                    s += __shfl_xor(s, 1); s += __shfl_xor(s, 2);
                    const float p = exp2f(s); l += p;
                    const float* vr = Vs + key * 128 + quarter * 32;
#pragma unroll
                    for (int i = 0; i < 32; ++i) o[i] += p * vr[i];
                }
            }
            __syncthreads();
            const float il = 1.f / l;
            float* X = Ks;
            if (comp == 1) {
#pragma unroll
                for (int i = 0; i < 32; ++i) X[qi * 128 + quarter * 32 + i] = lam * o[i] * il;
            }
            __syncthreads();
            if (comp == 0) {
                float ss = 0.f;
#pragma unroll
                for (int i = 0; i < 32; ++i) { o[i] = o[i] * il - X[qi * 128 + quarter * 32 + i]; ss += o[i] * o[i]; }
                ss += __shfl_xor(ss, 1); ss += __shfl_xor(ss, 2);
                const float rstd = 1.f / sqrtf(ss * (1.f / 128.f) + EPS);
                bf16* op = QB + (size_t)qrow * 1024 + h * 128 + quarter * 32;
#pragma unroll
                for (int i = 0; i < 32; i += 2) *(unsigned*)(op + i) = pk2(o[i] * rstd * a.diff_norm_w[quarter * 32 + i], o[i + 1] * rstd * a.diff_norm_w[quarter * 32 + i + 1]);
            }
            __syncthreads();
        }
    }
    xcd_barrier(bar);

    {
        for (int r = gw; r < MLAT; r += NGW) {
            const float* xr = a.x + (size_t)r * 1024; const int v = r / SEQ;
            f32x4 xv[4]; float ss = 0.f;
#pragma unroll
            for (int j = 0; j < 4; ++j) { xv[j] = ((const f32x4*)xr)[64 * j + lane]; ss += (xv[j].x * xv[j].x + xv[j].y * xv[j].y) + (xv[j].z * xv[j].z + xv[j].w * xv[j].w); }
            const float rstd = 1.f / sqrtf(wave_sum(ss) * (1.f / 1024.f) + EPS);
            const float* sh = MOD + v * 3072; const float* sc = sh + 1024;
#pragma unroll
            for (int j = 0; j < 4; ++j) { const int c0 = (64 * j + lane) * 4;
                const float h0 = xv[j].x * rstd * (1.f + sc[c0]) + sh[c0], h1 = xv[j].y * rstd * (1.f + sc[c0 + 1]) + sh[c0 + 1];
                const float h2 = xv[j].z * rstd * (1.f + sc[c0 + 2]) + sh[c0 + 2], h3 = xv[j].w * rstd * (1.f + sc[c0 + 3]) + sh[c0 + 3];
                v2u o; o.x = pk2(h0, h1); o.y = pk2(h2, h3); *(v2u*)(H2 + (size_t)r * 1024 + c0) = o; }
            const float* orow = a.out + (size_t)r * 1024 + lane * 16;
            f32x4 ov[4]; float s2 = 0.f;
#pragma unroll
            for (int j = 0; j < 4; ++j) { ov[j] = ((const f32x4*)orow)[j]; s2 += (ov[j].x * ov[j].x + ov[j].y * ov[j].y) + (ov[j].z * ov[j].z + ov[j].w * ov[j].w); }
            s2 += __shfl_xor(s2, 1); s2 += __shfl_xor(s2, 2); s2 += __shfl_xor(s2, 4);
            const float r2 = 1.f / sqrtf(s2 * (1.f / 128.f) + EPS);
            const float* gwp = a.gdn_norm_w + (lane & 7) * 16;
            v4u o0, o1;
            o0.x = pk2(ov[0].x * r2 * gwp[0], ov[0].y * r2 * gwp[1]); o0.y = pk2(ov[0].z * r2 * gwp[2], ov[0].w * r2 * gwp[3]);
            o0.z = pk2(ov[1].x * r2 * gwp[4], ov[1].y * r2 * gwp[5]); o0.w = pk2(ov[1].z * r2 * gwp[6], ov[1].w * r2 * gwp[7]);
            o1.x = pk2(ov[2].x * r2 * gwp[8], ov[2].y * r2 * gwp[9]); o1.y = pk2(ov[2].z * r2 * gwp[10], ov[2].w * r2 * gwp[11]);
            o1.z = pk2(ov[3].x * r2 * gwp[12], ov[3].y * r2 * gwp[13]); o1.w = pk2(ov[3].z * r2 * gwp[14], ov[3].w * r2 * gwp[15]);
            *(v4u*)(NA + (size_t)r * 1024 + lane * 16) = o0; *(v4u*)(NA + (size_t)r * 1024 + lane * 16 + 8) = o1;
        }
    }
    xcd_barrier(bar);


#if PG8_R2
    { pg8::Gemm g{H2, W2T, MLAT, 4096, 1024}; pg8::StaticOrder S; S.init(MLAT, 4096, G, bid); pg8::EpiR2 e{NA, QB, GATES, NA, QB};
      pg8::gemm_phase<pg8::EpiR2, pg8::StaticOrder, true, true>((LAS unsigned char*)lds, g, S, e); }
#else
    { EpiR2 e{NA, QB, GATES}; gemm_naive(lds, H2, W2T, MLAT, 4096, 1024, e); }
#endif
    xcd_barrier(bar);


#if PG8_F1
    { pg8::Gemm g{NA, W2T + (size_t)4096 * 1024, MLAT, 1024, 1024}; pg8::StaticOrder S; S.init(MLAT, 1024, G, bid); pg8::EpiF e{T1, T1, GATES, 0};
      pg8::gemm_phase<pg8::EpiF, pg8::StaticOrder, true, true>((LAS unsigned char*)lds, g, S, e); }
#else
    { EpiF1 e{T1, GATES}; gemm_naive(lds, NA, W2T + (size_t)4096 * 1024, MLAT, 1024, 1024, e); }
#endif


#if PG8_F2
    { pg8::Gemm g{QB, W2T + (size_t)5120 * 1024, MLAT, 1024, 1024}; pg8::StaticOrder S; S.init(MLAT, 1024, G, bid); pg8::EpiF e{MERGED, T1, GATES, 1};
      pg8::gemm_phase<pg8::EpiF, pg8::StaticOrder, true, true>((LAS unsigned char*)lds, g, S, e); }
#else
    { EpiF2 e{MERGED, T1, GATES}; gemm_naive(lds, QB, W2T + (size_t)5120 * 1024, MLAT, 1024, 1024, e); }
#endif

    xcd_barrier(bar);


#if PG8_G
    { pg8::Gemm g{MERGED, W2T + (size_t)6144 * 1024, MLAT, 1024, 1024}; pg8::StaticOrder S; S.init(MLAT, 1024, G, bid); pg8::EpiG e{a.out, a.x, MOD, SEQ / 256};
      pg8::gemm_phase<pg8::EpiG, pg8::StaticOrder, true, true>((LAS unsigned char*)lds, g, S, e); }
#else
    { EpiG e{a.out, a.x, MOD}; gemm_naive(lds, MERGED, W2T + (size_t)6144 * 1024, MLAT, 1024, 1024, e); }
#endif

}

extern "C" void kernel_launch(void* const* d_in, const int* in_sizes, int n_in, void* d_out, int out_size, void* d_ws, size_t ws_size, hipStream_t stream) {
    static int grid = 0;
    if (grid == 0) {
        if (n_in != 21 || in_sizes[0] != MLAT * DM || out_size != MLAT * DM || ws_size < WS_END) { fprintf(stderr, "kernel_launch: unexpected shapes n_in %d in0 %d out %d ws %zu\n", n_in, n_in > 0 ? in_sizes[0] : -1, out_size, ws_size); grid = -1; return; }
        int dev = 0, cus = 0, per_cu = 0;
        if (hipGetDevice(&dev) != hipSuccess || hipDeviceGetAttribute(&cus, hipDeviceAttributeMultiprocessorCount, dev) != hipSuccess) { grid = -1; return; }
        if (hipFuncSetAttribute((const void*)hybrid_fwd, hipFuncAttributeMaxDynamicSharedMemorySize, LDS_BYTES) != hipSuccess) { fprintf(stderr, "kernel_launch: hipFuncSetAttribute failed\n"); grid = -1; return; }
        if (hipOccupancyMaxActiveBlocksPerMultiprocessor(&per_cu, (const void*)hybrid_fwd, 512, LDS_BYTES) != hipSuccess || per_cu < 1) { fprintf(stderr, "kernel_launch: occupancy query says %d\n", per_cu); per_cu = 1; }
        (void)hipGetLastError();
        grid = cus;
    }
    if (grid < 0) return;
    (void)hipMemsetAsync((char*)d_ws + WS_CTL, 0, CTL_BYTES, stream);
    Args a{};
    a.x = (const float*)d_in[0]; a.c = (const float*)d_in[1]; a.ctx = (const float*)d_in[2]; a.c_ctx = (const float*)d_in[3]; a.w_ada = (const float*)d_in[4]; a.b_ada = (const float*)d_in[5];
    a.w_in = (const float*)d_in[6]; a.conv_w = (const float*)d_in[7]; a.a_log = (const float*)d_in[8]; a.dt_bias = (const float*)d_in[9]; a.gdn_norm_w = (const float*)d_in[10];
    a.q_norm_w = (const float*)d_in[11]; a.k_norm_w = (const float*)d_in[12]; a.lq1 = (const float*)d_in[13]; a.lk1 = (const float*)d_in[14]; a.lq2 = (const float*)d_in[15]; a.lk2 = (const float*)d_in[16];
    a.diff_norm_w = (const float*)d_in[17]; a.w_oa = (const float*)d_in[18]; a.w_ob = (const float*)d_in[19]; a.w_out = (const float*)d_in[20];
    a.out = (float*)d_out; a.ws = (unsigned char*)d_ws;
    hipLaunchKernelGGL(hybrid_fwd, dim3(grid), dim3(512), LDS_BYTES, stream, a);
    const hipError_t le = hipPeekAtLastError();
    if (le != hipSuccess) fprintf(stderr, "kernel_launch: launch failed: %s\n", hipGetErrorName(le));
}
```

```cpp
#include <hip/hip_runtime.h>
#include <cstdio>
#include <cstdint>
#define PG8_R1 1
#define PG8_R2 1
#define PG8_F1 1
#define PG8_F2 1
#define PG8_G 1
#define DIAG_IDX 0
#define R2_SKIP_Z 0

#define GAS __attribute__((address_space(1)))
#define LAS __attribute__((address_space(3)))
typedef unsigned short bf16;
typedef unsigned v4u __attribute__((ext_vector_type(4)));
typedef unsigned v2u __attribute__((ext_vector_type(2)));
typedef float f32x4 __attribute__((ext_vector_type(4)));

constexpr int NB = 2, SEQ = 8192, DM = 1024, LCTX = 256, NH = 8;
constexpr int MLAT = NB * SEQ, MCTX = NB * LCTX, MTOT = MLAT + MCTX;
constexpr int IN_COLS = 10272;
constexpr int N1 = 6400, N2ALL = 7168;
constexpr float EPS = 1e-6f;
constexpr float QSCALE = 0.125f * 1.4426950408889634f;

constexpr size_t MiB = 1u << 20;
constexpr size_t WS_CTL = 0, CTL_BYTES = 1 * MiB;
constexpr size_t WS_MODP = 1 * MiB;
constexpr size_t WS_MOD = 2 * MiB;
constexpr size_t WS_W2T = 3 * MiB;
constexpr size_t WS_AB = 17 * MiB;
constexpr size_t WS_T = 20 * MiB;
constexpr size_t WS_QKV = 53 * MiB;
constexpr size_t WS_QB = 152 * MiB;
constexpr size_t WS_KB = 184 * MiB;
constexpr size_t WS_VB = 217 * MiB;
constexpr size_t WS_END = 250 * MiB;
constexpr size_t WS_MERGED = 20 * MiB;
constexpr size_t WS_H2 = 53 * MiB;
constexpr size_t WS_NA = 85 * MiB;
constexpr size_t WS_T1 = 117 * MiB;
constexpr size_t WS_GATES = 184 * MiB;
constexpr size_t DO_H = 0;
constexpr size_t DO_W1T = 33 * MiB;

constexpr int LDS_BYTES = 147456;
constexpr int MISC_OFF = 131072 + 320;

__device__ __forceinline__ unsigned f2bf(float f) { unsigned u = __builtin_bit_cast(unsigned, f); return (u + 0x7fffu + ((u >> 16) & 1u)) >> 16; }
__device__ __forceinline__ unsigned pk2(float lo, float hi) { return f2bf(lo) | (f2bf(hi) << 16); }
__device__ __forceinline__ float bf2f(unsigned short h) { return __builtin_bit_cast(float, (unsigned)h << 16); }
__device__ __forceinline__ float bflo(unsigned w) { return __builtin_bit_cast(float, w << 16); }
__device__ __forceinline__ float bfhi(unsigned w) { return __builtin_bit_cast(float, w & 0xffff0000u); }
__device__ __forceinline__ float silu_f(float x) { return x / (1.f + __expf(-x)); }
__device__ __forceinline__ float sigmoid_f(float x) { return 1.f / (1.f + __expf(-x)); }
__device__ __forceinline__ float softplus_f(float x) { return fmaxf(x, 0.f) + log1pf(__expf(-fabsf(x))); }

#define XB_TMO      128
#define XB_XCNT(j)  (256  + 64 * (j))
#define XB_XSUB(j)  (1280 + 64 * (j))
#define XB_XGEN(j)  (2304 + 64 * (j))
#define XB_TOP      3328
#define XB_TOPGEN   3392
#define XCD_BAR_WORDS 3456
#define XB_SPIN_CAP (1u << 22)
__device__ __forceinline__ unsigned xb_ld(unsigned* p)              { return __hip_atomic_load(p, __ATOMIC_RELAXED, __HIP_MEMORY_SCOPE_AGENT); }
__device__ __forceinline__ unsigned xb_add(unsigned* p, unsigned v) { return __hip_atomic_fetch_add(p, v, __ATOMIC_RELAXED, __HIP_MEMORY_SCOPE_AGENT); }
__device__ __forceinline__ unsigned xb_xcc_id() { return (unsigned)__builtin_amdgcn_s_getreg((3 << 11) | 20) & 0xFu; }
#define XB_SPIN(cond, bar) do { unsigned _sp = 0; while (cond) { __builtin_amdgcn_s_sleep(1); \
    if ((++_sp & 255u) == 0u) { if (xb_ld(&(bar)[XB_TMO])) break; if (_sp > XB_SPIN_CAP) { atomicAdd(&(bar)[XB_TMO], 1u); break; } } } } while (0)
struct XcdBarrier { unsigned* bar; unsigned x; volatile LAS unsigned* st; };
__device__ __forceinline__ XcdBarrier xcd_barrier_post(unsigned* bar, volatile LAS unsigned* st) {
    XcdBarrier b; b.bar = bar; b.x = xb_xcc_id(); b.st = st;
    if (threadIdx.x == 0) (void)xb_add(&bar[XB_XCNT(b.x)], 1u);
    return b;
}
__device__ __forceinline__ void xcd_barrier_complete(unsigned* bar, unsigned x, unsigned& nloc, unsigned& nx) {
    const unsigned G = gridDim.x * gridDim.y * gridDim.z;
    unsigned sum, cnt, mine, sp = 0u;
    for (;;) {
        sum = 0u; cnt = 0u; mine = 0u;
#pragma unroll
        for (unsigned j = 0; j < 16; ++j) { const unsigned c = xb_ld(&bar[XB_XCNT(j)]); sum += c; cnt += (c > 0u) ? 1u : 0u; mine = (j == x) ? c : mine; }
        if (sum == G) break;
        __builtin_amdgcn_s_sleep(1);
        if ((++sp & 255u) == 0u) { if (xb_ld(&bar[XB_TMO])) break; if (sp > XB_SPIN_CAP) { atomicAdd(&bar[XB_TMO], 1u); break; } }
    }
    nloc = mine > 0u ? mine : 1u; nx = cnt > 0u ? cnt : 1u;
}
__device__ __forceinline__ void xcd_barrier(const XcdBarrier& b) {
    asm volatile("s_waitcnt vmcnt(0)" ::: "memory");
    __syncthreads();
    if (threadIdx.x == 0) {
        unsigned* bar = b.bar;
        __builtin_amdgcn_s_waitcnt(0);
        unsigned nloc = b.st[0], nx = b.st[1];
        if (nloc == 0u) { xcd_barrier_complete(bar, b.x, nloc, nx); b.st[0] = nloc; b.st[1] = nx; }
        const unsigned old = xb_add(&bar[XB_XSUB(b.x)], 1u);
        const unsigned gen = old / nloc;
        if (old + 1u == (gen + 1u) * nloc) {
            __builtin_amdgcn_fence(__ATOMIC_RELEASE, "agent");
            asm volatile("s_waitcnt vmcnt(0)" ::: "memory");
            const unsigned og = xb_add(&bar[XB_TOP], 1u);
            const unsigned tg = og / nx;
            if (og + 1u == (tg + 1u) * nx) xb_add(&bar[XB_TOPGEN], 1u);
            else XB_SPIN(xb_ld(&bar[XB_TOPGEN]) == tg, bar);
            __builtin_amdgcn_fence(__ATOMIC_ACQUIRE, "agent");
            xb_add(&bar[XB_XGEN(b.x)], 1u);
            asm volatile("s_waitcnt vmcnt(0)" ::: "memory");
        } else {
            XB_SPIN(xb_ld(&bar[XB_XGEN(b.x)]) == gen, bar);
            __builtin_amdgcn_fence(__ATOMIC_ACQUIRE, "agent");
            asm volatile("s_waitcnt vmcnt(0)" ::: "memory");
        }
    }
    __syncthreads();
    __builtin_amdgcn_fence(__ATOMIC_ACQUIRE, "agent");
    asm volatile("s_waitcnt vmcnt(0)" ::: "memory");
}

struct Args {
    const float* x; const float* c; const float* ctx; const float* c_ctx; const float* w_ada; const float* b_ada; const float* w_in; const float* conv_w;
    const float* a_log; const float* dt_bias; const float* gdn_norm_w; const float* q_norm_w; const float* k_norm_w;
    const float* lq1; const float* lk1; const float* lq2; const float* lk2; const float* diff_norm_w; const float* w_oa; const float* w_ob; const float* w_out;
    float* out; unsigned char* ws;
};

__device__ __forceinline__ float wave_sum(float v) {
#pragma unroll
    for (int o = 1; o < 64; o <<= 1) v += __shfl_xor(v, o);
    return v;
}

__device__ __forceinline__ int w1_src(int n) { if (n < 3072) return n; if (n < 4096) return 4128 + (n - 3072); if (n < 5120) return 5152 + (n - 4096); if (n < 6144) return 6176 + (n - 5120);
    if (n < 6176) return 4096 + (n - 6144); return -1; }
__device__ __forceinline__ int w2_src(int n) { if (n < 1024) return 3072 + n; if (n < 2048) return 7200 + (n - 1024); return 8224 + (n - 2048); }
__device__ __forceinline__ void transpose_item(const float* W, int ldw, int c0, bf16* WT, int n0, int k0, LAS float* scr, int lane) {
#pragma unroll 8
    for (int i = 0; i < 32; ++i) { const int kk = 2 * i + (lane >> 5); scr[kk * 33 + (lane & 31)] = (c0 >= 0) ? W[(size_t)(k0 + kk) * ldw + c0 + (lane & 31)] : 0.f; }
    asm volatile("s_waitcnt lgkmcnt(0)" ::: "memory");
    const int c = lane & 7;
#pragma unroll
    for (int j = 0; j < 4; ++j) { const int n = (lane >> 3) + 8 * j; const LAS float* s = scr + (8 * c) * 33 + n;
        v4u o; o.x = pk2(s[0 * 33], s[1 * 33]); o.y = pk2(s[2 * 33], s[3 * 33]); o.z = pk2(s[4 * 33], s[5 * 33]); o.w = pk2(s[6 * 33], s[7 * 33]);
        *(v4u*)(WT + (size_t)(n0 + n) * 1024 + k0 + 8 * c) = o; }
    asm volatile("s_waitcnt lgkmcnt(0)" ::: "memory");
}

template <class Epi>
__device__ __forceinline__ void gemm_naive(unsigned char* ldsg, const bf16* A, const bf16* Bt, int M, int N, int K, const Epi& epi) {
    float* As = (float*)ldsg; float* Bs = As + 32 * 132;
    const int tid = threadIdx.x, ty = tid >> 4, tx = tid & 15;
    const int nM = M / 128, nN = N / 128;
    for (int unit = blockIdx.x; unit < nM * nN; unit += gridDim.x) {
        const int pm = unit / nN, pn = unit % nN;
        float acc[4][8];
#pragma unroll
        for (int i = 0; i < 4; ++i)
#pragma unroll
            for (int j = 0; j < 8; ++j) acc[i][j] = 0.f;
        const int srow = tid >> 2, skc = (tid & 3) * 8;
        for (int k0 = 0; k0 < K; k0 += 32) {
            const v4u av = *(const v4u*)(A + (size_t)(pm * 128 + srow) * K + k0 + skc);
            const v4u bv = *(const v4u*)(Bt + (size_t)(pn * 128 + srow) * K + k0 + skc);
            As[(skc + 0) * 132 + srow] = bflo(av.x); As[(skc + 1) * 132 + srow] = bfhi(av.x); As[(skc + 2) * 132 + srow] = bflo(av.y); As[(skc + 3) * 132 + srow] = bfhi(av.y);
            As[(skc + 4) * 132 + srow] = bflo(av.z); As[(skc + 5) * 132 + srow] = bfhi(av.z); As[(skc + 6) * 132 + srow] = bflo(av.w); As[(skc + 7) * 132 + srow] = bfhi(av.w);
            Bs[(skc + 0) * 132 + srow] = bflo(bv.x); Bs[(skc + 1) * 132 + srow] = bfhi(bv.x); Bs[(skc + 2) * 132 + srow] = bflo(bv.y); Bs[(skc + 3) * 132 + srow] = bfhi(bv.y);
            Bs[(skc + 4) * 132 + srow] = bflo(bv.z); Bs[(skc + 5) * 132 + srow] = bfhi(bv.z); Bs[(skc + 6) * 132 + srow] = bflo(bv.w); Bs[(skc + 7) * 132 + srow] = bfhi(bv.w);
            __syncthreads();
#pragma unroll 8
            for (int kk = 0; kk < 32; ++kk) {
                const f32x4 a = *(const f32x4*)(As + kk * 132 + ty * 4);
                const f32x4 b0 = *(const f32x4*)(Bs + kk * 132 + tx * 8), b1 = *(const f32x4*)(Bs + kk * 132 + tx * 8 + 4);
#pragma unroll
                for (int i = 0; i < 4; ++i) { acc[i][0] += a[i] * b0[0]; acc[i][1] += a[i] * b0[1]; acc[i][2] += a[i] * b0[2]; acc[i][3] += a[i] * b0[3];
                    acc[i][4] += a[i] * b1[0]; acc[i][5] += a[i] * b1[1]; acc[i][6] += a[i] * b1[2]; acc[i][7] += a[i] * b1[3]; }
            }
            __syncthreads();
        }
#pragma unroll
        for (int i = 0; i < 4; ++i)
#pragma unroll
            for (int j = 0; j < 8; ++j) epi(pm * 128 + ty * 4 + i, pn * 128 + tx * 8 + j, acc[i][j]);
    }
}

struct EpiR1 { bf16* QKV; bf16* QB; bf16* KB; bf16* VB; float* AB;
    __device__ __forceinline__ void operator()(int r, int c, float v) const {
        if (c < 3072) QKV[(size_t)r * 3072 + c] = (bf16)f2bf(v);
        else if (c < 4096) { if (r < MLAT) QB[(size_t)r * 1024 + (c - 3072)] = (bf16)f2bf(v); }
        else if (c < 5120) KB[(size_t)r * 1024 + (c - 4096)] = (bf16)f2bf(v);
        else if (c < 6144) VB[(size_t)r * 1024 + (c - 5120)] = (bf16)f2bf(v);
        else if (c < 6176) AB[(size_t)r * 32 + (c - 6144)] = v;
    } };
struct EpiR2 { bf16* NA; bf16* QB; bf16* GATES;
    __device__ __forceinline__ void operator()(int r, int c, float v) const {
        if (c < 1024) { bf16* p = NA + (size_t)r * 1024 + c; *p = (bf16)f2bf(silu_f(v) * bf2f(*p)); }
        else if (c < 2048) { bf16* p = QB + (size_t)r * 1024 + (c - 1024); *p = (bf16)f2bf(0.8f * silu_f(v) * bf2f(*p)); }
        else GATES[(size_t)r * 2048 + (c - 2048)] = (bf16)f2bf(sigmoid_f(v));
    } };
struct EpiR2Chk { bf16* NA; bf16* QB; bf16* GATES; const bf16* YA2; const bf16* YB2; unsigned* cnt;
    __device__ __forceinline__ void operator()(int r, int c, float v) const {
        float ref, got;
        if (c < 1024) { bf16* p = NA + (size_t)r * 1024 + c; ref = silu_f(v) * bf2f(YA2[(size_t)r * 1024 + c]); got = bf2f(*p); *p = (bf16)f2bf(ref); if (fabsf(ref - got) > 0.02f * fabsf(ref) + 0.01f) atomicAdd(cnt + 0, 1u); }
        else if (c < 2048) { bf16* p = QB + (size_t)r * 1024 + (c - 1024); ref = 0.8f * silu_f(v) * bf2f(YB2[(size_t)r * 1024 + (c - 1024)]); got = bf2f(*p); *p = (bf16)f2bf(ref); if (fabsf(ref - got) > 0.02f * fabsf(ref) + 0.01f) atomicAdd(cnt + 1, 1u); }
        else { bf16* p = GATES + (size_t)r * 2048 + (c - 2048); ref = sigmoid_f(v); got = bf2f(*p); *p = (bf16)f2bf(ref); if (fabsf(ref - got) > 0.02f) atomicAdd(cnt + 2, 1u); }
    } };
struct EpiF1 { bf16* T1; const bf16* GATES;
    __device__ __forceinline__ void operator()(int r, int c, float v) const { T1[(size_t)r * 1024 + c] = (bf16)f2bf(v * bf2f(GATES[(size_t)r * 2048 + c])); } };
struct EpiF2 { bf16* MERGED; const bf16* T1; const bf16* GATES;
    __device__ __forceinline__ void operator()(int r, int c, float v) const { MERGED[(size_t)r * 1024 + c] = (bf16)f2bf(bf2f(T1[(size_t)r * 1024 + c]) + v * bf2f(GATES[(size_t)r * 2048 + 1024 + c])); } };
struct EpiG { float* out; const float* x; const float* mod;
    __device__ __forceinline__ void operator()(int r, int c, float v) const { const int b = r / SEQ; out[(size_t)r * 1024 + c] = x[(size_t)r * 1024 + c] + mod[b * 3072 + 2048 + c] * v; } };

namespace pg8 {
#define PG8_LAS __attribute__((address_space(3)))
typedef unsigned short bf16_t;
typedef short bf16x8 __attribute__((ext_vector_type(8)));
typedef float f32x4 __attribute__((ext_vector_type(4)));
typedef unsigned u32x4 __attribute__((ext_vector_type(4)));
constexpr int BM = 256, BK = 64, HALF = 128, HTB = HALF * BK * 2  , STAGE_BYTES = 8 * HTB, NXCD = 8, WGM = 8;

__host__ __device__ __forceinline__ int lds_byte(int r, int c) { const int st = (r >> 4) * 2 + (c >> 5), rr = r & 15, cc = c & 31, ob = rr * 64 + cc * 2; return st * 1024 + (ob ^ (((ob >> 9) & 1) << 5)); }
__host__ __device__ __forceinline__ void stage_rc(int b, int& R, int& C) { const int st = b / 1024, sb = b % 1024, swz = sb ^ (((sb >> 9) & 1) << 5); R = (st >> 1) * 16 + swz / 64; C = (st & 1) * 32 + (swz % 64) / 2; }
__host__ __device__ __forceinline__ int perm32(int rho) { const int n = rho >> 4, i = rho & 15; return 8 * (i >> 2) + 4 * n + (i & 3); }

struct Unit { int pm, pn; };
struct Gemm { const bf16_t* A; const bf16_t* Bt; int M, N, K; };

struct StaticOrder {
    int nM, nN, nwg, G, c;
    __host__ __device__ void init(int M, int N, int G_, int c_) { nM = M / BM; nN = N / BM; nwg = nM * nN; G = G_; c = c_; }
    __host__ __device__ bool next(int i, Unit& u) const {
        const long L = (long)i * G + c; if (L >= nwg) return false;
        int wgid = (int)L; { const int q = nwg / NXCD, r = nwg % NXCD, xcd = wgid % NXCD, off = wgid / NXCD; wgid = (xcd < r ? xcd * (q + 1) : r * (q + 1) + (xcd - r) * q) + off; }
        const int nig = WGM * nN, gid = wgid / nig, fm = gid * WGM, gsz = (nM - fm) < WGM ? (nM - fm) : WGM;
        u.pm = fm + ((wgid % nig) % gsz); u.pn = (wgid % nig) / gsz; return true;
    }
    __device__ __forceinline__ void a_ready(const Unit&) const {}
    __device__ __forceinline__ void done(const Unit&) const {}
};

__device__ __forceinline__ unsigned cvt_pk_bf16(float lo, float hi) { unsigned r; asm volatile("v_cvt_pk_bf16_f32 %0, %1, %2" : "=v"(r) : "v"(lo), "v"(hi)); return r; }
__device__ __forceinline__ float silu_e(float x) { return x * __builtin_amdgcn_rcpf(1.f + __expf(-x)); }
__device__ __forceinline__ float sigm_e(float x) { return __builtin_amdgcn_rcpf(1.f + __expf(-x)); }
__device__ __forceinline__ float blo(unsigned w) { return __builtin_bit_cast(float, w << 16); }
__device__ __forceinline__ float bhi(unsigned w) { return __builtin_bit_cast(float, w & 0xffff0000u); }
__device__ __forceinline__ u32x4 pack8(const f32x4 v0, const f32x4 v1) { u32x4 w; w.x = cvt_pk_bf16(v0[0], v0[1]); w.y = cvt_pk_bf16(v0[2], v0[3]); w.z = cvt_pk_bf16(v1[0], v1[1]); w.w = cvt_pk_bf16(v1[2], v1[3]); return w; }
struct EpiR1 {
    static constexpr bool PERM = true, AFTER_DRAIN = false;
    bf16_t* QKV; bf16_t* QB; bf16_t* KB; bf16_t* VB; float* AB; int mlat_tiles;
    __device__ __forceinline__ void operator()(const f32x4 (&acc)[2][2][4][2], const Unit& u, int wr, int wc, int fr, int fq) const {
        const int row0 = u.pm * BM + wr * 64 + fr, cl = wc * 32 + 8 * fq;
        bf16_t* base; int ldc, colt;
        if (u.pn < 12) { base = QKV; ldc = 3072; colt = u.pn * 256; }
        else if (u.pn < 16) { if (u.pm >= mlat_tiles) return; base = QB; ldc = 1024; colt = (u.pn - 12) * 256; }
        else if (u.pn < 20) { base = KB; ldc = 1024; colt = (u.pn - 16) * 256; }
        else if (u.pn < 24) { base = VB; ldc = 1024; colt = (u.pn - 20) * 256; }
        else {
            if (wc == 0) {
#pragma unroll
                for (int ai = 0; ai < 2; ++ai)
#pragma unroll
                    for (int m = 0; m < 4; ++m) { float* p = AB + (size_t)(row0 + ai * HALF + m * 16) * 32 + 8 * fq; *(f32x4*)p = acc[ai][0][m][0]; *(f32x4*)(p + 4) = acc[ai][0][m][1]; }
            }
            return;
        }
#pragma unroll
        for (int ai = 0; ai < 2; ++ai)
#pragma unroll
            for (int m = 0; m < 4; ++m) { bf16_t* rowp = base + (size_t)(row0 + ai * HALF + m * 16) * ldc + colt + cl;
#pragma unroll
                for (int bj = 0; bj < 2; ++bj) *(u32x4*)(rowp + bj * HALF) = pack8(acc[ai][bj][m][0], acc[ai][bj][m][1]); }
    }
};
struct EpiR2 {
    static constexpr bool PERM = true, AFTER_DRAIN = false;
    bf16_t* NA; bf16_t* QB; bf16_t* GATES; bf16_t* YA2; bf16_t* YB2;
    __device__ __forceinline__ void operator()(const f32x4 (&acc)[2][2][4][2], const Unit& u, int wr, int wc, int fr, int fq) const {
        const int row0 = u.pm * BM + wr * 64 + fr, cl = wc * 32 + 8 * fq;
        if (u.pn >= 8) {
            const int colt = (u.pn - 8) * 256;
#pragma unroll
            for (int ai = 0; ai < 2; ++ai)
#pragma unroll
                for (int m = 0; m < 4; ++m) { bf16_t* rowp = GATES + (size_t)(row0 + ai * HALF + m * 16) * 2048 + colt + cl;
#pragma unroll
                    for (int bj = 0; bj < 2; ++bj) { f32x4 v0 = acc[ai][bj][m][0], v1 = acc[ai][bj][m][1];
#pragma unroll
                        for (int i = 0; i < 4; ++i) { v0[i] = sigm_e(v0[i]); v1[i] = sigm_e(v1[i]); }
                        *(u32x4*)(rowp + bj * HALF) = pack8(v0, v1); } }
            return;
        }
        if (R2_SKIP_Z) return;
        bf16_t* base = (u.pn < 4) ? NA : QB; bf16_t* dst = (u.pn < 4) ? YA2 : YB2; const float sc = (u.pn < 4) ? 1.0f : 0.8f; const int colt = (u.pn & 3) * 256;
#pragma unroll
        for (int ai = 0; ai < 2; ++ai)
#pragma unroll
            for (int m = 0; m < 4; ++m) { bf16_t* rowp = base + (size_t)(row0 + ai * HALF + m * 16) * 1024 + colt + cl; bf16_t* rowd = dst + (size_t)(row0 + ai * HALF + m * 16) * 1024 + colt + cl;
#pragma unroll
                for (int bj = 0; bj < 2; ++bj) { const u32x4 old = *(const u32x4*)(rowp + bj * HALF); f32x4 v0 = acc[ai][bj][m][0], v1 = acc[ai][bj][m][1];
                    v0[0] = silu_e(v0[0]) * sc * blo(old.x); v0[1] = silu_e(v0[1]) * sc * bhi(old.x); v0[2] = silu_e(v0[2]) * sc * blo(old.y); v0[3] = silu_e(v0[3]) * sc * bhi(old.y);
                    v1[0] = silu_e(v1[0]) * sc * blo(old.z); v1[1] = silu_e(v1[1]) * sc * bhi(old.z); v1[2] = silu_e(v1[2]) * sc * blo(old.w); v1[3] = silu_e(v1[3]) * sc * bhi(old.w);
                    *(u32x4*)(rowd + bj * HALF) = pack8(v0, v1); } }
    }
};
struct EpiF {
    static constexpr bool PERM = true, AFTER_DRAIN = false;
    bf16_t* OUT; const bf16_t* T1; const bf16_t* GATES; int mode;
    __device__ __forceinline__ void operator()(const f32x4 (&acc)[2][2][4][2], const Unit& u, int wr, int wc, int fr, int fq) const {
        const int row0 = u.pm * BM + wr * 64 + fr, col0 = u.pn * BM + wc * 32 + 8 * fq;
#pragma unroll
        for (int ai = 0; ai < 2; ++ai)
#pragma unroll
            for (int m = 0; m < 4; ++m) { const size_t r = (size_t)(row0 + ai * HALF + m * 16);
#pragma unroll
                for (int bj = 0; bj < 2; ++bj) { const int c = col0 + bj * HALF;
                    const u32x4 g = *(const u32x4*)(GATES + r * 2048 + mode * 1024 + c); f32x4 v0 = acc[ai][bj][m][0], v1 = acc[ai][bj][m][1];
                    v0[0] *= blo(g.x); v0[1] *= bhi(g.x); v0[2] *= blo(g.y); v0[3] *= bhi(g.y); v1[0] *= blo(g.z); v1[1] *= bhi(g.z); v1[2] *= blo(g.w); v1[3] *= bhi(g.w);
                    if (mode) { const u32x4 t = *(const u32x4*)(T1 + r * 1024 + c);
                        v0[0] += blo(t.x); v0[1] += bhi(t.x); v0[2] += blo(t.y); v0[3] += bhi(t.y); v1[0] += blo(t.z); v1[1] += bhi(t.z); v1[2] += blo(t.w); v1[3] += bhi(t.w); }
                    *(u32x4*)(OUT + r * 1024 + c) = pack8(v0, v1); } }
    }
};
struct EpiG {
    static constexpr bool PERM = true, AFTER_DRAIN = false;
    float* out; const float* x; const float* mod; int tiles_per_batch;
    __device__ __forceinline__ void operator()(const f32x4 (&acc)[2][2][4][2], const Unit& u, int wr, int wc, int fr, int fq) const {
        const int row0 = u.pm * BM + wr * 64 + fr, col0 = u.pn * BM + wc * 32 + 8 * fq; const int b = u.pm / tiles_per_batch;
        f32x4 gv[2][2];
#pragma unroll
        for (int bj = 0; bj < 2; ++bj) { gv[bj][0] = *(const f32x4*)(mod + b * 3072 + 2048 + col0 + bj * HALF); gv[bj][1] = *(const f32x4*)(mod + b * 3072 + 2048 + col0 + bj * HALF + 4); }
#pragma unroll
        for (int ai = 0; ai < 2; ++ai)
#pragma unroll
            for (int m = 0; m < 4; ++m) { const size_t off = (size_t)(row0 + ai * HALF + m * 16) * 1024 + col0;
#pragma unroll
                for (int bj = 0; bj < 2; ++bj) { const f32x4 x0 = *(const f32x4*)(x + off + bj * HALF), x1 = *(const f32x4*)(x + off + bj * HALF + 4);
                    *(f32x4*)(out + off + bj * HALF) = x0 + gv[bj][0] * acc[ai][bj][m][0]; *(f32x4*)(out + off + bj * HALF + 4) = x1 + gv[bj][1] * acc[ai][bj][m][1]; } }
    }
};
template <class Epi, class Sched, bool ALIGN_EPI = false, bool SP2 = false>
__device__ __forceinline__ void gemm_phase(PG8_LAS unsigned char* lds, const Gemm g, const Sched& S, const Epi& E) {
    const int tid = threadIdx.x, wid = __builtin_amdgcn_readfirstlane(tid >> 6), lane = tid & 63, wr = wid >> 2, wc = wid & 3, fr = lane & 15, fq = lane >> 4;
    const int K = g.K, nt = K / BK;
    unsigned voffA[2], voffB[2];
#pragma unroll
    for (int i = 0; i < 2; ++i) { int R, C; stage_rc(tid * 16 + i * 8192, R, C); const int Rb = Epi::PERM ? ((R & ~31) + perm32(R & 31)) : R;
        voffA[i] = (unsigned)(R * K + C) * 2u; voffB[i] = (unsigned)(Rb * K + C) * 2u; }
    const size_t kstep = (size_t)(BK * 2);
    const size_t hstep = (size_t)HALF * K * 2;
    const size_t tstep = 2 * hstep;
    const unsigned ldsw = (unsigned)wid * 1024u;
    const int aoff = lds_byte(wr * 64 + fr, fq * 8), boff = lds_byte(wc * 32 + fr, fq * 8);
#define PG8_SA(b, h) (((b) * 2 + (h)) * HTB)
#define PG8_SB(b, h) ((4 + (b) * 2 + (h)) * HTB)
#define PG8_STAGE(bufoff, gbase, voff) do { _Pragma("unroll") for (int _i = 0; _i < 2; ++_i) \
        __builtin_amdgcn_global_load_lds((const unsigned*)((const char*)(gbase) + (voff)[_i]), (PG8_LAS unsigned*)(lds + (bufoff) + ldsw + _i * 8192), 16, 0, 0); } while (0)
#define PG8_LDA(dst, b, h) do { _Pragma("unroll") for (int m = 0; m < 4; ++m) _Pragma("unroll") for (int k = 0; k < 2; ++k) dst[m][k] = *(const PG8_LAS bf16x8*)(lds + PG8_SA(b, h) + aoff + m * 2048 + k * 1024); } while (0)
#define PG8_LDB(dst, b, h) do { _Pragma("unroll") for (int n = 0; n < 2; ++n) _Pragma("unroll") for (int k = 0; k < 2; ++k) dst[n][k] = *(const PG8_LAS bf16x8*)(lds + PG8_SB(b, h) + boff + n * 2048 + k * 1024); } while (0)
#define PG8_MMA(ai, bj, At, Bt) do { __builtin_amdgcn_s_setprio(1); _Pragma("unroll") for (int m = 0; m < 4; ++m) _Pragma("unroll") for (int n = 0; n < 2; ++n) _Pragma("unroll") for (int k = 0; k < 2; ++k) \
        acc[ai][bj][m][n] = __builtin_amdgcn_mfma_f32_16x16x32_bf16(Bt[n][k], At[m][k], acc[ai][bj][m][n], 0, 0, 0); __builtin_amdgcn_s_setprio(0); } while (0)
#define PG8_WAIT_V(n) asm volatile("s_waitcnt vmcnt(" #n ")" ::: "memory")
#define PG8_WAIT_L(n) asm volatile("s_waitcnt lgkmcnt(" #n ")" ::: "memory")
#define PG8_BAR __builtin_amdgcn_s_barrier()
#define PG8_SCHED __builtin_amdgcn_sched_barrier(0)
    Unit cur, nxt; int ui = 0;
    if (!S.next(0, cur)) return;
    f32x4 acc[2][2][4][2];
#pragma unroll
    for (int a = 0; a < 2; ++a)
#pragma unroll
        for (int b = 0; b < 2; ++b)
#pragma unroll
            for (int m = 0; m < 4; ++m)
#pragma unroll
                for (int n = 0; n < 2; ++n) acc[a][b][m][n] = (f32x4){0.f, 0.f, 0.f, 0.f};
    bf16x8 At[4][2], B0[2][2], B1[2][2];
    const char* cA = (const char*)g.A + (size_t)cur.pm * tstep; const char* cB = (const char*)g.Bt + (size_t)cur.pn * tstep;
    S.a_ready(cur);
    if constexpr (SP2) {
        PG8_STAGE(PG8_SB(0, 0), cB, voffB); PG8_STAGE(PG8_SB(0, 1), cB + hstep, voffB); PG8_STAGE(PG8_SA(0, 0), cA, voffA); PG8_STAGE(PG8_SA(0, 1), cA + hstep, voffA);
        if (wr == 1) PG8_BAR;
        PG8_WAIT_V(2); PG8_BAR;
        PG8_STAGE(PG8_SB(1, 0), cB + kstep, voffB); PG8_STAGE(PG8_SA(1, 0), cA + kstep, voffA); PG8_STAGE(PG8_SB(1, 1), cB + hstep + kstep, voffB);
        PG8_WAIT_V(6); PG8_BAR;
    } else {
        PG8_STAGE(PG8_SB(0, 0), cB, voffB); PG8_STAGE(PG8_SA(0, 0), cA, voffA); PG8_STAGE(PG8_SB(0, 1), cB + hstep, voffB); PG8_STAGE(PG8_SA(0, 1), cA + hstep, voffA);
        if (wr == 1) PG8_BAR;
        PG8_WAIT_V(4); PG8_BAR;
        PG8_STAGE(PG8_SB(1, 0), cB + kstep, voffB); PG8_STAGE(PG8_SA(1, 0), cA + kstep, voffA); PG8_STAGE(PG8_SB(1, 1), cB + hstep + kstep, voffB);
        PG8_WAIT_V(6); PG8_BAR;
    }
    for (;;) {
        const bool has_next = S.next(ui + 1, nxt);
        const char* nA = has_next ? (const char*)g.A + (size_t)nxt.pm * tstep : cA; const char* nB = has_next ? (const char*)g.Bt + (size_t)nxt.pn * tstep : cB;
        for (int t = 0; t < nt; t += 2) {
            const bool last = (t == nt - 2);
            const char* a1 = cA + (size_t)(t + 1) * kstep;
            const char* a2 = last ? nA : cA + (size_t)(t + 2) * kstep; const char* b2 = last ? nB : cB + (size_t)(t + 2) * kstep;
            const char* a3 = a2 + kstep; const char* b3 = b2 + kstep;
            if (last && has_next) S.a_ready(nxt);
            if constexpr (SP2) {
            PG8_LDB(B0, 0, 0); PG8_LDB(B1, 0, 1); PG8_SCHED; PG8_LDA(At, 0, 0); PG8_STAGE(PG8_SA(1, 1), a1 + hstep, voffA);
            PG8_WAIT_V(8); PG8_WAIT_L(0); PG8_BAR; PG8_MMA(0, 0, At, B0); PG8_MMA(0, 1, At, B1); PG8_BAR; PG8_SCHED;
            PG8_LDA(At, 0, 1); PG8_STAGE(PG8_SB(0, 0), b2, voffB); PG8_STAGE(PG8_SB(0, 1), b2 + hstep, voffB); PG8_STAGE(PG8_SA(0, 0), a2, voffA);
            PG8_WAIT_V(8); PG8_WAIT_L(0); PG8_BAR; PG8_MMA(1, 0, At, B0); PG8_MMA(1, 1, At, B1); PG8_BAR; PG8_SCHED;
            PG8_LDB(B0, 1, 0); PG8_LDB(B1, 1, 1); PG8_SCHED; PG8_LDA(At, 1, 0); PG8_STAGE(PG8_SA(0, 1), a2 + hstep, voffA);
            PG8_WAIT_V(8); PG8_WAIT_L(0); PG8_BAR; PG8_MMA(0, 0, At, B0); PG8_MMA(0, 1, At, B1); PG8_BAR; PG8_SCHED;
            PG8_LDA(At, 1, 1); PG8_STAGE(PG8_SB(1, 0), b3, voffB); PG8_STAGE(PG8_SB(1, 1), b3 + hstep, voffB); PG8_STAGE(PG8_SA(1, 0), a3, voffA);
            PG8_WAIT_V(8); PG8_WAIT_L(0); PG8_BAR; PG8_MMA(1, 0, At, B0); PG8_MMA(1, 1, At, B1); PG8_BAR; PG8_SCHED;
            } else {
            PG8_LDB(B0, 0, 0); PG8_SCHED; PG8_LDA(At, 0, 0); PG8_STAGE(PG8_SA(1, 1), a1 + hstep, voffA);
            PG8_WAIT_L(8); PG8_BAR; PG8_WAIT_L(0); PG8_MMA(0, 0, At, B0); PG8_BAR; PG8_SCHED;
            PG8_LDB(B1, 0, 1); PG8_STAGE(PG8_SB(0, 0), b2, voffB);
            PG8_BAR; PG8_WAIT_L(0); PG8_MMA(0, 1, At, B1); PG8_BAR;
            PG8_LDA(At, 0, 1); PG8_STAGE(PG8_SA(0, 0), a2, voffA);
            PG8_BAR; PG8_WAIT_L(0); PG8_MMA(1, 0, At, B0); PG8_BAR; PG8_SCHED;
            PG8_STAGE(PG8_SB(0, 1), b2 + hstep, voffB);
            PG8_WAIT_V(6); PG8_BAR; PG8_MMA(1, 1, At, B1); PG8_BAR;
            PG8_LDB(B0, 1, 0); PG8_SCHED; PG8_LDA(At, 1, 0); PG8_STAGE(PG8_SA(0, 1), a2 + hstep, voffA);
            PG8_WAIT_L(8); PG8_BAR; PG8_WAIT_L(0); PG8_MMA(0, 0, At, B0); PG8_BAR; PG8_SCHED;
            PG8_LDB(B1, 1, 1); PG8_STAGE(PG8_SB(1, 0), b3, voffB);
            PG8_BAR; PG8_WAIT_L(0); PG8_MMA(0, 1, At, B1); PG8_BAR;
            PG8_LDA(At, 1, 1); PG8_STAGE(PG8_SA(1, 0), a3, voffA);
            PG8_BAR; PG8_WAIT_L(0); PG8_MMA(1, 0, At, B0); PG8_BAR; PG8_SCHED;
            PG8_STAGE(PG8_SB(1, 1), b3 + hstep, voffB);
            PG8_WAIT_V(6); PG8_BAR; PG8_MMA(1, 1, At, B1); PG8_BAR;
            }
        }
        if constexpr (ALIGN_EPI) { if (wr == 0) PG8_BAR; }
        if constexpr (!Epi::AFTER_DRAIN) { E(acc, cur, wr, wc, fr, fq); S.done(cur); }
        if (!has_next) break;
#pragma unroll
        for (int a = 0; a < 2; ++a)
#pragma unroll
            for (int b = 0; b < 2; ++b)
#pragma unroll
                for (int m = 0; m < 4; ++m)
#pragma unroll
                    for (int n = 0; n < 2; ++n) acc[a][b][m][n] = (f32x4){0.f, 0.f, 0.f, 0.f};
        cur = nxt; cA = nA; cB = nB; ++ui;
        if constexpr (ALIGN_EPI) { if (wr == 1) PG8_BAR; }
    }
    PG8_WAIT_V(0);
    if constexpr (!ALIGN_EPI) { if (wr == 0) PG8_BAR; }
    PG8_BAR;
    if constexpr (Epi::AFTER_DRAIN) { E.fused(acc, cur, wr, wc, fr, fq, lds, wid, lane); S.done(cur); }
#undef PG8_SA
#undef PG8_SB
#undef PG8_STAGE
#undef PG8_LDA
#undef PG8_LDB
#undef PG8_MMA
#undef PG8_WAIT_V
#undef PG8_WAIT_L
#undef PG8_BAR
#undef PG8_SCHED
}
}

namespace att {
using bf16x8 = __attribute__((ext_vector_type(8))) short;
using s16x4  = __attribute__((ext_vector_type(4))) short;
using f32x16 = __attribute__((ext_vector_type(16))) float;
using u32x4  = __attribute__((ext_vector_type(4))) unsigned;
constexpr int KVBLK = 64, NTILES = (LCTX + SEQ) / KVBLK;
constexpr int SHM_V = KVBLK * 128 * 2, SHM_K = KVBLK * 128 * 2;
constexpr int LDS_WS = 2 * SHM_V + 2 * SHM_K;
#define KSWZ(row, colB) ((row) * 256 + ((colB) ^ (((row) & 7) << 4)))
#define SBAR() __builtin_amdgcn_sched_barrier(0)
__device__ __forceinline__ int crow(int r, int hi) { return (r & 3) + 8 * (r >> 2) + 4 * hi; }
__device__ __forceinline__ unsigned cvtpk(float lo, float hi) { unsigned r; asm volatile("v_cvt_pk_bf16_f32 %0, %1, %2" : "=v"(r) : "v"(lo), "v"(hi)); return r; }
__device__ __forceinline__ int v_st(int k, int c) { const int kk = (k & ~0xC) | ((k & 4) << 1) | ((k & 8) >> 1); return ((kk >> 3) * 4 + (c >> 5)) * 512 + ((kk & 7) * 32 + (c & 31)) * 2; }
__device__ __forceinline__ int v_rd_base(int lane) { return ((lane & 3) << 3) | (((lane >> 2) & 3) << 6) | (((lane >> 4) & 1) << 5) | (((lane >> 5) & 1) << 8); }
constexpr int v_rd_off(int d0, int ks, int half) { return d0 * 512 + ks * 4096 + half * 2048; }
template <int OFF> __device__ __forceinline__ s16x4 tr_read(int vb) { s16x4 r; asm volatile("ds_read_b64_tr_b16 %0, %1 offset:%2" : "=&v"(r) : "v"(vb), "i"(OFF) : "memory"); return r; }
template <int D0> __device__ __forceinline__ void pv_one(f32x16& od, int vb, bf16x8 pa0, bf16x8 pa1, bf16x8 pa2, bf16x8 pa3) {
  const s16x4 l0 = tr_read<v_rd_off(D0, 0, 0)>(vb), h0 = tr_read<v_rd_off(D0, 0, 1)>(vb), l1 = tr_read<v_rd_off(D0, 1, 0)>(vb), h1 = tr_read<v_rd_off(D0, 1, 1)>(vb);
  const s16x4 l2 = tr_read<v_rd_off(D0, 2, 0)>(vb), h2 = tr_read<v_rd_off(D0, 2, 1)>(vb), l3 = tr_read<v_rd_off(D0, 3, 0)>(vb), h3 = tr_read<v_rd_off(D0, 3, 1)>(vb);
  asm volatile("s_waitcnt lgkmcnt(0)" ::: "memory"); SBAR();
#define PK(L, H) (bf16x8){L[0], L[1], L[2], L[3], H[0], H[1], H[2], H[3]}
  od = __builtin_amdgcn_mfma_f32_32x32x16_bf16(pa0, PK(l0, h0), od, 0, 0, 0);
  od = __builtin_amdgcn_mfma_f32_32x32x16_bf16(pa1, PK(l1, h1), od, 0, 0, 0);
  od = __builtin_amdgcn_mfma_f32_32x32x16_bf16(pa2, PK(l2, h2), od, 0, 0, 0);
  od = __builtin_amdgcn_mfma_f32_32x32x16_bf16(pa3, PK(l3, h3), od, 0, 0, 0);
#undef PK
}
__device__ __forceinline__ void pv_d0(f32x16* o, int vb, bf16x8 pa0, bf16x8 pa1, bf16x8 pa2, bf16x8 pa3) {
  pv_one<0>(o[0], vb, pa0, pa1, pa2, pa3); pv_one<1>(o[1], vb, pa0, pa1, pa2, pa3); pv_one<2>(o[2], vb, pa0, pa1, pa2, pa3); pv_one<3>(o[3], vb, pa0, pa1, pa2, pa3);
}
__device__ __forceinline__ void qkt(f32x16& p0, f32x16& p1, const char* Ks, const bf16x8* qr, int comp, int r32, int hi, float negm) {
#pragma unroll
  for (int r = 0; r < 16; ++r) { p0[r] = negm; p1[r] = negm; }
#pragma unroll
  for (int d0 = 0; d0 < 4; ++d0) { const int cb = ((comp * 4 + d0) * 16 + hi * 8) * 2;
    const bf16x8 b0 = *reinterpret_cast<const bf16x8*>(Ks + KSWZ(r32, cb));
    const bf16x8 b1 = *reinterpret_cast<const bf16x8*>(Ks + KSWZ(32 + r32, cb));
    p0 = __builtin_amdgcn_mfma_f32_32x32x16_bf16(b0, qr[d0], p0, 0, 0, 0);
    p1 = __builtin_amdgcn_mfma_f32_32x32x16_bf16(b1, qr[d0], p1, 0, 0, 0); }
}
__device__ __forceinline__ void partialSM(f32x16& p0) {
#pragma unroll
  for (int r = 0; r < 16; ++r) p0[r] = __builtin_amdgcn_exp2f(p0[r]);
}
__device__ __forceinline__ void finishSM(f32x16& p0, f32x16& p1, float& l_reg, bf16x8& pa0, bf16x8& pa1, bf16x8& pa2, bf16x8& pa3) {
#pragma unroll
  for (int r = 0; r < 16; ++r) p1[r] = __builtin_amdgcn_exp2f(p1[r]);
  float ps = 0.f;
#pragma unroll
  for (int r = 0; r < 16; ++r) ps += p0[r];
#pragma unroll
  for (int r = 0; r < 16; ++r) ps += p1[r];
  l_reg += ps;
#define PK4(P, BASE, OUT) do { unsigned a0 = cvtpk(P[BASE + 0], P[BASE + 1]), a1 = cvtpk(P[BASE + 2], P[BASE + 3]);   \
    unsigned b0 = cvtpk(P[BASE + 4], P[BASE + 5]), b1 = cvtpk(P[BASE + 6], P[BASE + 7]);                              \
    auto r0 = __builtin_amdgcn_permlane32_swap(a0, b0, false, false); auto r1 = __builtin_amdgcn_permlane32_swap(a1, b1, false, false); \
    u32x4 w = {r0[0], r1[0], r0[1], r1[1]}; OUT = *reinterpret_cast<bf16x8*>(&w); } while (0)
  PK4(p0, 0, pa0); PK4(p0, 8, pa1); PK4(p1, 0, pa2); PK4(p1, 8, pa3);
#undef PK4
}
__device__ __forceinline__ long tile_row(int b, int t) { return t < LCTX / KVBLK ? (long)(MLAT + b * LCTX + t * KVBLK) : (long)(b * SEQ + (t - LCTX / KVBLK) * KVBLK); }

__device__ __forceinline__ void attn_unit(int b, int h, int qb, unsigned short* QBm, const unsigned short* __restrict__ KBm, const unsigned short* __restrict__ VBm,
                                          const float* dnw, float lam, float negm, char* lds) {
  const int tid = threadIdx.x, wid = __builtin_amdgcn_readfirstlane(tid >> 6), lane = tid & 63, r32 = lane & 31, hi = lane >> 5, comp = wid >> 2, g = wid & 3;
  char* V_lds = lds; char* K_lds = lds + 2 * SHM_V;
  float* wsf = (float*)(lds + LDS_WS) + wid * 64;
  float l_reg = 0.f; f32x16 o[4] = {}; bf16x8 qr[4];
  const long qrow0 = (long)b * SEQ + qb * 128 + g * 32;
  const unsigned short* Qw = QBm + (qrow0 + r32) * 1024 + h * 128 + comp * 64 + hi * 8;
#pragma unroll
  for (int d0 = 0; d0 < 4; ++d0) qr[d0] = *reinterpret_cast<const bf16x8*>(Qw + d0 * 16);
  const int sr = tid >> 4, sc = (tid & 15) * 8, vst0 = v_st(sr, sc), vst1 = v_st(32 + sr, sc);
  const int vb0 = (int)(uintptr_t)V_lds + v_rd_base(lane);
  const unsigned short* Kh = KBm + h * 128 + sc; const unsigned short* Vh = VBm + h * 128 + sc;
  struct { bf16x8 vs0, vs1, ks0, ks1; } sr_[1];
#define SLOAD(i, t) do { const long _r = tile_row(b, (t)) + sr; sr_[i].vs0 = *reinterpret_cast<const bf16x8*>(Vh + _r * 1024); sr_[i].vs1 = *reinterpret_cast<const bf16x8*>(Vh + (_r + 32) * 1024); \
    sr_[i].ks0 = *reinterpret_cast<const bf16x8*>(Kh + _r * 1024); sr_[i].ks1 = *reinterpret_cast<const bf16x8*>(Kh + (_r + 32) * 1024); } while (0)
#define SWRITE(bb, i) do { *(bf16x8*)(V_lds + (bb) * SHM_V + vst0) = sr_[i].vs0; *(bf16x8*)(V_lds + (bb) * SHM_V + vst1) = sr_[i].vs1; const int kc = sc * 2; \
    *(bf16x8*)(K_lds + (bb) * SHM_K + KSWZ(sr, kc)) = sr_[i].ks0; *(bf16x8*)(K_lds + (bb) * SHM_K + KSWZ(32 + sr, kc)) = sr_[i].ks1; } while (0)
#define SWAIT() asm volatile("s_waitcnt vmcnt(0)" ::: "memory")
  f32x16 pA0, pA1, pB0, pB1; bf16x8 pa0, pa1, pa2, pa3; constexpr int NT = NTILES;
  constexpr int SE = 0, SO = 0;
  SLOAD(SE, 0); asm volatile("s_waitcnt vmcnt(0)" ::: "memory"); SWRITE(0, SE); __syncthreads();
  qkt(pA0, pA1, K_lds, qr, comp, r32, hi, negm); partialSM(pA0);
  SLOAD(SO, 1);
  SWAIT(); SWRITE(1, SO); __syncthreads();
  for (int j = 1; j + 1 < NT; j += 2) {
    SBAR(); qkt(pB0, pB1, K_lds + SHM_K, qr, comp, r32, hi, negm);
    finishSM(pA0, pA1, l_reg, pa0, pa1, pa2, pa3); SBAR();
    SLOAD(SE, j + 1); SBAR();
    pv_d0(o, vb0, pa0, pa1, pa2, pa3); partialSM(pB0);
    __syncthreads(); SWAIT(); SWRITE(0, SE);
    __syncthreads();
    SBAR(); qkt(pA0, pA1, K_lds, qr, comp, r32, hi, negm);
    finishSM(pB0, pB1, l_reg, pa0, pa1, pa2, pa3); SBAR();
    SLOAD(SO, j + 2); SBAR();
    pv_d0(o, vb0 + SHM_V, pa0, pa1, pa2, pa3); partialSM(pA0);
    __syncthreads(); SWAIT(); SWRITE(1, SO);
    __syncthreads();
  }
  SBAR(); qkt(pB0, pB1, K_lds + SHM_K, qr, comp, r32, hi, negm);
  finishSM(pA0, pA1, l_reg, pa0, pa1, pa2, pa3); SBAR();
  pv_d0(o, vb0, pa0, pa1, pa2, pa3); partialSM(pB0);
  finishSM(pB0, pB1, l_reg, pa0, pa1, pa2, pa3); SBAR();
  pv_d0(o, vb0 + SHM_V, pa0, pa1, pa2, pa3);
  asm volatile("s_waitcnt vmcnt(0)" ::: "memory");
  { auto rr = __builtin_amdgcn_permlane32_swap(__float_as_uint(l_reg), __float_as_uint(l_reg), false, false); l_reg = __uint_as_float(rr[0]) + __uint_as_float(rr[1]); }
  if (hi == 0) wsf[r32] = l_reg;
  asm volatile("s_waitcnt lgkmcnt(0)" ::: "memory");
  float rli[16];
#pragma unroll
  for (int r = 0; r < 16; ++r) rli[r] = __builtin_amdgcn_rcpf(wsf[crow(r, hi)]);
  __syncthreads();
  float* X = (float*)lds + g * 32 * 128;
  if (comp == 1) {
#pragma unroll
    for (int r = 0; r < 16; ++r) { const int row = crow(r, hi);
#pragma unroll
      for (int d0 = 0; d0 < 4; ++d0) X[row * 128 + d0 * 32 + r32] = o[d0][r] * rli[r] * lam; }
  }
  __syncthreads();
  if (comp == 0) {
    float ss[16];
#pragma unroll
    for (int r = 0; r < 16; ++r) { const int row = crow(r, hi); float s = 0.f;
#pragma unroll
      for (int d0 = 0; d0 < 4; ++d0) { const float v = o[d0][r] * rli[r] - X[row * 128 + d0 * 32 + r32]; o[d0][r] = v; s += v * v; }
      ss[r] = s; }
#pragma unroll
    for (int m = 1; m < 32; m <<= 1) {
#pragma unroll
      for (int r = 0; r < 16; ++r) ss[r] += __shfl_xor(ss[r], m);
    }
    float dw[4];
#pragma unroll
    for (int d0 = 0; d0 < 4; ++d0) dw[d0] = dnw[d0 * 32 + r32];
    unsigned short* Ow = QBm + qrow0 * 1024 + h * 128;
#pragma unroll
    for (int r = 0; r < 16; ++r) { const float rstd = 1.f / sqrtf(ss[r] * (1.f / 128.f) + EPS); const int row = crow(r, hi);
#pragma unroll
      for (int d0 = 0; d0 < 4; ++d0) Ow[(long)row * 1024 + d0 * 32 + r32] = (unsigned short)f2bf(o[d0][r] * rstd * dw[d0]); }
  }
  __syncthreads();
#undef SLOAD
#undef SWRITE
#undef SWAIT
}
#undef KSWZ
#undef SBAR
}

__global__ void __launch_bounds__(512, 2) hybrid_fwd(Args a) {
    extern __shared__ __attribute__((aligned(16))) unsigned char lds[];
    const int tid = threadIdx.x, lane = tid & 63, wave = __builtin_amdgcn_readfirstlane(tid >> 6);
    const int G = gridDim.x, bid = blockIdx.x;
    const int gw = bid * 8 + wave, NGW = G * 8;
    unsigned char* ws = a.ws;
    unsigned* ctl = (unsigned*)(ws + WS_CTL);
    volatile LAS unsigned* MISC = (volatile LAS unsigned*)((LAS unsigned char*)lds + MISC_OFF);
    for (int u = tid; u < (LDS_BYTES - 131072) / 4; u += 512) ((LAS unsigned*)((LAS unsigned char*)lds + 131072))[u] = 0u;
    __syncthreads();
    XcdBarrier bar = xcd_barrier_post(ctl + 4096, MISC + 8);

    float* MODP = (float*)(ws + WS_MODP); float* MOD = (float*)(ws + WS_MOD);
    bf16* W2T = (bf16*)(ws + WS_W2T); float* AB = (float*)(ws + WS_AB);
    bf16* QKV = (bf16*)(ws + WS_QKV); bf16* QB = (bf16*)(ws + WS_QB); bf16* KB = (bf16*)(ws + WS_KB); bf16* VB = (bf16*)(ws + WS_VB);
    bf16* MERGED = (bf16*)(ws + WS_MERGED); bf16* H2 = (bf16*)(ws + WS_H2); bf16* NA = (bf16*)(ws + WS_NA); bf16* T1 = (bf16*)(ws + WS_T1); bf16* GATES = (bf16*)(ws + WS_GATES);
    bf16* H = (bf16*)((unsigned char*)a.out + DO_H); bf16* W1T = (bf16*)((unsigned char*)a.out + DO_W1T);


#define THRASH() do { f32x4 _s = {0.f,0.f,0.f,0.f}; for (size_t _i = (size_t)bid * 512 + tid; _i < (size_t)MLAT * 1024 / 4; _i += (size_t)G * 512) { const f32x4 _v = ((const f32x4*)a.x)[_i]; _s += _v; } \
    ((f32x4*)(ws + WS_END))[(size_t)bid * 512 + tid] = _s; } while (0)
    {
        for (int u = bid; u < 48; u += G) {
            const int ks = u / 6, nb = u % 6, n = nb * 512 + tid;
            float s0 = 0.f, s1 = 0.f, s2 = 0.f;
            for (int k = ks * 128; k < ks * 128 + 128; ++k) {
                const float w = a.w_ada[(size_t)k * 3072 + n];
                s0 += silu_f(a.c[k]) * w; s1 += silu_f(a.c[1024 + k]) * w; s2 += silu_f(a.c_ctx[k]) * w;
            }
            MODP[(ks * 3 + 0) * 3072 + n] = s0; MODP[(ks * 3 + 1) * 3072 + n] = s1; MODP[(ks * 3 + 2) * 3072 + n] = s2;
        }
        LAS float* scr = (LAS float*)((LAS unsigned char*)lds + wave * 16384);
        constexpr int NB1 = N1 / 32, NB2 = N2ALL / 32, NIT = 16 * (NB1 + NB2);
        for (int it = gw; it < NIT; it += NGW) {
            const int kb = it & 15, nbi = it >> 4;
            if (nbi < NB1) { const int n0 = nbi * 32; transpose_item(a.w_in, IN_COLS, w1_src(n0), W1T, n0, kb * 64, scr, lane); }
            else { const int n0 = (nbi - NB1) * 32;
                if (n0 < 4096) transpose_item(a.w_in, IN_COLS, w2_src(n0), W2T, n0, kb * 64, scr, lane);
                else if (n0 < 5120) transpose_item(a.w_oa, 1024, n0 - 4096, W2T, n0, kb * 64, scr, lane);
                else if (n0 < 6144) transpose_item(a.w_ob, 1024, n0 - 5120, W2T, n0, kb * 64, scr, lane);
                else transpose_item(a.w_out, 1024, n0 - 6144, W2T, n0, kb * 64, scr, lane); }
        }
    }
    xcd_barrier(bar);

    {
        float* modl = (float*)lds;
        for (int i = tid; i < 9216; i += 512) { const int n = i % 3072; float s = a.b_ada[n];
#pragma unroll
            for (int ks = 0; ks < 8; ++ks) s += MODP[ks * 9216 + i];
            modl[i] = s; if (bid == 0) MOD[i] = s; }
        __syncthreads();
        for (int r = gw; r < MTOT; r += NGW) {
            const float* xr; int v;
            if (r < MLAT) { xr = a.x + (size_t)r * 1024; v = r / SEQ; } else { xr = a.ctx + (size_t)(r - MLAT) * 1024; v = 2; }
            f32x4 xv[4]; float ss = 0.f;
#pragma unroll
            for (int j = 0; j < 4; ++j) { xv[j] = ((const f32x4*)xr)[64 * j + lane]; ss += (xv[j].x * xv[j].x + xv[j].y * xv[j].y) + (xv[j].z * xv[j].z + xv[j].w * xv[j].w); }
            const float rstd = 1.f / sqrtf(wave_sum(ss) * (1.f / 1024.f) + EPS);
            const float* sh = modl + v * 3072; const float* sc = sh + 1024;
#pragma unroll
            for (int j = 0; j < 4; ++j) { const int c0 = (64 * j + lane) * 4;
                const float h0 = xv[j].x * rstd * (1.f + sc[c0]) + sh[c0], h1 = xv[j].y * rstd * (1.f + sc[c0 + 1]) + sh[c0 + 1];
                const float h2 = xv[j].z * rstd * (1.f + sc[c0 + 2]) + sh[c0 + 2], h3 = xv[j].w * rstd * (1.f + sc[c0 + 3]) + sh[c0 + 3];
                v2u o; o.x = pk2(h0, h1); o.y = pk2(h2, h3); *(v2u*)(H + (size_t)r * 1024 + c0) = o; }
        }
    }
    xcd_barrier(bar);


#if PG8_R1
    { pg8::Gemm g{H, W1T, MTOT, N1, 1024}; pg8::StaticOrder S; S.init(MTOT, N1, G, bid); pg8::EpiR1 e{QKV, QB, KB, VB, AB, MLAT / 256};
      pg8::gemm_phase<pg8::EpiR1, pg8::StaticOrder, true, true>((LAS unsigned char*)lds, g, S, e); }
#else
    { EpiR1 e{QKV, QB, KB, VB, AB}; gemm_naive(lds, H, W1T, MTOT, N1, 1024, e); }
#endif

    xcd_barrier(bar);

    {
        for (size_t i = (size_t)bid * 512 + tid; i < (size_t)MLAT * 1024 / 4; i += (size_t)G * 512) ((f32x4*)a.out)[i] = (f32x4){0.f, 0.f, 0.f, 0.f};
        for (int it = gw; it < MLAT + MTOT; it += NGW) {
            const bool isq = it < MLAT; const int r = isq ? it : it - MLAT;
            bf16* p = (isq ? QB : KB) + (size_t)r * 1024 + lane * 16;
            const float* gw_ = isq ? a.q_norm_w : a.k_norm_w;
            const v4u w0 = *(const v4u*)p, w1 = *(const v4u*)(p + 8);
            float v[16] = {bflo(w0.x), bfhi(w0.x), bflo(w0.y), bfhi(w0.y), bflo(w0.z), bfhi(w0.z), bflo(w0.w), bfhi(w0.w),
                           bflo(w1.x), bfhi(w1.x), bflo(w1.y), bfhi(w1.y), bflo(w1.z), bfhi(w1.z), bflo(w1.w), bfhi(w1.w)};
            float ss = 0.f;
#pragma unroll
            for (int i = 0; i < 16; ++i) ss += v[i] * v[i];
            ss += __shfl_xor(ss, 1); ss += __shfl_xor(ss, 2);
            const float rstd = 1.f / sqrtf(ss * (1.f / 64.f) + EPS);
            const int sub = lane & 3;
#pragma unroll
            for (int i = 0; i < 16; ++i) v[i] = v[i] * rstd * gw_[sub * 16 + i];
            if (r < MLAT) {
                const int t = r % SEQ; const float pos = (float)((sub < 2) ? (t >> 6) : (t & 63));
#pragma unroll
                for (int i = 0; i < 16; ++i) {
                    const float other = __shfl_xor(v[i], 1);
                    const float invf = exp2f(-(float)i * (13.287712379549449f / 16.f));
                    const float ang = pos * invf; const float cs = cosf(ang), sn = sinf(ang);
                    v[i] = (sub & 1) ? (v[i] * cs + other * sn) : (v[i] * cs - other * sn);
                }
            }
            const float sc = isq ? QSCALE : 1.f;
            v4u o0, o1; o0.x = pk2(v[0] * sc, v[1] * sc); o0.y = pk2(v[2] * sc, v[3] * sc); o0.z = pk2(v[4] * sc, v[5] * sc); o0.w = pk2(v[6] * sc, v[7] * sc);
            o1.x = pk2(v[8] * sc, v[9] * sc); o1.y = pk2(v[10] * sc, v[11] * sc); o1.z = pk2(v[12] * sc, v[13] * sc); o1.w = pk2(v[14] * sc, v[15] * sc);
            *(v4u*)p = o0; *(v4u*)(p + 8) = o1;
        }
    }
    xcd_barrier(bar);

    {
        for (int wu = gw; wu < 1024; wu += NGW) {
            const int chain = wu >> 5, sl = wu & 31; const int b = chain >> 4, h = (chain >> 1) & 7, d = chain & 1;
            const int g = lane >> 2, dv = sl * 4 + (lane & 3);
            const float Aexp = __expf(a.a_log[d * 8 + h]), dtb = a.dt_bias[d * 8 + h];
            float wq[5][8], wk[5][8], wv[5];
#pragma unroll
            for (int j = 0; j < 5; ++j) { wv[j] = a.conv_w[j * 3072 + 2048 + h * 128 + dv];
#pragma unroll
                for (int i = 0; i < 8; ++i) { wq[j][i] = a.conv_w[j * 3072 + h * 128 + g * 8 + i]; wk[j][i] = a.conv_w[j * 3072 + 1024 + h * 128 + g * 8 + i]; } }
            float S[8];
#pragma unroll
            for (int i = 0; i < 8; ++i) S[i] = 0.f;
            for (int seg = 0; seg < 2; ++seg) {
                const int Ls = seg == 0 ? LCTX : SEQ; const int r0 = seg == 0 ? MLAT + b * LCTX : b * SEQ;
                for (int step = 0; step < Ls; ++step) {
                    const int t = d ? (Ls - 1 - step) : step;
                    float q[8], k[8], v = 0.f;
#pragma unroll
                    for (int i = 0; i < 8; ++i) { q[i] = 0.f; k[i] = 0.f; }
#pragma unroll
                    for (int j = 0; j < 5; ++j) { const int tt = t + j - 2;
                        if (tt >= 0 && tt < Ls) { const bf16* rp = QKV + (size_t)(r0 + tt) * 3072 + h * 128;
                            const v4u qv = *(const v4u*)(rp + g * 8), kv = *(const v4u*)(rp + 1024 + g * 8);
                            v += bf2f(rp[2048 + dv]) * wv[j];
                            q[0] += bflo(qv.x) * wq[j][0]; q[1] += bfhi(qv.x) * wq[j][1]; q[2] += bflo(qv.y) * wq[j][2]; q[3] += bfhi(qv.y) * wq[j][3];
                            q[4] += bflo(qv.z) * wq[j][4]; q[5] += bfhi(qv.z) * wq[j][5]; q[6] += bflo(qv.w) * wq[j][6]; q[7] += bfhi(qv.w) * wq[j][7];
                            k[0] += bflo(kv.x) * wk[j][0]; k[1] += bfhi(kv.x) * wk[j][1]; k[2] += bflo(kv.y) * wk[j][2]; k[3] += bfhi(kv.y) * wk[j][3];
                            k[4] += bflo(kv.z) * wk[j][4]; k[5] += bfhi(kv.z) * wk[j][5]; k[6] += bflo(kv.w) * wk[j][6]; k[7] += bfhi(kv.w) * wk[j][7]; } }
                    v = silu_f(v); float sq = 0.f, sk = 0.f;
#pragma unroll
                    for (int i = 0; i < 8; ++i) { q[i] = silu_f(q[i]); k[i] = silu_f(k[i]); sq += q[i] * q[i]; sk += k[i] * k[i]; }
#pragma unroll
                    for (int o = 4; o < 64; o <<= 1) { sq += __shfl_xor(sq, o); sk += __shfl_xor(sk, o); }
                    const float rq = (1.f / sqrtf(sq + EPS)) * 0.08838834764831845f, rk = 1.f / sqrtf(sk + EPS);
                    const float araw = AB[(size_t)(r0 + t) * 32 + d * 8 + h], braw = AB[(size_t)(r0 + t) * 32 + 16 + d * 8 + h];
                    const float dec = __expf(-Aexp * softplus_f(araw + dtb)), beta = sigmoid_f(braw);
                    float kS = 0.f;
#pragma unroll
                    for (int i = 0; i < 8; ++i) { k[i] *= rk; S[i] *= dec; kS += k[i] * S[i]; }
#pragma unroll
                    for (int o = 4; o < 64; o <<= 1) kS += __shfl_xor(kS, o);
                    const float vn = beta * (v - kS); float oo = 0.f;
#pragma unroll
                    for (int i = 0; i < 8; ++i) { S[i] += k[i] * vn; oo += q[i] * rq * S[i]; }
#pragma unroll
                    for (int o = 4; o < 64; o <<= 1) oo += __shfl_xor(oo, o);
                    if (seg == 1 && lane < 4) atomicAdd(a.out + (size_t)(r0 + t) * 1024 + h * 128 + dv, oo);
                }
            }
        }
        __syncthreads();
        {
            float lam, negm;
            { float s1 = 0.f, s2 = 0.f, mq = 0.f, mk = 0.f; for (int i = 0; i < 64; ++i) { s1 += a.lq1[i] * a.lk1[i]; s2 += a.lq2[i] * a.lk2[i]; mq = fmaxf(mq, fabsf(a.q_norm_w[i])); mk = fmaxf(mk, fabsf(a.k_norm_w[i])); }
              lam = __expf(s1) - __expf(s2) + 0.2f; negm = -(8.f * mq * mk * 1.4426950408889634f); }
            const int vcu = (G % 8 == 0) ? (bid % 8) * (G / 8) + bid / 8 : bid;
            for (int unit = vcu; unit < 1024; unit += G) {
                const int i4 = unit / G, v = unit % G; const int idx = (G == 256) ? (v * 4 + i4) : unit; const int pair = idx / 64, qb = idx % 64;
                att::attn_unit(pair >> 3, pair & 7, qb, QB, KB, VB, a.diff_norm_w, lam, negm, (char*)lds);
            }
        }
    }
    xcd_barrier(bar);

    {
        for (int r = gw; r < MLAT; r += NGW) {
            const float* xr = a.x + (size_t)r * 1024; const int v = r / SEQ;
            f32x4 xv[4]; float ss = 0.f;
#pragma unroll
            for (int j = 0; j < 4; ++j) { xv[j] = ((const f32x4*)xr)[64 * j + lane]; ss += (xv[j].x * xv[j].x + xv[j].y * xv[j].y) + (xv[j].z * xv[j].z + xv[j].w * xv[j].w); }
            const float rstd = 1.f / sqrtf(wave_sum(ss) * (1.f / 1024.f) + EPS);
            const float* sh = MOD + v * 3072; const float* sc = sh + 1024;
#pragma unroll
            for (int j = 0; j < 4; ++j) { const int c0 = (64 * j + lane) * 4;
                const float h0 = xv[j].x * rstd * (1.f + sc[c0]) + sh[c0], h1 = xv[j].y * rstd * (1.f + sc[c0 + 1]) + sh[c0 + 1];
                const float h2 = xv[j].z * rstd * (1.f + sc[c0 + 2]) + sh[c0 + 2], h3 = xv[j].w * rstd * (1.f + sc[c0 + 3]) + sh[c0 + 3];
                v2u o; o.x = pk2(h0, h1); o.y = pk2(h2, h3); *(v2u*)(H2 + (size_t)r * 1024 + c0) = o; }
            const float* orow = a.out + (size_t)r * 1024 + lane * 16;
            f32x4 ov[4]; float s2 = 0.f;
#pragma unroll
            for (int j = 0; j < 4; ++j) { ov[j] = ((const f32x4*)orow)[j]; s2 += (ov[j].x * ov[j].x + ov[j].y * ov[j].y) + (ov[j].z * ov[j].z + ov[j].w * ov[j].w); }
            s2 += __shfl_xor(s2, 1); s2 += __shfl_xor(s2, 2); s2 += __shfl_xor(s2, 4);
            const float r2 = 1.f / sqrtf(s2 * (1.f / 128.f) + EPS);
            const float* gwp = a.gdn_norm_w + (lane & 7) * 16;
            v4u o0, o1;
            o0.x = pk2(ov[0].x * r2 * gwp[0], ov[0].y * r2 * gwp[1]); o0.y = pk2(ov[0].z * r2 * gwp[2], ov[0].w * r2 * gwp[3]);
            o0.z = pk2(ov[1].x * r2 * gwp[4], ov[1].y * r2 * gwp[5]); o0.w = pk2(ov[1].z * r2 * gwp[6], ov[1].w * r2 * gwp[7]);
            o1.x = pk2(ov[2].x * r2 * gwp[8], ov[2].y * r2 * gwp[9]); o1.y = pk2(ov[2].z * r2 * gwp[10], ov[2].w * r2 * gwp[11]);
            o1.z = pk2(ov[3].x * r2 * gwp[12], ov[3].y * r2 * gwp[13]); o1.w = pk2(ov[3].z * r2 * gwp[14], ov[3].w * r2 * gwp[15]);
            *(v4u*)(NA + (size_t)r * 1024 + lane * 16) = o0; *(v4u*)(NA + (size_t)r * 1024 + lane * 16 + 8) = o1;
        }
    }
    xcd_barrier(bar);


#if PG8_R2
    { pg8::Gemm g{H2, W2T, MLAT, 4096, 1024}; pg8::StaticOrder S; S.init(MLAT, 4096, G, bid); pg8::EpiR2 e{NA, QB, GATES, NA, QB};
      pg8::gemm_phase<pg8::EpiR2, pg8::StaticOrder, true, true>((LAS unsigned char*)lds, g, S, e); }
#else
    { EpiR2 e{NA, QB, GATES}; gemm_naive(lds, H2, W2T, MLAT, 4096, 1024, e); }
#endif
    xcd_barrier(bar);


#if PG8_F1
    { pg8::Gemm g{NA, W2T + (size_t)4096 * 1024, MLAT, 1024, 1024}; pg8::StaticOrder S; S.init(MLAT, 1024, G, bid); pg8::EpiF e{T1, T1, GATES, 0};
      pg8::gemm_phase<pg8::EpiF, pg8::StaticOrder, true, true>((LAS unsigned char*)lds, g, S, e); }
#else
    { EpiF1 e{T1, GATES}; gemm_naive(lds, NA, W2T + (size_t)4096 * 1024, MLAT, 1024, 1024, e); }
#endif


#if PG8_F2
    { pg8::Gemm g{QB, W2T + (size_t)5120 * 1024, MLAT, 1024, 1024}; pg8::StaticOrder S; S.init(MLAT, 1024, G, bid); pg8::EpiF e{MERGED, T1, GATES, 1};
      pg8::gemm_phase<pg8::EpiF, pg8::StaticOrder, true, true>((LAS unsigned char*)lds, g, S, e); }
#else
    { EpiF2 e{MERGED, T1, GATES}; gemm_naive(lds, QB, W2T + (size_t)5120 * 1024, MLAT, 1024, 1024, e); }
#endif

    xcd_barrier(bar);


#if PG8_G
    { pg8::Gemm g{MERGED, W2T + (size_t)6144 * 1024, MLAT, 1024, 1024}; pg8::StaticOrder S; S.init(MLAT, 1024, G, bid); pg8::EpiG e{a.out, a.x, MOD, SEQ / 256};
      pg8::gemm_phase<pg8::EpiG, pg8::StaticOrder, true, true>((LAS unsigned char*)lds, g, S, e); }
#else
    { EpiG e{a.out, a.x, MOD}; gemm_naive(lds, MERGED, W2T + (size_t)6144 * 1024, MLAT, 1024, 1024, e); }
#endif

}

extern "C" void kernel_launch(void* const* d_in, const int* in_sizes, int n_in, void* d_out, int out_size, void* d_ws, size_t ws_size, hipStream_t stream) {
    static int grid = 0;
    if (grid == 0) {
        if (n_in != 21 || in_sizes[0] != MLAT * DM || out_size != MLAT * DM || ws_size < WS_END) { fprintf(stderr, "kernel_launch: unexpected shapes n_in %d in0 %d out %d ws %zu\n", n_in, n_in > 0 ? in_sizes[0] : -1, out_size, ws_size); grid = -1; return; }
        int dev = 0, cus = 0, per_cu = 0;
        if (hipGetDevice(&dev) != hipSuccess || hipDeviceGetAttribute(&cus, hipDeviceAttributeMultiprocessorCount, dev) != hipSuccess) { grid = -1; return; }
        if (hipFuncSetAttribute((const void*)hybrid_fwd, hipFuncAttributeMaxDynamicSharedMemorySize, LDS_BYTES) != hipSuccess) { fprintf(stderr, "kernel_launch: hipFuncSetAttribute failed\n"); grid = -1; return; }
        if (hipOccupancyMaxActiveBlocksPerMultiprocessor(&per_cu, (const void*)hybrid_fwd, 512, LDS_BYTES) != hipSuccess || per_cu < 1) { fprintf(stderr, "kernel_launch: occupancy query says %d\n", per_cu); per_cu = 1; }
        (void)hipGetLastError();
        grid = cus;
    }
    if (grid < 0) return;
    (void)hipMemsetAsync((char*)d_ws + WS_CTL, 0, CTL_BYTES, stream);
    Args a{};
    a.x = (const float*)d_in[0]; a.c = (const float*)d_in[1]; a.ctx = (const float*)d_in[2]; a.c_ctx = (const float*)d_in[3]; a.w_ada = (const float*)d_in[4]; a.b_ada = (const float*)d_in[5];
    a.w_in = (const float*)d_in[6]; a.conv_w = (const float*)d_in[7]; a.a_log = (const float*)d_in[8]; a.dt_bias = (const float*)d_in[9]; a.gdn_norm_w = (const float*)d_in[10];
    a.q_norm_w = (const float*)d_in[11]; a.k_norm_w = (const float*)d_in[12]; a.lq1 = (const float*)d_in[13]; a.lk1 = (const float*)d_in[14]; a.lq2 = (const float*)d_in[15]; a.lk2 = (const float*)d_in[16];
    a.diff_norm_w = (const float*)d_in[17]; a.w_oa = (const float*)d_in[18]; a.w_ob = (const float*)d_in[19]; a.w_out = (const float*)d_in[20];
    a.out = (float*)d_out; a.ws = (unsigned char*)d_ws;
    hipLaunchKernelGGL(hybrid_fwd, dim3(grid), dim3(512), LDS_BYTES, stream, a);
    const hipError_t le = hipPeekAtLastError();
    if (le != hipSuccess) fprintf(stderr, "kernel_launch: launch failed: %s\n", hipGetErrorName(le));
}
```

```cpp
#include <hip/hip_runtime.h>
#include <cstdio>
#include <cstdint>
#define PG8_R1 1
#define PG8_R2 1
#define PG8_F1 1
#define PG8_F2 1
#define PG8_G 1
#define GDN_NAIVE 0
#define DIAG_IDX 0
#define R2_SKIP_Z 0

#define GAS __attribute__((address_space(1)))
#define LAS __attribute__((address_space(3)))
typedef unsigned short bf16;
typedef unsigned v4u __attribute__((ext_vector_type(4)));
typedef unsigned v2u __attribute__((ext_vector_type(2)));
typedef float f32x4 __attribute__((ext_vector_type(4)));

constexpr int NB = 2, SEQ = 8192, DM = 1024, LCTX = 256, NH = 8;
constexpr int MLAT = NB * SEQ, MCTX = NB * LCTX, MTOT = MLAT + MCTX;
constexpr int IN_COLS = 10272;
constexpr int N1 = 6400, N2ALL = 7168;
constexpr float EPS = 1e-6f;
constexpr float QSCALE = 0.125f * 1.4426950408889634f;

constexpr size_t MiB = 1u << 20;
constexpr size_t WS_CTL = 0, CTL_BYTES = 1 * MiB;
constexpr size_t WS_MODP = 1 * MiB;
constexpr size_t WS_MOD = 2 * MiB;
constexpr size_t WS_W2T = 3 * MiB;
constexpr size_t WS_AB = 17 * MiB;
constexpr size_t WS_T = 20 * MiB;
constexpr size_t WS_QKV = 53 * MiB;
constexpr size_t WS_QB = 152 * MiB;
constexpr size_t WS_KB = 184 * MiB;
constexpr size_t WS_VB = 217 * MiB;
constexpr size_t WS_END = 250 * MiB;
constexpr size_t WS_MERGED = 20 * MiB;
constexpr size_t WS_H2 = 53 * MiB;
constexpr size_t WS_NA = 85 * MiB;
constexpr size_t WS_T1 = 117 * MiB;
constexpr size_t WS_GATES = 184 * MiB;
constexpr size_t DO_H = 0;
constexpr size_t DO_W1T = 33 * MiB;

constexpr int LDS_BYTES = 163840;
constexpr int MISC_OFF = 163840 - 256;

__device__ __forceinline__ unsigned f2bf(float f) { unsigned u = __builtin_bit_cast(unsigned, f); return (u + 0x7fffu + ((u >> 16) & 1u)) >> 16; }
__device__ __forceinline__ unsigned pk2(float lo, float hi) { return f2bf(lo) | (f2bf(hi) << 16); }
__device__ __forceinline__ float bf2f(unsigned short h) { return __builtin_bit_cast(float, (unsigned)h << 16); }
__device__ __forceinline__ float bflo(unsigned w) { return __builtin_bit_cast(float, w << 16); }
__device__ __forceinline__ float bfhi(unsigned w) { return __builtin_bit_cast(float, w & 0xffff0000u); }
__device__ __forceinline__ float silu_f(float x) { return x / (1.f + __expf(-x)); }
__device__ __forceinline__ float sigmoid_f(float x) { return 1.f / (1.f + __expf(-x)); }
__device__ __forceinline__ float softplus_f(float x) { return fmaxf(x, 0.f) + log1pf(__expf(-fabsf(x))); }

#define XB_TMO      128
#define XB_XCNT(j)  (256  + 64 * (j))
#define XB_XSUB(j)  (1280 + 64 * (j))
#define XB_XGEN(j)  (2304 + 64 * (j))
#define XB_TOP      3328
#define XB_TOPGEN   3392
#define XCD_BAR_WORDS 3456
#define XB_SPIN_CAP (1u << 22)
__device__ __forceinline__ unsigned xb_ld(unsigned* p)              { return __hip_atomic_load(p, __ATOMIC_RELAXED, __HIP_MEMORY_SCOPE_AGENT); }
__device__ __forceinline__ unsigned xb_add(unsigned* p, unsigned v) { return __hip_atomic_fetch_add(p, v, __ATOMIC_RELAXED, __HIP_MEMORY_SCOPE_AGENT); }
__device__ __forceinline__ unsigned xb_xcc_id() { return (unsigned)__builtin_amdgcn_s_getreg((3 << 11) | 20) & 0xFu; }
#define XB_SPIN(cond, bar) do { unsigned _sp = 0; while (cond) { __builtin_amdgcn_s_sleep(1); \
    if ((++_sp & 255u) == 0u) { if (xb_ld(&(bar)[XB_TMO])) break; if (_sp > XB_SPIN_CAP) { atomicAdd(&(bar)[XB_TMO], 1u); break; } } } } while (0)
struct XcdBarrier { unsigned* bar; unsigned x; volatile LAS unsigned* st; };
__device__ __forceinline__ XcdBarrier xcd_barrier_post(unsigned* bar, volatile LAS unsigned* st) {
    XcdBarrier b; b.bar = bar; b.x = xb_xcc_id(); b.st = st;
    if (threadIdx.x == 0) (void)xb_add(&bar[XB_XCNT(b.x)], 1u);
    return b;
}
__device__ __forceinline__ void xcd_barrier_complete(unsigned* bar, unsigned x, unsigned& nloc, unsigned& nx) {
    const unsigned G = gridDim.x * gridDim.y * gridDim.z;
    unsigned sum, cnt, mine, sp = 0u;
    for (;;) {
        sum = 0u; cnt = 0u; mine = 0u;
#pragma unroll
        for (unsigned j = 0; j < 16; ++j) { const unsigned c = xb_ld(&bar[XB_XCNT(j)]); sum += c; cnt += (c > 0u) ? 1u : 0u; mine = (j == x) ? c : mine; }
        if (sum == G) break;
        __builtin_amdgcn_s_sleep(1);
        if ((++sp & 255u) == 0u) { if (xb_ld(&bar[XB_TMO])) break; if (sp > XB_SPIN_CAP) { atomicAdd(&bar[XB_TMO], 1u); break; } }
    }
    nloc = mine > 0u ? mine : 1u; nx = cnt > 0u ? cnt : 1u;
}
__device__ __forceinline__ void xcd_barrier(const XcdBarrier& b) {
    asm volatile("s_waitcnt vmcnt(0)" ::: "memory");
    __syncthreads();
    if (threadIdx.x == 0) {
        unsigned* bar = b.bar;
        __builtin_amdgcn_s_waitcnt(0);
        unsigned nloc = b.st[0], nx = b.st[1];
        if (nloc == 0u) { xcd_barrier_complete(bar, b.x, nloc, nx); b.st[0] = nloc; b.st[1] = nx; }
        const unsigned old = xb_add(&bar[XB_XSUB(b.x)], 1u);
        const unsigned gen = old / nloc;
        if (old + 1u == (gen + 1u) * nloc) {
            __builtin_amdgcn_fence(__ATOMIC_RELEASE, "agent");
            asm volatile("s_waitcnt vmcnt(0)" ::: "memory");
            const unsigned og = xb_add(&bar[XB_TOP], 1u);
            const unsigned tg = og / nx;
            if (og + 1u == (tg + 1u) * nx) xb_add(&bar[XB_TOPGEN], 1u);
            else XB_SPIN(xb_ld(&bar[XB_TOPGEN]) == tg, bar);
            __builtin_amdgcn_fence(__ATOMIC_ACQUIRE, "agent");
            xb_add(&bar[XB_XGEN(b.x)], 1u);
            asm volatile("s_waitcnt vmcnt(0)" ::: "memory");
        } else {
            XB_SPIN(xb_ld(&bar[XB_XGEN(b.x)]) == gen, bar);
            __builtin_amdgcn_fence(__ATOMIC_ACQUIRE, "agent");
            asm volatile("s_waitcnt vmcnt(0)" ::: "memory");
        }
    }
    __syncthreads();
    __builtin_amdgcn_fence(__ATOMIC_ACQUIRE, "agent");
    asm volatile("s_waitcnt vmcnt(0)" ::: "memory");
}

struct Args {
    const float* x; const float* c; const float* ctx; const float* c_ctx; const float* w_ada; const float* b_ada; const float* w_in; const float* conv_w;
    const float* a_log; const float* dt_bias; const float* gdn_norm_w; const float* q_norm_w; const float* k_norm_w;
    const float* lq1; const float* lk1; const float* lq2; const float* lk2; const float* diff_norm_w; const float* w_oa; const float* w_ob; const float* w_out;
    float* out; unsigned char* ws;
};

__device__ __forceinline__ float wave_sum(float v) {
#pragma unroll
    for (int o = 1; o < 64; o <<= 1) v += __shfl_xor(v, o);
    return v;
}

__device__ __forceinline__ int w1_src(int n) { if (n < 3072) return n; if (n < 4096) return 4128 + (n - 3072); if (n < 5120) return 5152 + (n - 4096); if (n < 6144) return 6176 + (n - 5120);
    if (n < 6176) return 4096 + (n - 6144); return -1; }
__device__ __forceinline__ int w2_src(int n) { if (n < 1024) return 3072 + n; if (n < 2048) return 7200 + (n - 1024); return 8224 + (n - 2048); }
__device__ __forceinline__ void transpose_item(const float* W, int ldw, int c0, bf16* WT, int n0, int k0, LAS float* scr, int lane) {
#pragma unroll 8
    for (int i = 0; i < 32; ++i) { const int kk = 2 * i + (lane >> 5); scr[kk * 33 + (lane & 31)] = (c0 >= 0) ? W[(size_t)(k0 + kk) * ldw + c0 + (lane & 31)] : 0.f; }
    asm volatile("s_waitcnt lgkmcnt(0)" ::: "memory");
    const int c = lane & 7;
#pragma unroll
    for (int j = 0; j < 4; ++j) { const int n = (lane >> 3) + 8 * j; const LAS float* s = scr + (8 * c) * 33 + n;
        v4u o; o.x = pk2(s[0 * 33], s[1 * 33]); o.y = pk2(s[2 * 33], s[3 * 33]); o.z = pk2(s[4 * 33], s[5 * 33]); o.w = pk2(s[6 * 33], s[7 * 33]);
        *(v4u*)(WT + (size_t)(n0 + n) * 1024 + k0 + 8 * c) = o; }
    asm volatile("s_waitcnt lgkmcnt(0)" ::: "memory");
}

template <class Epi>
__device__ __forceinline__ void gemm_naive(unsigned char* ldsg, const bf16* A, const bf16* Bt, int M, int N, int K, const Epi& epi) {
    float* As = (float*)ldsg; float* Bs = As + 32 * 132;
    const int tid = threadIdx.x, ty = tid >> 4, tx = tid & 15;
    const int nM = M / 128, nN = N / 128;
    for (int unit = blockIdx.x; unit < nM * nN; unit += gridDim.x) {
        const int pm = unit / nN, pn = unit % nN;
        float acc[4][8];
#pragma unroll
        for (int i = 0; i < 4; ++i)
#pragma unroll
            for (int j = 0; j < 8; ++j) acc[i][j] = 0.f;
        const int srow = tid >> 2, skc = (tid & 3) * 8;
        for (int k0 = 0; k0 < K; k0 += 32) {
            const v4u av = *(const v4u*)(A + (size_t)(pm * 128 + srow) * K + k0 + skc);
            const v4u bv = *(const v4u*)(Bt + (size_t)(pn * 128 + srow) * K + k0 + skc);
            As[(skc + 0) * 132 + srow] = bflo(av.x); As[(skc + 1) * 132 + srow] = bfhi(av.x); As[(skc + 2) * 132 + srow] = bflo(av.y); As[(skc + 3) * 132 + srow] = bfhi(av.y);
            As[(skc + 4) * 132 + srow] = bflo(av.z); As[(skc + 5) * 132 + srow] = bfhi(av.z); As[(skc + 6) * 132 + srow] = bflo(av.w); As[(skc + 7) * 132 + srow] = bfhi(av.w);
            Bs[(skc + 0) * 132 + srow] = bflo(bv.x); Bs[(skc + 1) * 132 + srow] = bfhi(bv.x); Bs[(skc + 2) * 132 + srow] = bflo(bv.y); Bs[(skc + 3) * 132 + srow] = bfhi(bv.y);
            Bs[(skc + 4) * 132 + srow] = bflo(bv.z); Bs[(skc + 5) * 132 + srow] = bfhi(bv.z); Bs[(skc + 6) * 132 + srow] = bflo(bv.w); Bs[(skc + 7) * 132 + srow] = bfhi(bv.w);
            __syncthreads();
#pragma unroll 8
            for (int kk = 0; kk < 32; ++kk) {
                const f32x4 a = *(const f32x4*)(As + kk * 132 + ty * 4);
                const f32x4 b0 = *(const f32x4*)(Bs + kk * 132 + tx * 8), b1 = *(const f32x4*)(Bs + kk * 132 + tx * 8 + 4);
#pragma unroll
                for (int i = 0; i < 4; ++i) { acc[i][0] += a[i] * b0[0]; acc[i][1] += a[i] * b0[1]; acc[i][2] += a[i] * b0[2]; acc[i][3] += a[i] * b0[3];
                    acc[i][4] += a[i] * b1[0]; acc[i][5] += a[i] * b1[1]; acc[i][6] += a[i] * b1[2]; acc[i][7] += a[i] * b1[3]; }
            }
            __syncthreads();
        }
#pragma unroll
        for (int i = 0; i < 4; ++i)
#pragma unroll
            for (int j = 0; j < 8; ++j) epi(pm * 128 + ty * 4 + i, pn * 128 + tx * 8 + j, acc[i][j]);
    }
}

struct EpiR1 { bf16* QKV; bf16* QB; bf16* KB; bf16* VB; float* AB;
    __device__ __forceinline__ void operator()(int r, int c, float v) const {
        if (c < 3072) QKV[(size_t)r * 3072 + c] = (bf16)f2bf(v);
        else if (c < 4096) { if (r < MLAT) QB[(size_t)r * 1024 + (c - 3072)] = (bf16)f2bf(v); }
        else if (c < 5120) KB[(size_t)r * 1024 + (c - 4096)] = (bf16)f2bf(v);
        else if (c < 6144) VB[(size_t)r * 1024 + (c - 5120)] = (bf16)f2bf(v);
        else if (c < 6176) AB[(size_t)r * 32 + (c - 6144)] = v;
    } };
struct EpiR2 { bf16* NA; bf16* QB; bf16* GATES;
    __device__ __forceinline__ void operator()(int r, int c, float v) const {
        if (c < 1024) { bf16* p = NA + (size_t)r * 1024 + c; *p = (bf16)f2bf(silu_f(v) * bf2f(*p)); }
        else if (c < 2048) { bf16* p = QB + (size_t)r * 1024 + (c - 1024); *p = (bf16)f2bf(0.8f * silu_f(v) * bf2f(*p)); }
        else GATES[(size_t)r * 2048 + (c - 2048)] = (bf16)f2bf(sigmoid_f(v));
    } };
struct EpiR2Chk { bf16* NA; bf16* QB; bf16* GATES; const bf16* YA2; const bf16* YB2; unsigned* cnt;
    __device__ __forceinline__ void operator()(int r, int c, float v) const {
        float ref, got;
        if (c < 1024) { bf16* p = NA + (size_t)r * 1024 + c; ref = silu_f(v) * bf2f(YA2[(size_t)r * 1024 + c]); got = bf2f(*p); *p = (bf16)f2bf(ref); if (fabsf(ref - got) > 0.02f * fabsf(ref) + 0.01f) atomicAdd(cnt + 0, 1u); }
        else if (c < 2048) { bf16* p = QB + (size_t)r * 1024 + (c - 1024); ref = 0.8f * silu_f(v) * bf2f(YB2[(size_t)r * 1024 + (c - 1024)]); got = bf2f(*p); *p = (bf16)f2bf(ref); if (fabsf(ref - got) > 0.02f * fabsf(ref) + 0.01f) atomicAdd(cnt + 1, 1u); }
        else { bf16* p = GATES + (size_t)r * 2048 + (c - 2048); ref = sigmoid_f(v); got = bf2f(*p); *p = (bf16)f2bf(ref); if (fabsf(ref - got) > 0.02f) atomicAdd(cnt + 2, 1u); }
    } };
struct EpiF1 { bf16* T1; const bf16* GATES;
    __device__ __forceinline__ void operator()(int r, int c, float v) const { T1[(size_t)r * 1024 + c] = (bf16)f2bf(v * bf2f(GATES[(size_t)r * 2048 + c])); } };
struct EpiF2 { bf16* MERGED; const bf16* T1; const bf16* GATES;
    __device__ __forceinline__ void operator()(int r, int c, float v) const { MERGED[(size_t)r * 1024 + c] = (bf16)f2bf(bf2f(T1[(size_t)r * 1024 + c]) + v * bf2f(GATES[(size_t)r * 2048 + 1024 + c])); } };
struct EpiG { float* out; const float* x; const float* mod;
    __device__ __forceinline__ void operator()(int r, int c, float v) const { const int b = r / SEQ; out[(size_t)r * 1024 + c] = x[(size_t)r * 1024 + c] + mod[b * 3072 + 2048 + c] * v; } };

namespace pg8 {
#define PG8_LAS __attribute__((address_space(3)))
typedef unsigned short bf16_t;
typedef short bf16x8 __attribute__((ext_vector_type(8)));
typedef float f32x4 __attribute__((ext_vector_type(4)));
typedef unsigned u32x4 __attribute__((ext_vector_type(4)));
constexpr int BM = 256, BK = 64, HALF = 128, HTB = HALF * BK * 2  , STAGE_BYTES = 8 * HTB, NXCD = 8, WGM = 8;

__host__ __device__ __forceinline__ int lds_byte(int r, int c) { const int st = (r >> 4) * 2 + (c >> 5), rr = r & 15, cc = c & 31, ob = rr * 64 + cc * 2; return st * 1024 + (ob ^ (((ob >> 9) & 1) << 5)); }
__host__ __device__ __forceinline__ void stage_rc(int b, int& R, int& C) { const int st = b / 1024, sb = b % 1024, swz = sb ^ (((sb >> 9) & 1) << 5); R = (st >> 1) * 16 + swz / 64; C = (st & 1) * 32 + (swz % 64) / 2; }
__host__ __device__ __forceinline__ int perm32(int rho) { const int n = rho >> 4, i = rho & 15; return 8 * (i >> 2) + 4 * n + (i & 3); }

struct Unit { int pm, pn; };
struct Gemm { const bf16_t* A; const bf16_t* Bt; int M, N, K; };

struct StaticOrder {
    int nM, nN, nwg, G, c;
    __host__ __device__ void init(int M, int N, int G_, int c_) { nM = M / BM; nN = N / BM; nwg = nM * nN; G = G_; c = c_; }
    __host__ __device__ bool next(int i, Unit& u) const {
        const long L = (long)i * G + c; if (L >= nwg) return false;
        int wgid = (int)L; { const int q = nwg / NXCD, r = nwg % NXCD, xcd = wgid % NXCD, off = wgid / NXCD; wgid = (xcd < r ? xcd * (q + 1) : r * (q + 1) + (xcd - r) * q) + off; }
        const int nig = WGM * nN, gid = wgid / nig, fm = gid * WGM, gsz = (nM - fm) < WGM ? (nM - fm) : WGM;
        u.pm = fm + ((wgid % nig) % gsz); u.pn = (wgid % nig) / gsz; return true;
    }
    __device__ __forceinline__ void a_ready(const Unit&) const {}
    __device__ __forceinline__ void done(const Unit&) const {}
};

__device__ __forceinline__ unsigned cvt_pk_bf16(float lo, float hi) { unsigned r; asm volatile("v_cvt_pk_bf16_f32 %0, %1, %2" : "=v"(r) : "v"(lo), "v"(hi)); return r; }
__device__ __forceinline__ float silu_e(float x) { return x * __builtin_amdgcn_rcpf(1.f + __expf(-x)); }
__device__ __forceinline__ float sigm_e(float x) { return __builtin_amdgcn_rcpf(1.f + __expf(-x)); }
__device__ __forceinline__ float blo(unsigned w) { return __builtin_bit_cast(float, w << 16); }
__device__ __forceinline__ float bhi(unsigned w) { return __builtin_bit_cast(float, w & 0xffff0000u); }
__device__ __forceinline__ u32x4 pack8(const f32x4 v0, const f32x4 v1) { u32x4 w; w.x = cvt_pk_bf16(v0[0], v0[1]); w.y = cvt_pk_bf16(v0[2], v0[3]); w.z = cvt_pk_bf16(v1[0], v1[1]); w.w = cvt_pk_bf16(v1[2], v1[3]); return w; }
struct EpiR1 {
    static constexpr bool PERM = true, AFTER_DRAIN = false;
    bf16_t* QKV; bf16_t* QB; bf16_t* KB; bf16_t* VB; float* AB; int mlat_tiles;
    __device__ __forceinline__ void operator()(const f32x4 (&acc)[2][2][4][2], const Unit& u, int wr, int wc, int fr, int fq) const {
        const int row0 = u.pm * BM + wr * 64 + fr, cl = wc * 32 + 8 * fq;
        bf16_t* base; int ldc, colt;
        if (u.pn < 12) { base = QKV; ldc = 3072; colt = u.pn * 256; }
        else if (u.pn < 16) { if (u.pm >= mlat_tiles) return; base = QB; ldc = 1024; colt = (u.pn - 12) * 256; }
        else if (u.pn < 20) { base = KB; ldc = 1024; colt = (u.pn - 16) * 256; }
        else if (u.pn < 24) { base = VB; ldc = 1024; colt = (u.pn - 20) * 256; }
        else {
            if (wc == 0) {
#pragma unroll
                for (int ai = 0; ai < 2; ++ai)
#pragma unroll
                    for (int m = 0; m < 4; ++m) { float* p = AB + (size_t)(row0 + ai * HALF + m * 16) * 32 + 8 * fq; *(f32x4*)p = acc[ai][0][m][0]; *(f32x4*)(p + 4) = acc[ai][0][m][1]; }
            }
            return;
        }
#pragma unroll
        for (int ai = 0; ai < 2; ++ai)
#pragma unroll
            for (int m = 0; m < 4; ++m) { bf16_t* rowp = base + (size_t)(row0 + ai * HALF + m * 16) * ldc + colt + cl;
#pragma unroll
                for (int bj = 0; bj < 2; ++bj) *(u32x4*)(rowp + bj * HALF) = pack8(acc[ai][bj][m][0], acc[ai][bj][m][1]); }
    }
};
struct EpiR2 {
    static constexpr bool PERM = true, AFTER_DRAIN = false;
    bf16_t* NA; bf16_t* QB; bf16_t* GATES; bf16_t* YA2; bf16_t* YB2;
    __device__ __forceinline__ void operator()(const f32x4 (&acc)[2][2][4][2], const Unit& u, int wr, int wc, int fr, int fq) const {
        const int row0 = u.pm * BM + wr * 64 + fr, cl = wc * 32 + 8 * fq;
        if (u.pn >= 8) {
            const int colt = (u.pn - 8) * 256;
#pragma unroll
            for (int ai = 0; ai < 2; ++ai)
#pragma unroll
                for (int m = 0; m < 4; ++m) { bf16_t* rowp = GATES + (size_t)(row0 + ai * HALF + m * 16) * 2048 + colt + cl;
#pragma unroll
                    for (int bj = 0; bj < 2; ++bj) { f32x4 v0 = acc[ai][bj][m][0], v1 = acc[ai][bj][m][1];
#pragma unroll
                        for (int i = 0; i < 4; ++i) { v0[i] = sigm_e(v0[i]); v1[i] = sigm_e(v1[i]); }
                        *(u32x4*)(rowp + bj * HALF) = pack8(v0, v1); } }
            return;
        }
        if (R2_SKIP_Z) return;
        bf16_t* base = (u.pn < 4) ? NA : QB; bf16_t* dst = (u.pn < 4) ? YA2 : YB2; const float sc = (u.pn < 4) ? 1.0f : 0.8f; const int colt = (u.pn & 3) * 256;
#pragma unroll
        for (int ai = 0; ai < 2; ++ai)
#pragma unroll
            for (int m = 0; m < 4; ++m) { bf16_t* rowp = base + (size_t)(row0 + ai * HALF + m * 16) * 1024 + colt + cl; bf16_t* rowd = dst + (size_t)(row0 + ai * HALF + m * 16) * 1024 + colt + cl;
#pragma unroll
                for (int bj = 0; bj < 2; ++bj) { const u32x4 old = *(const u32x4*)(rowp + bj * HALF); f32x4 v0 = acc[ai][bj][m][0], v1 = acc[ai][bj][m][1];
                    v0[0] = silu_e(v0[0]) * sc * blo(old.x); v0[1] = silu_e(v0[1]) * sc * bhi(old.x); v0[2] = silu_e(v0[2]) * sc * blo(old.y); v0[3] = silu_e(v0[3]) * sc * bhi(old.y);
                    v1[0] = silu_e(v1[0]) * sc * blo(old.z); v1[1] = silu_e(v1[1]) * sc * bhi(old.z); v1[2] = silu_e(v1[2]) * sc * blo(old.w); v1[3] = silu_e(v1[3]) * sc * bhi(old.w);
                    *(u32x4*)(rowd + bj * HALF) = pack8(v0, v1); } }
    }
};
struct EpiF {
    static constexpr bool PERM = true, AFTER_DRAIN = false;
    bf16_t* OUT; const bf16_t* T1; const bf16_t* GATES; int mode;
    __device__ __forceinline__ void operator()(const f32x4 (&acc)[2][2][4][2], const Unit& u, int wr, int wc, int fr, int fq) const {
        const int row0 = u.pm * BM + wr * 64 + fr, col0 = u.pn * BM + wc * 32 + 8 * fq;
#pragma unroll
        for (int ai = 0; ai < 2; ++ai)
#pragma unroll
            for (int m = 0; m < 4; ++m) { const size_t r = (size_t)(row0 + ai * HALF + m * 16);
#pragma unroll
                for (int bj = 0; bj < 2; ++bj) { const int c = col0 + bj * HALF;
                    const u32x4 g = *(const u32x4*)(GATES + r * 2048 + mode * 1024 + c); f32x4 v0 = acc[ai][bj][m][0], v1 = acc[ai][bj][m][1];
                    v0[0] *= blo(g.x); v0[1] *= bhi(g.x); v0[2] *= blo(g.y); v0[3] *= bhi(g.y); v1[0] *= blo(g.z); v1[1] *= bhi(g.z); v1[2] *= blo(g.w); v1[3] *= bhi(g.w);
                    if (mode) { const u32x4 t = *(const u32x4*)(T1 + r * 1024 + c);
                        v0[0] += blo(t.x); v0[1] += bhi(t.x); v0[2] += blo(t.y); v0[3] += bhi(t.y); v1[0] += blo(t.z); v1[1] += bhi(t.z); v1[2] += blo(t.w); v1[3] += bhi(t.w); }
                    *(u32x4*)(OUT + r * 1024 + c) = pack8(v0, v1); } }
    }
};
struct EpiG {
    static constexpr bool PERM = true, AFTER_DRAIN = false;
    float* out; const float* x; const float* mod; int tiles_per_batch;
    __device__ __forceinline__ void operator()(const f32x4 (&acc)[2][2][4][2], const Unit& u, int wr, int wc, int fr, int fq) const {
        const int row0 = u.pm * BM + wr * 64 + fr, col0 = u.pn * BM + wc * 32 + 8 * fq; const int b = u.pm / tiles_per_batch;
        f32x4 gv[2][2];
#pragma unroll
        for (int bj = 0; bj < 2; ++bj) { gv[bj][0] = *(const f32x4*)(mod + b * 3072 + 2048 + col0 + bj * HALF); gv[bj][1] = *(const f32x4*)(mod + b * 3072 + 2048 + col0 + bj * HALF + 4); }
#pragma unroll
        for (int ai = 0; ai < 2; ++ai)
#pragma unroll
            for (int m = 0; m < 4; ++m) { const size_t off = (size_t)(row0 + ai * HALF + m * 16) * 1024 + col0;
#pragma unroll
                for (int bj = 0; bj < 2; ++bj) { const f32x4 x0 = *(const f32x4*)(x + off + bj * HALF), x1 = *(const f32x4*)(x + off + bj * HALF + 4);
                    *(f32x4*)(out + off + bj * HALF) = x0 + gv[bj][0] * acc[ai][bj][m][0]; *(f32x4*)(out + off + bj * HALF + 4) = x1 + gv[bj][1] * acc[ai][bj][m][1]; } }
    }
};
template <class Epi, class Sched, bool ALIGN_EPI = false, bool SP2 = false>
__device__ __forceinline__ void gemm_phase(PG8_LAS unsigned char* lds, const Gemm g, const Sched& S, const Epi& E) {
    const int tid = threadIdx.x, wid = __builtin_amdgcn_readfirstlane(tid >> 6), lane = tid & 63, wr = wid >> 2, wc = wid & 3, fr = lane & 15, fq = lane >> 4;
    const int K = g.K, nt = K / BK;
    unsigned voffA[2], voffB[2];
#pragma unroll
    for (int i = 0; i < 2; ++i) { int R, C; stage_rc(tid * 16 + i * 8192, R, C); const int Rb = Epi::PERM ? ((R & ~31) + perm32(R & 31)) : R;
        voffA[i] = (unsigned)(R * K + C) * 2u; voffB[i] = (unsigned)(Rb * K + C) * 2u; }
    const size_t kstep = (size_t)(BK * 2);
    const size_t hstep = (size_t)HALF * K * 2;
    const size_t tstep = 2 * hstep;
    const unsigned ldsw = (unsigned)wid * 1024u;
    const int aoff = lds_byte(wr * 64 + fr, fq * 8), boff = lds_byte(wc * 32 + fr, fq * 8);
#define PG8_SA(b, h) (((b) * 2 + (h)) * HTB)
#define PG8_SB(b, h) ((4 + (b) * 2 + (h)) * HTB)
#define PG8_STAGE(bufoff, gbase, voff) do { _Pragma("unroll") for (int _i = 0; _i < 2; ++_i) \
        __builtin_amdgcn_global_load_lds((const unsigned*)((const char*)(gbase) + (voff)[_i]), (PG8_LAS unsigned*)(lds + (bufoff) + ldsw + _i * 8192), 16, 0, 0); } while (0)
#define PG8_LDA(dst, b, h) do { _Pragma("unroll") for (int m = 0; m < 4; ++m) _Pragma("unroll") for (int k = 0; k < 2; ++k) dst[m][k] = *(const PG8_LAS bf16x8*)(lds + PG8_SA(b, h) + aoff + m * 2048 + k * 1024); } while (0)
#define PG8_LDB(dst, b, h) do { _Pragma("unroll") for (int n = 0; n < 2; ++n) _Pragma("unroll") for (int k = 0; k < 2; ++k) dst[n][k] = *(const PG8_LAS bf16x8*)(lds + PG8_SB(b, h) + boff + n * 2048 + k * 1024); } while (0)
#define PG8_MMA(ai, bj, At, Bt) do { __builtin_amdgcn_s_setprio(1); _Pragma("unroll") for (int m = 0; m < 4; ++m) _Pragma("unroll") for (int n = 0; n < 2; ++n) _Pragma("unroll") for (int k = 0; k < 2; ++k) \
        acc[ai][bj][m][n] = __builtin_amdgcn_mfma_f32_16x16x32_bf16(Bt[n][k], At[m][k], acc[ai][bj][m][n], 0, 0, 0); __builtin_amdgcn_s_setprio(0); } while (0)
#define PG8_WAIT_V(n) asm volatile("s_waitcnt vmcnt(" #n ")" ::: "memory")
#define PG8_WAIT_L(n) asm volatile("s_waitcnt lgkmcnt(" #n ")" ::: "memory")
#define PG8_BAR __builtin_amdgcn_s_barrier()
#define PG8_SCHED __builtin_amdgcn_sched_barrier(0)
    Unit cur, nxt; int ui = 0;
    if (!S.next(0, cur)) return;
    f32x4 acc[2][2][4][2];
#pragma unroll
    for (int a = 0; a < 2; ++a)
#pragma unroll
        for (int b = 0; b < 2; ++b)
#pragma unroll
            for (int m = 0; m < 4; ++m)
#pragma unroll
                for (int n = 0; n < 2; ++n) acc[a][b][m][n] = (f32x4){0.f, 0.f, 0.f, 0.f};
    bf16x8 At[4][2], B0[2][2], B1[2][2];
    const char* cA = (const char*)g.A + (size_t)cur.pm * tstep; const char* cB = (const char*)g.Bt + (size_t)cur.pn * tstep;
    S.a_ready(cur);
    if constexpr (SP2) {
        PG8_STAGE(PG8_SB(0, 0), cB, voffB); PG8_STAGE(PG8_SB(0, 1), cB + hstep, voffB); PG8_STAGE(PG8_SA(0, 0), cA, voffA); PG8_STAGE(PG8_SA(0, 1), cA + hstep, voffA);
        if (wr == 1) PG8_BAR;
        PG8_WAIT_V(2); PG8_BAR;
        PG8_STAGE(PG8_SB(1, 0), cB + kstep, voffB); PG8_STAGE(PG8_SA(1, 0), cA + kstep, voffA); PG8_STAGE(PG8_SB(1, 1), cB + hstep + kstep, voffB);
        PG8_WAIT_V(6); PG8_BAR;
    } else {
        PG8_STAGE(PG8_SB(0, 0), cB, voffB); PG8_STAGE(PG8_SA(0, 0), cA, voffA); PG8_STAGE(PG8_SB(0, 1), cB + hstep, voffB); PG8_STAGE(PG8_SA(0, 1), cA + hstep, voffA);
        if (wr == 1) PG8_BAR;
        PG8_WAIT_V(4); PG8_BAR;
        PG8_STAGE(PG8_SB(1, 0), cB + kstep, voffB); PG8_STAGE(PG8_SA(1, 0), cA + kstep, voffA); PG8_STAGE(PG8_SB(1, 1), cB + hstep + kstep, voffB);
        PG8_WAIT_V(6); PG8_BAR;
    }
    for (;;) {
        const bool has_next = S.next(ui + 1, nxt);
        const char* nA = has_next ? (const char*)g.A + (size_t)nxt.pm * tstep : cA; const char* nB = has_next ? (const char*)g.Bt + (size_t)nxt.pn * tstep : cB;
        for (int t = 0; t < nt; t += 2) {
            const bool last = (t == nt - 2);
            const char* a1 = cA + (size_t)(t + 1) * kstep;
            const char* a2 = last ? nA : cA + (size_t)(t + 2) * kstep; const char* b2 = last ? nB : cB + (size_t)(t + 2) * kstep;
            const char* a3 = a2 + kstep; const char* b3 = b2 + kstep;
            if (last && has_next) S.a_ready(nxt);
            if constexpr (SP2) {
            PG8_LDB(B0, 0, 0); PG8_LDB(B1, 0, 1); PG8_SCHED; PG8_LDA(At, 0, 0); PG8_STAGE(PG8_SA(1, 1), a1 + hstep, voffA);
            PG8_WAIT_V(8); PG8_WAIT_L(0); PG8_BAR; PG8_MMA(0, 0, At, B0); PG8_MMA(0, 1, At, B1); PG8_BAR; PG8_SCHED;
            PG8_LDA(At, 0, 1); PG8_STAGE(PG8_SB(0, 0), b2, voffB); PG8_STAGE(PG8_SB(0, 1), b2 + hstep, voffB); PG8_STAGE(PG8_SA(0, 0), a2, voffA);
            PG8_WAIT_V(8); PG8_WAIT_L(0); PG8_BAR; PG8_MMA(1, 0, At, B0); PG8_MMA(1, 1, At, B1); PG8_BAR; PG8_SCHED;
            PG8_LDB(B0, 1, 0); PG8_LDB(B1, 1, 1); PG8_SCHED; PG8_LDA(At, 1, 0); PG8_STAGE(PG8_SA(0, 1), a2 + hstep, voffA);
            PG8_WAIT_V(8); PG8_WAIT_L(0); PG8_BAR; PG8_MMA(0, 0, At, B0); PG8_MMA(0, 1, At, B1); PG8_BAR; PG8_SCHED;
            PG8_LDA(At, 1, 1); PG8_STAGE(PG8_SB(1, 0), b3, voffB); PG8_STAGE(PG8_SB(1, 1), b3 + hstep, voffB); PG8_STAGE(PG8_SA(1, 0), a3, voffA);
            PG8_WAIT_V(8); PG8_WAIT_L(0); PG8_BAR; PG8_MMA(1, 0, At, B0); PG8_MMA(1, 1, At, B1); PG8_BAR; PG8_SCHED;
            } else {
            PG8_LDB(B0, 0, 0); PG8_SCHED; PG8_LDA(At, 0, 0); PG8_STAGE(PG8_SA(1, 1), a1 + hstep, voffA);
            PG8_WAIT_L(8); PG8_BAR; PG8_WAIT_L(0); PG8_MMA(0, 0, At, B0); PG8_BAR; PG8_SCHED;
            PG8_LDB(B1, 0, 1); PG8_STAGE(PG8_SB(0, 0), b2, voffB);
            PG8_BAR; PG8_WAIT_L(0); PG8_MMA(0, 1, At, B1); PG8_BAR;
            PG8_LDA(At, 0, 1); PG8_STAGE(PG8_SA(0, 0), a2, voffA);
            PG8_BAR; PG8_WAIT_L(0); PG8_MMA(1, 0, At, B0); PG8_BAR; PG8_SCHED;
            PG8_STAGE(PG8_SB(0, 1), b2 + hstep, voffB);
            PG8_WAIT_V(6); PG8_BAR; PG8_MMA(1, 1, At, B1); PG8_BAR;
            PG8_LDB(B0, 1, 0); PG8_SCHED; PG8_LDA(At, 1, 0); PG8_STAGE(PG8_SA(0, 1), a2 + hstep, voffA);
            PG8_WAIT_L(8); PG8_BAR; PG8_WAIT_L(0); PG8_MMA(0, 0, At, B0); PG8_BAR; PG8_SCHED;
            PG8_LDB(B1, 1, 1); PG8_STAGE(PG8_SB(1, 0), b3, voffB);
            PG8_BAR; PG8_WAIT_L(0); PG8_MMA(0, 1, At, B1); PG8_BAR;
            PG8_LDA(At, 1, 1); PG8_STAGE(PG8_SA(1, 0), a3, voffA);
            PG8_BAR; PG8_WAIT_L(0); PG8_MMA(1, 0, At, B0); PG8_BAR; PG8_SCHED;
            PG8_STAGE(PG8_SB(1, 1), b3 + hstep, voffB);
            PG8_WAIT_V(6); PG8_BAR; PG8_MMA(1, 1, At, B1); PG8_BAR;
            }
        }
        if constexpr (ALIGN_EPI) { if (wr == 0) PG8_BAR; }
        if constexpr (!Epi::AFTER_DRAIN) { E(acc, cur, wr, wc, fr, fq); S.done(cur); }
        if (!has_next) break;
#pragma unroll
        for (int a = 0; a < 2; ++a)
#pragma unroll
            for (int b = 0; b < 2; ++b)
#pragma unroll
                for (int m = 0; m < 4; ++m)
#pragma unroll
                    for (int n = 0; n < 2; ++n) acc[a][b][m][n] = (f32x4){0.f, 0.f, 0.f, 0.f};
        cur = nxt; cA = nA; cB = nB; ++ui;
        if constexpr (ALIGN_EPI) { if (wr == 1) PG8_BAR; }
    }
    PG8_WAIT_V(0);
    if constexpr (!ALIGN_EPI) { if (wr == 0) PG8_BAR; }
    PG8_BAR;
    if constexpr (Epi::AFTER_DRAIN) { E.fused(acc, cur, wr, wc, fr, fq, lds, wid, lane); S.done(cur); }
#undef PG8_SA
#undef PG8_SB
#undef PG8_STAGE
#undef PG8_LDA
#undef PG8_LDB
#undef PG8_MMA
#undef PG8_WAIT_V
#undef PG8_WAIT_L
#undef PG8_BAR
#undef PG8_SCHED
}
}

namespace att {
using bf16x8 = __attribute__((ext_vector_type(8))) short;
using s16x4  = __attribute__((ext_vector_type(4))) short;
using f32x16 = __attribute__((ext_vector_type(16))) float;
using u32x4  = __attribute__((ext_vector_type(4))) unsigned;
constexpr int KVBLK = 64, NTILES = (LCTX + SEQ) / KVBLK;
constexpr int SHM_V = KVBLK * 128 * 2, SHM_K = KVBLK * 128 * 2;
constexpr int LDS_WS = 2 * SHM_V + 2 * SHM_K;
#define KSWZ(row, colB) ((row) * 256 + ((colB) ^ (((row) & 7) << 4)))
#define SBAR() __builtin_amdgcn_sched_barrier(0)
__device__ __forceinline__ int crow(int r, int hi) { return (r & 3) + 8 * (r >> 2) + 4 * hi; }
__device__ __forceinline__ unsigned cvtpk(float lo, float hi) { unsigned r; asm volatile("v_cvt_pk_bf16_f32 %0, %1, %2" : "=v"(r) : "v"(lo), "v"(hi)); return r; }
__device__ __forceinline__ int v_st(int k, int c) { const int kk = (k & ~0xC) | ((k & 4) << 1) | ((k & 8) >> 1); return ((kk >> 3) * 4 + (c >> 5)) * 512 + ((kk & 7) * 32 + (c & 31)) * 2; }
__device__ __forceinline__ int v_rd_base(int lane) { return ((lane & 3) << 3) | (((lane >> 2) & 3) << 6) | (((lane >> 4) & 1) << 5) | (((lane >> 5) & 1) << 8); }
constexpr int v_rd_off(int d0, int ks, int half) { return d0 * 512 + ks * 4096 + half * 2048; }
template <int OFF> __device__ __forceinline__ s16x4 tr_read(int vb) { s16x4 r; asm volatile("ds_read_b64_tr_b16 %0, %1 offset:%2" : "=&v"(r) : "v"(vb), "i"(OFF) : "memory"); return r; }
template <int D0> __device__ __forceinline__ void pv_one(f32x16& od, int vb, bf16x8 pa0, bf16x8 pa1, bf16x8 pa2, bf16x8 pa3) {
  const s16x4 l0 = tr_read<v_rd_off(D0, 0, 0)>(vb), h0 = tr_read<v_rd_off(D0, 0, 1)>(vb), l1 = tr_read<v_rd_off(D0, 1, 0)>(vb), h1 = tr_read<v_rd_off(D0, 1, 1)>(vb);
  const s16x4 l2 = tr_read<v_rd_off(D0, 2, 0)>(vb), h2 = tr_read<v_rd_off(D0, 2, 1)>(vb), l3 = tr_read<v_rd_off(D0, 3, 0)>(vb), h3 = tr_read<v_rd_off(D0, 3, 1)>(vb);
  asm volatile("s_waitcnt lgkmcnt(0)" ::: "memory"); SBAR();
#define PK(L, H) (bf16x8){L[0], L[1], L[2], L[3], H[0], H[1], H[2], H[3]}
  od = __builtin_amdgcn_mfma_f32_32x32x16_bf16(pa0, PK(l0, h0), od, 0, 0, 0);
  od = __builtin_amdgcn_mfma_f32_32x32x16_bf16(pa1, PK(l1, h1), od, 0, 0, 0);
  od = __builtin_amdgcn_mfma_f32_32x32x16_bf16(pa2, PK(l2, h2), od, 0, 0, 0);
  od = __builtin_amdgcn_mfma_f32_32x32x16_bf16(pa3, PK(l3, h3), od, 0, 0, 0);
#undef PK
}
__device__ __forceinline__ void pv_d0(f32x16* o, int vb, bf16x8 pa0, bf16x8 pa1, bf16x8 pa2, bf16x8 pa3) {
  pv_one<0>(o[0], vb, pa0, pa1, pa2, pa3); pv_one<1>(o[1], vb, pa0, pa1, pa2, pa3); pv_one<2>(o[2], vb, pa0, pa1, pa2, pa3); pv_one<3>(o[3], vb, pa0, pa1, pa2, pa3);
}
__device__ __forceinline__ void qkt(f32x16& p0, f32x16& p1, const char* Ks, const bf16x8* qr, int comp, int r32, int hi, float negm) {
#pragma unroll
  for (int r = 0; r < 16; ++r) { p0[r] = negm; p1[r] = negm; }
#pragma unroll
  for (int d0 = 0; d0 < 4; ++d0) { const int cb = ((comp * 4 + d0) * 16 + hi * 8) * 2;
    const bf16x8 b0 = *reinterpret_cast<const bf16x8*>(Ks + KSWZ(r32, cb));
    const bf16x8 b1 = *reinterpret_cast<const bf16x8*>(Ks + KSWZ(32 + r32, cb));
    p0 = __builtin_amdgcn_mfma_f32_32x32x16_bf16(b0, qr[d0], p0, 0, 0, 0);
    p1 = __builtin_amdgcn_mfma_f32_32x32x16_bf16(b1, qr[d0], p1, 0, 0, 0); }
}
__device__ __forceinline__ void partialSM(f32x16& p0) {
#pragma unroll
  for (int r = 0; r < 16; ++r) p0[r] = __builtin_amdgcn_exp2f(p0[r]);
}
__device__ __forceinline__ void finishSM(f32x16& p0, f32x16& p1, float& l_reg, bf16x8& pa0, bf16x8& pa1, bf16x8& pa2, bf16x8& pa3) {
#pragma unroll
  for (int r = 0; r < 16; ++r) p1[r] = __builtin_amdgcn_exp2f(p1[r]);
  float ps = 0.f;
#pragma unroll
  for (int r = 0; r < 16; ++r) ps += p0[r];
#pragma unroll
  for (int r = 0; r < 16; ++r) ps += p1[r];
  l_reg += ps;
#define PK4(P, BASE, OUT) do { unsigned a0 = cvtpk(P[BASE + 0], P[BASE + 1]), a1 = cvtpk(P[BASE + 2], P[BASE + 3]);   \
    unsigned b0 = cvtpk(P[BASE + 4], P[BASE + 5]), b1 = cvtpk(P[BASE + 6], P[BASE + 7]);                              \
    auto r0 = __builtin_amdgcn_permlane32_swap(a0, b0, false, false); auto r1 = __builtin_amdgcn_permlane32_swap(a1, b1, false, false); \
    u32x4 w = {r0[0], r1[0], r0[1], r1[1]}; OUT = *reinterpret_cast<bf16x8*>(&w); } while (0)
  PK4(p0, 0, pa0); PK4(p0, 8, pa1); PK4(p1, 0, pa2); PK4(p1, 8, pa3);
#undef PK4
}
__device__ __forceinline__ long tile_row(int b, int t) { return t < LCTX / KVBLK ? (long)(MLAT + b * LCTX + t * KVBLK) : (long)(b * SEQ + (t - LCTX / KVBLK) * KVBLK); }

__device__ __forceinline__ void attn_unit(int b, int h, int qb, unsigned short* QBm, const unsigned short* __restrict__ KBm, const unsigned short* __restrict__ VBm,
                                          const float* dnw, float lam, float negm, char* lds) {
  const int tid = threadIdx.x, wid = __builtin_amdgcn_readfirstlane(tid >> 6), lane = tid & 63, r32 = lane & 31, hi = lane >> 5, comp = wid >> 2, g = wid & 3;
  char* V_lds = lds; char* K_lds = lds + 2 * SHM_V;
  float* wsf = (float*)(lds + LDS_WS) + wid * 64;
  float l_reg = 0.f; f32x16 o[4] = {}; bf16x8 qr[4];
  const long qrow0 = (long)b * SEQ + qb * 128 + g * 32;
  const unsigned short* Qw = QBm + (qrow0 + r32) * 1024 + h * 128 + comp * 64 + hi * 8;
#pragma unroll
  for (int d0 = 0; d0 < 4; ++d0) qr[d0] = *reinterpret_cast<const bf16x8*>(Qw + d0 * 16);
  const int sr = tid >> 4, sc = (tid & 15) * 8, vst0 = v_st(sr, sc), vst1 = v_st(32 + sr, sc);
  const int vb0 = (int)(uintptr_t)V_lds + v_rd_base(lane);
  const unsigned short* Kh = KBm + h * 128 + sc; const unsigned short* Vh = VBm + h * 128 + sc;
  struct { bf16x8 vs0, vs1, ks0, ks1; } sr_[1];
#define SLOAD(i, t) do { const long _r = tile_row(b, (t)) + sr; sr_[i].vs0 = *reinterpret_cast<const bf16x8*>(Vh + _r * 1024); sr_[i].vs1 = *reinterpret_cast<const bf16x8*>(Vh + (_r + 32) * 1024); \
    sr_[i].ks0 = *reinterpret_cast<const bf16x8*>(Kh + _r * 1024); sr_[i].ks1 = *reinterpret_cast<const bf16x8*>(Kh + (_r + 32) * 1024); } while (0)
#define SWRITE(bb, i) do { *(bf16x8*)(V_lds + (bb) * SHM_V + vst0) = sr_[i].vs0; *(bf16x8*)(V_lds + (bb) * SHM_V + vst1) = sr_[i].vs1; const int kc = sc * 2; \
    *(bf16x8*)(K_lds + (bb) * SHM_K + KSWZ(sr, kc)) = sr_[i].ks0; *(bf16x8*)(K_lds + (bb) * SHM_K + KSWZ(32 + sr, kc)) = sr_[i].ks1; } while (0)
#define SWAIT() asm volatile("s_waitcnt vmcnt(0)" ::: "memory")
  f32x16 pA0, pA1, pB0, pB1; bf16x8 pa0, pa1, pa2, pa3; constexpr int NT = NTILES;
  constexpr int SE = 0, SO = 0;
  SLOAD(SE, 0); asm volatile("s_waitcnt vmcnt(0)" ::: "memory"); SWRITE(0, SE); __syncthreads();
  qkt(pA0, pA1, K_lds, qr, comp, r32, hi, negm); partialSM(pA0);
  SLOAD(SO, 1);
  SWAIT(); SWRITE(1, SO); __syncthreads();
  for (int j = 1; j + 1 < NT; j += 2) {
    SBAR(); qkt(pB0, pB1, K_lds + SHM_K, qr, comp, r32, hi, negm);
    finishSM(pA0, pA1, l_reg, pa0, pa1, pa2, pa3); SBAR();
    SLOAD(SE, j + 1); SBAR();
    pv_d0(o, vb0, pa0, pa1, pa2, pa3); partialSM(pB0);
    __syncthreads(); SWAIT(); SWRITE(0, SE);
    __syncthreads();
    SBAR(); qkt(pA0, pA1, K_lds, qr, comp, r32, hi, negm);
    finishSM(pB0, pB1, l_reg, pa0, pa1, pa2, pa3); SBAR();
    SLOAD(SO, j + 2); SBAR();
    pv_d0(o, vb0 + SHM_V, pa0, pa1, pa2, pa3); partialSM(pA0);
    __syncthreads(); SWAIT(); SWRITE(1, SO);
    __syncthreads();
  }
  SBAR(); qkt(pB0, pB1, K_lds + SHM_K, qr, comp, r32, hi, negm);
  finishSM(pA0, pA1, l_reg, pa0, pa1, pa2, pa3); SBAR();
  pv_d0(o, vb0, pa0, pa1, pa2, pa3); partialSM(pB0);
  finishSM(pB0, pB1, l_reg, pa0, pa1, pa2, pa3); SBAR();
  pv_d0(o, vb0 + SHM_V, pa0, pa1, pa2, pa3);
  asm volatile("s_waitcnt vmcnt(0)" ::: "memory");
  { auto rr = __builtin_amdgcn_permlane32_swap(__float_as_uint(l_reg), __float_as_uint(l_reg), false, false); l_reg = __uint_as_float(rr[0]) + __uint_as_float(rr[1]); }
  if (hi == 0) wsf[r32] = l_reg;
  asm volatile("s_waitcnt lgkmcnt(0)" ::: "memory");
  float rli[16];
#pragma unroll
  for (int r = 0; r < 16; ++r) rli[r] = __builtin_amdgcn_rcpf(wsf[crow(r, hi)]);
  __syncthreads();
  float* X = (float*)lds + g * 32 * 128;
  if (comp == 1) {
#pragma unroll
    for (int r = 0; r < 16; ++r) { const int row = crow(r, hi);
#pragma unroll
      for (int d0 = 0; d0 < 4; ++d0) X[row * 128 + d0 * 32 + r32] = o[d0][r] * rli[r] * lam; }
  }
  __syncthreads();
  if (comp == 0) {
    float ss[16];
#pragma unroll
    for (int r = 0; r < 16; ++r) { const int row = crow(r, hi); float s = 0.f;
#pragma unroll
      for (int d0 = 0; d0 < 4; ++d0) { const float v = o[d0][r] * rli[r] - X[row * 128 + d0 * 32 + r32]; o[d0][r] = v; s += v * v; }
      ss[r] = s; }
#pragma unroll
    for (int m = 1; m < 32; m <<= 1) {
#pragma unroll
      for (int r = 0; r < 16; ++r) ss[r] += __shfl_xor(ss[r], m);
    }
    float dw[4];
#pragma unroll
    for (int d0 = 0; d0 < 4; ++d0) dw[d0] = dnw[d0 * 32 + r32];
    unsigned short* Ow = QBm + qrow0 * 1024 + h * 128;
#pragma unroll
    for (int r = 0; r < 16; ++r) { const float rstd = 1.f / sqrtf(ss[r] * (1.f / 128.f) + EPS); const int row = crow(r, hi);
#pragma unroll
      for (int d0 = 0; d0 < 4; ++d0) Ow[(long)row * 1024 + d0 * 32 + r32] = (unsigned short)f2bf(o[d0][r] * rstd * dw[d0]); }
  }
  __syncthreads();
#undef SLOAD
#undef SWRITE
#undef SWAIT
}
#undef KSWZ
#undef SBAR
}

namespace gdn {
using bf16x8 = __attribute__((ext_vector_type(8))) short;
using f32x16 = __attribute__((ext_vector_type(16))) float;
using u32x4  = __attribute__((ext_vector_type(4))) unsigned;
using u32x2  = __attribute__((ext_vector_type(2))) unsigned;
constexpr int LK = 136, LT = 72;
constexpr int L_KBN = 0, L_QD = 17408, L_KDT = 34816, L_QK = 53248, L_VB = 62464, L_SBF = 79872, L_RBF = 114688, L_VNBF = 133120, L_SM = 151552, L_END = 152832;
constexpr int NSTEP = (LCTX + SEQ) / 64;
__device__ __forceinline__ int crow(int r, int hi) { return (r & 3) + 8 * (r >> 2) + 4 * hi; }
__device__ __forceinline__ f32x16 mma(bf16x8 a, bf16x8 b, f32x16 c) { return __builtin_amdgcn_mfma_f32_32x32x16_bf16(a, b, c, 0, 0, 0); }
#define GFRAG(base, ld, tile, ks) (*(const bf16x8*)((base) + ((32 * (tile) + r32) * (ld) + 16 * (ks) + 8 * hi) * 2))

__device__ __forceinline__ void conv8(float (&acc)[8][8], const unsigned short* src, const float* w, int t0, int Ls) {
    float wv[5][8];
#pragma unroll
    for (int j = 0; j < 5; ++j) { const f32x4 a = *(const f32x4*)(w + j * 3072), b = *(const f32x4*)(w + j * 3072 + 4);
        wv[j][0] = a[0]; wv[j][1] = a[1]; wv[j][2] = a[2]; wv[j][3] = a[3]; wv[j][4] = b[0]; wv[j][5] = b[1]; wv[j][6] = b[2]; wv[j][7] = b[3]; }
#pragma unroll
    for (int tt = 0; tt < 8; ++tt)
#pragma unroll
        for (int i = 0; i < 8; ++i) acc[tt][i] = 0.f;
#pragma unroll
    for (int rr = 0; rr < 12; ++rr) {
        const int t = t0 - 2 + rr;
        v4u xv = {0u, 0u, 0u, 0u};
        if (t >= 0 && t < Ls) xv = *(const v4u*)(src + (size_t)t * 3072);
        const float x[8] = {bflo(xv.x), bfhi(xv.x), bflo(xv.y), bfhi(xv.y), bflo(xv.z), bfhi(xv.z), bflo(xv.w), bfhi(xv.w)};
#pragma unroll
        for (int tt = 0; tt < 8; ++tt) { const int j = rr - tt;
            if (j >= 0 && j <= 4) {
#pragma unroll
                for (int i = 0; i < 8; ++i) acc[tt][i] += x[i] * wv[j][i]; } }
        if ((rr & 3) == 3) __builtin_amdgcn_sched_barrier(0);
    }
#pragma unroll
    for (int tt = 0; tt < 8; ++tt)
#pragma unroll
        for (int i = 0; i < 8; ++i) acc[tt][i] = silu_f(acc[tt][i]);
}
__device__ __forceinline__ void l2scale8(float (&acc)[8][8], float mul) {
#pragma unroll
    for (int tt = 0; tt < 8; ++tt) { float s = 0.f;
#pragma unroll
        for (int i = 0; i < 8; ++i) s += acc[tt][i] * acc[tt][i];
        s += __shfl_xor(s, 1); s += __shfl_xor(s, 2); s += __shfl_xor(s, 4); s += __shfl_xor(s, 8);
        const float rs = mul / sqrtf(s + EPS);
#pragma unroll
        for (int i = 0; i < 8; ++i) acc[tt][i] *= rs; }
}
__device__ __forceinline__ u32x4 pack8s(const float (&v)[8], float s) { u32x4 w; w.x = pk2(v[0] * s, v[1] * s); w.y = pk2(v[2] * s, v[3] * s); w.z = pk2(v[4] * s, v[5] * s); w.w = pk2(v[6] * s, v[7] * s); return w; }

__device__ __forceinline__ void gates_wave(float* sm, const float* AB, long r0, int c0, int d, int h, float Aexp, float dtb, int lane) {
    const int t = d ? (c0 + 63 - lane) : (c0 + lane);
    const float araw = AB[(r0 + t) * 32 + d * 8 + h], braw = AB[(r0 + t) * 32 + 16 + d * 8 + h];
    float gc = -Aexp * softplus_f(araw + dtb); const float beta = sigmoid_f(braw);
#pragma unroll
    for (int o = 1; o < 64; o <<= 1) { const float u = __shfl_up(gc, o); if (lane >= o) gc += u; }
    const float g63 = __shfl(gc, 63);
    sm[lane] = gc; sm[64 + lane] = beta; sm[128 + lane] = __expf(gc); sm[192 + lane] = __expf(g63 - gc);
    if (lane == 0) sm[256] = __expf(g63);
}

__device__ __forceinline__ void t_unit(int b, int h, int seg, int cidx, const unsigned short* QKV, const float* AB, const float* conv_w, const float* a_log, const float* dt_bias,
                                       unsigned short* Tbuf, char* lds) {
    const int tid = threadIdx.x, lane = tid & 63, wid = __builtin_amdgcn_readfirstlane(tid >> 6), r32 = lane & 31, hi = lane >> 5;
    const int Ls = seg ? SEQ : LCTX, nch = Ls / 64, c0 = cidx * 64; const long r0 = seg ? (long)b * SEQ : (long)MLAT + b * LCTX;
    char* Kn = lds; float* KK = (float*)(lds + 17408); float* Ap = (float*)(lds + 33792); float* sm = (float*)(lds + 66560);
    if (tid < 128) {
        const int co = tid & 15, tg = tid >> 4; float acc[8][8];
        conv8(acc, QKV + r0 * 3072 + 1024 + h * 128 + co * 8, conv_w + 1024 + h * 128 + co * 8, c0 + tg * 8, Ls);
        l2scale8(acc, 1.f);
#pragma unroll
        for (int tt = 0; tt < 8; ++tt) *(u32x4*)(Kn + ((tg * 8 + tt) * LK + co * 8) * 2) = pack8s(acc[tt], 1.f);
    } else if (wid == 2 || wid == 3) { const int d = wid - 2; gates_wave(sm + d * 260, AB, r0, c0, d, h, __expf(a_log[d * 8 + h]), dt_bias[d * 8 + h], lane); }
    __syncthreads();
    if (wid < 4) {
        const int mt = wid >> 1, nt = wid & 1; f32x16 acc = {};
#pragma unroll
        for (int ks = 0; ks < 8; ++ks) acc = mma(GFRAG(Kn, LK, mt, ks), GFRAG(Kn, LK, nt, ks), acc);
#pragma unroll
        for (int r = 0; r < 16; ++r) KK[(32 * mt + crow(r, hi)) * 64 + 32 * nt + r32] = acc[r];
    }
    __syncthreads();
    for (int e = tid; e < 8192; e += 512) { const int d = e >> 12, i = (e >> 6) & 63, j = e & 63; const float* s = sm + d * 260;
        const int ti = d ? 63 - i : i, tj = d ? 63 - j : j;
        Ap[e] = (j < i) ? s[64 + i] * KK[ti * 64 + tj] * __expf(s[i] - s[j]) : 0.f; }
    __syncthreads();
    if (wid < 2) {
        const int d = wid; const float* A = Ap + d * 4096; float T[64];
#pragma unroll
        for (int i = 0; i < 64; ++i) { float acc = (lane == i) ? 1.f : 0.f;
#pragma unroll
            for (int j4 = 0; j4 < (i + 3) / 4; ++j4) { const f32x4 a = *(const f32x4*)(A + i * 64 + j4 * 4);
#pragma unroll
                for (int q = 0; q < 4; ++q) if (j4 * 4 + q < i) acc -= a[q] * T[j4 * 4 + q]; }
            T[i] = acc; }
        const int sidx = seg ? 4 + (d ? nch - 1 - cidx : cidx) : (d ? nch - 1 - cidx : cidx);
        unsigned short* Tg = Tbuf + ((size_t)((b * 8 + h) * 2 + d) * NSTEP + sidx) * 4096;
#pragma unroll
        for (int i = 0; i < 64; ++i) Tg[i * 64 + lane] = (unsigned short)f2bf(T[i]);
    }
    __syncthreads();
}

__device__ __forceinline__ void chain(int b, int h, int d, const unsigned short* QKV, const float* AB, const float* conv_w, const float* a_log, const float* dt_bias,
                                      const unsigned short* Tbuf, float* o_a, char* lds) {
    const int tid0 = threadIdx.x, wid = __builtin_amdgcn_readfirstlane(tid0 >> 6);
    const int nt = wid & 3, mh = wid >> 2;
    char* Kbn = lds + L_KBN; char* Qd = lds + L_QD; char* KdT = lds + L_KDT; char* QKb = lds + L_QK; char* Vb = lds + L_VB; char* Sbf = lds + L_SBF; char* Rbf = lds + L_RBF; char* VNbf = lds + L_VNBF;
    float* sm = (float*)(lds + L_SM);
    const float Aexp = __expf(a_log[d * 8 + h]), dtb = dt_bias[d * 8 + h];
    for (int e = tid0; e < 128 * LK / 2; e += 512) ((unsigned*)Sbf)[e] = 0u;
    f32x16 S0 = {}, S1 = {};
    const unsigned short* Tchain = Tbuf + (size_t)((b * 8 + h) * 2 + d) * NSTEP * 4096;
    __syncthreads();
    for (int sidx = 0; sidx < NSTEP; ++sidx) {
        int tid_ = threadIdx.x; asm volatile("" : "+v"(tid_));
        const int tid = tid_, lane = tid & 63, r32 = lane & 31, hi = lane >> 5;
        const int co = tid % 48, tg = tid / 48, tensor = co >> 4, c8 = (co & 15) * 8;
        const int seg = sidx >= 4, n = seg ? sidx - 4 : sidx, Ls = seg ? SEQ : LCTX, nch = Ls / 64, cidx = d ? nch - 1 - n : n, c0 = cidx * 64;
        const long r0 = seg ? (long)b * SEQ : (long)MLAT + b * LCTX;
        float acc[8][8];
        if (tid < 384) {
            conv8(acc, QKV + r0 * 3072 + tensor * 1024 + h * 128 + c8, conv_w + tensor * 1024 + h * 128 + c8, c0 + tg * 8, Ls);
            if (tensor == 0) l2scale8(acc, 0.08838834764831845f); else if (tensor == 1) l2scale8(acc, 1.f);
        } else if (wid == 7) gates_wave(sm, AB, r0, c0, d, h, Aexp, dtb, lane);
        __syncthreads();
        bf16x8 Tf[4];
        { const unsigned short* Tg = Tchain + (size_t)sidx * 4096 + (32 * mh + r32) * 64 + 8 * hi;
#pragma unroll
          for (int ks = 0; ks < 4; ++ks) Tf[ks] = *(const bf16x8*)(Tg + 16 * ks); }
        if (tid < 384) {
#pragma unroll
            for (int tt = 0; tt < 8; ++tt) { const int il = d ? 63 - tg * 8 - tt : tg * 8 + tt;
                if (tensor == 0) *(u32x4*)(Qd + (il * LK + c8) * 2) = pack8s(acc[tt], 1.f);
                else if (tensor == 1) *(u32x4*)(Kbn + (il * LK + c8) * 2) = pack8s(acc[tt], 1.f);
                else *(u32x4*)(Vb + (il * LK + c8) * 2) = pack8s(acc[tt], sm[64 + il]); }
            if (tensor == 1) {
                const int ib = d ? 56 - tg * 8 : tg * 8;
#pragma unroll
                for (int i = 0; i < 8; ++i) { float v[8];
#pragma unroll
                    for (int p = 0; p < 8; ++p) v[p] = (d ? acc[7 - p][i] : acc[p][i]) * sm[192 + ib + p];
                    *(u32x4*)(KdT + ((c8 + i) * LT + ib) * 2) = pack8s(v, 1.f); }
            }
        }
        __syncthreads();
        if (seg && wid < 3) {
            const int mt = wid > 0, ntq = wid > 1; f32x16 a = {};
#pragma unroll
            for (int ks = 0; ks < 8; ++ks) a = mma(GFRAG(Qd, LK, mt, ks), GFRAG(Kbn, LK, ntq, ks), a);
            const int j = 32 * ntq + r32; const float gj = sm[j];
#pragma unroll
            for (int r = 0; r < 16; ++r) { const int i = 32 * mt + crow(r, hi); const float v = (i >= j) ? a[r] * __expf(sm[i] - gj) : 0.f;
                *(unsigned short*)(QKb + (i * LT + j) * 2) = (unsigned short)f2bf(v); }
        }
        __syncthreads();
        if (tid < 384 && tensor < 2) {
#pragma unroll
            for (int tt = 0; tt < 8; ++tt) { const int il = d ? 63 - tg * 8 - tt : tg * 8 + tt;
                if (tensor == 0) *(u32x4*)(Qd + (il * LK + c8) * 2) = pack8s(acc[tt], sm[128 + il]);
                else if (tensor == 1) *(u32x4*)(Kbn + (il * LK + c8) * 2) = pack8s(acc[tt], -sm[64 + il] * sm[128 + il]); }
        }
        __syncthreads();
        f32x16 rr, oo = {};
#pragma unroll
        for (int r = 0; r < 16; ++r) rr[r] = bf2f(*(const unsigned short*)(Vb + ((32 * mh + crow(r, hi)) * LK + 32 * nt + r32) * 2));
#pragma unroll
        for (int ks = 0; ks < 8; ++ks) { const bf16x8 sb = GFRAG(Sbf, LK, nt, ks); rr = mma(GFRAG(Kbn, LK, mh, ks), sb, rr); if (seg) oo = mma(GFRAG(Qd, LK, mh, ks), sb, oo); }
#pragma unroll
        for (int q4 = 0; q4 < 4; ++q4) { u32x2 w; w.x = pk2(rr[4 * q4], rr[4 * q4 + 1]); w.y = pk2(rr[4 * q4 + 2], rr[4 * q4 + 3]);
            *(u32x2*)(Rbf + ((32 * nt + r32) * LT + 32 * mh + 8 * q4 + 4 * hi) * 2) = w; }
        __syncthreads();
        f32x16 vn = {};
#pragma unroll
        for (int ks = 0; ks < 4; ++ks) if (mh == 1 || ks < 2) vn = mma(Tf[ks], GFRAG(Rbf, LT, nt, ks), vn);
#pragma unroll
        for (int q4 = 0; q4 < 4; ++q4) { u32x2 w; w.x = pk2(vn[4 * q4], vn[4 * q4 + 1]); w.y = pk2(vn[4 * q4 + 2], vn[4 * q4 + 3]);
            *(u32x2*)(VNbf + ((32 * nt + r32) * LT + 32 * mh + 8 * q4 + 4 * hi) * 2) = w; }
        __syncthreads();
        if (seg) {
#pragma unroll
            for (int ks = 0; ks < 4; ++ks) if (mh == 1 || ks < 2) oo = mma(GFRAG(QKb, LT, mh, ks), GFRAG(VNbf, LT, nt, ks), oo);
#pragma unroll
            for (int r = 0; r < 16; ++r) { const int il = 32 * mh + crow(r, hi); const int t = d ? c0 + 63 - il : c0 + il;
                atomicAdd(o_a + (size_t)(r0 + t) * 1024 + h * 128 + 32 * nt + r32, oo[r]); }
        }
        { const float gam = sm[256];
#pragma unroll
          for (int r = 0; r < 16; ++r) { S0[r] *= gam; S1[r] *= gam; }
#pragma unroll
          for (int ks = 0; ks < 4; ++ks) { const bf16x8 vb = GFRAG(VNbf, LT, nt, ks); S0 = mma(GFRAG(KdT, LT, 2 * mh, ks), vb, S0); S1 = mma(GFRAG(KdT, LT, 2 * mh + 1, ks), vb, S1); }
#pragma unroll
          for (int q4 = 0; q4 < 4; ++q4) { u32x2 w0, w1; w0.x = pk2(S0[4 * q4], S0[4 * q4 + 1]); w0.y = pk2(S0[4 * q4 + 2], S0[4 * q4 + 3]); w1.x = pk2(S1[4 * q4], S1[4 * q4 + 1]); w1.y = pk2(S1[4 * q4 + 2], S1[4 * q4 + 3]);
              *(u32x2*)(Sbf + ((32 * nt + r32) * LK + 64 * mh + 8 * q4 + 4 * hi) * 2) = w0; *(u32x2*)(Sbf + ((32 * nt + r32) * LK + 64 * mh + 32 + 8 * q4 + 4 * hi) * 2) = w1; } }
        __syncthreads();
    }
}
#undef GFRAG
}

__global__ void __launch_bounds__(512, 2) hybrid_fwd(Args a) {
    extern __shared__ __attribute__((aligned(16))) unsigned char lds[];
    const int tid0 = threadIdx.x, wave = __builtin_amdgcn_readfirstlane(tid0 >> 6);
#define PHASE_IDS() int tid = threadIdx.x; asm volatile("" : "+v"(tid)); const int lane = tid & 63; (void)lane
    const int G = gridDim.x, bid = blockIdx.x;
    const int gw = bid * 8 + wave, NGW = G * 8;
    unsigned char* ws = a.ws;
    unsigned* ctl = (unsigned*)(ws + WS_CTL);
    volatile LAS unsigned* MISC = (volatile LAS unsigned*)((LAS unsigned char*)lds + MISC_OFF);
    for (int u = tid0; u < (LDS_BYTES - 131072) / 4; u += 512) ((LAS unsigned*)((LAS unsigned char*)lds + 131072))[u] = 0u;
    __syncthreads();
    XcdBarrier bar = xcd_barrier_post(ctl + 4096, MISC + 8);

    float* MODP = (float*)(ws + WS_MODP); float* MOD = (float*)(ws + WS_MOD);
    bf16* W2T = (bf16*)(ws + WS_W2T); float* AB = (float*)(ws + WS_AB);
    bf16* QKV = (bf16*)(ws + WS_QKV); bf16* QB = (bf16*)(ws + WS_QB); bf16* KB = (bf16*)(ws + WS_KB); bf16* VB = (bf16*)(ws + WS_VB);
    bf16* MERGED = (bf16*)(ws + WS_MERGED); bf16* H2 = (bf16*)(ws + WS_H2); bf16* NA = (bf16*)(ws + WS_NA); bf16* T1 = (bf16*)(ws + WS_T1); bf16* GATES = (bf16*)(ws + WS_GATES);
    bf16* H = (bf16*)((unsigned char*)a.out + DO_H); bf16* W1T = (bf16*)((unsigned char*)a.out + DO_W1T);


#define THRASH() do { f32x4 _s = {0.f,0.f,0.f,0.f}; for (size_t _i = (size_t)bid * 512 + tid; _i < (size_t)MLAT * 1024 / 4; _i += (size_t)G * 512) { const f32x4 _v = ((const f32x4*)a.x)[_i]; _s += _v; } \
    ((f32x4*)(ws + WS_END))[(size_t)bid * 512 + tid] = _s; } while (0)
    {
        PHASE_IDS();
        for (int u = bid; u < 48; u += G) {
            const int ks = u / 6, nb = u % 6, n = nb * 512 + tid;
            float s0 = 0.f, s1 = 0.f, s2 = 0.f;
            for (int k = ks * 128; k < ks * 128 + 128; ++k) {
                const float w = a.w_ada[(size_t)k * 3072 + n];
                s0 += silu_f(a.c[k]) * w; s1 += silu_f(a.c[1024 + k]) * w; s2 += silu_f(a.c_ctx[k]) * w;
            }
            MODP[(ks * 3 + 0) * 3072 + n] = s0; MODP[(ks * 3 + 1) * 3072 + n] = s1; MODP[(ks * 3 + 2) * 3072 + n] = s2;
        }
        LAS float* scr = (LAS float*)((LAS unsigned char*)lds + wave * 16384);
        constexpr int NB1 = N1 / 32, NB2 = N2ALL / 32, NIT = 16 * (NB1 + NB2);
        for (int it = gw; it < NIT; it += NGW) {
            const int kb = it & 15, nbi = it >> 4;
            if (nbi < NB1) { const int n0 = nbi * 32; transpose_item(a.w_in, IN_COLS, w1_src(n0), W1T, n0, kb * 64, scr, lane); }
            else { const int n0 = (nbi - NB1) * 32;
                if (n0 < 4096) transpose_item(a.w_in, IN_COLS, w2_src(n0), W2T, n0, kb * 64, scr, lane);
                else if (n0 < 5120) transpose_item(a.w_oa, 1024, n0 - 4096, W2T, n0, kb * 64, scr, lane);
                else if (n0 < 6144) transpose_item(a.w_ob, 1024, n0 - 5120, W2T, n0, kb * 64, scr, lane);
                else transpose_item(a.w_out, 1024, n0 - 6144, W2T, n0, kb * 64, scr, lane); }
        }
    }
    xcd_barrier(bar);

    {
        PHASE_IDS();
        float* modl = (float*)lds;
        for (int i = tid; i < 9216; i += 512) { const int n = i % 3072; float s = a.b_ada[n];
#pragma unroll
            for (int ks = 0; ks < 8; ++ks) s += MODP[ks * 9216 + i];
            modl[i] = s; if (bid == 0) MOD[i] = s; }
        __syncthreads();
        for (int r = gw; r < MTOT; r += NGW) {
            const float* xr; int v;
            if (r < MLAT) { xr = a.x + (size_t)r * 1024; v = r / SEQ; } else { xr = a.ctx + (size_t)(r - MLAT) * 1024; v = 2; }
            f32x4 xv[4]; float ss = 0.f;
#pragma unroll
            for (int j = 0; j < 4; ++j) { xv[j] = ((const f32x4*)xr)[64 * j + lane]; ss += (xv[j].x * xv[j].x + xv[j].y * xv[j].y) + (xv[j].z * xv[j].z + xv[j].w * xv[j].w); }
            const float rstd = 1.f / sqrtf(wave_sum(ss) * (1.f / 1024.f) + EPS);
            const float* sh = modl + v * 3072; const float* sc = sh + 1024;
#pragma unroll
            for (int j = 0; j < 4; ++j) { const int c0 = (64 * j + lane) * 4;
                const float h0 = xv[j].x * rstd * (1.f + sc[c0]) + sh[c0], h1 = xv[j].y * rstd * (1.f + sc[c0 + 1]) + sh[c0 + 1];
                const float h2 = xv[j].z * rstd * (1.f + sc[c0 + 2]) + sh[c0 + 2], h3 = xv[j].w * rstd * (1.f + sc[c0 + 3]) + sh[c0 + 3];
                v2u o; o.x = pk2(h0, h1); o.y = pk2(h2, h3); *(v2u*)(H + (size_t)r * 1024 + c0) = o; }
        }
    }
    xcd_barrier(bar);


#if PG8_R1
    { pg8::Gemm g{H, W1T, MTOT, N1, 1024}; pg8::StaticOrder S; S.init(MTOT, N1, G, bid); pg8::EpiR1 e{QKV, QB, KB, VB, AB, MLAT / 256};
      pg8::gemm_phase<pg8::EpiR1, pg8::StaticOrder, true, true>((LAS unsigned char*)lds, g, S, e); }
#else
    { EpiR1 e{QKV, QB, KB, VB, AB}; gemm_naive(lds, H, W1T, MTOT, N1, 1024, e); }
#endif

    xcd_barrier(bar);

    {
        PHASE_IDS();
        for (size_t i = (size_t)bid * 512 + tid; i < (size_t)MLAT * 1024 / 4; i += (size_t)G * 512) ((f32x4*)a.out)[i] = (f32x4){0.f, 0.f, 0.f, 0.f};
        for (int it = gw; it < MLAT + MTOT; it += NGW) {
            const bool isq = it < MLAT; const int r = isq ? it : it - MLAT;
            bf16* p = (isq ? QB : KB) + (size_t)r * 1024 + lane * 16;
            const float* gw_ = isq ? a.q_norm_w : a.k_norm_w;
            const v4u w0 = *(const v4u*)p, w1 = *(const v4u*)(p + 8);
            float v[16] = {bflo(w0.x), bfhi(w0.x), bflo(w0.y), bfhi(w0.y), bflo(w0.z), bfhi(w0.z), bflo(w0.w), bfhi(w0.w),
                           bflo(w1.x), bfhi(w1.x), bflo(w1.y), bfhi(w1.y), bflo(w1.z), bfhi(w1.z), bflo(w1.w), bfhi(w1.w)};
            float ss = 0.f;
#pragma unroll
            for (int i = 0; i < 16; ++i) ss += v[i] * v[i];
            ss += __shfl_xor(ss, 1); ss += __shfl_xor(ss, 2);
            const float rstd = 1.f / sqrtf(ss * (1.f / 64.f) + EPS);
            const int sub = lane & 3;
#pragma unroll
            for (int i = 0; i < 16; ++i) v[i] = v[i] * rstd * gw_[sub * 16 + i];
            if (r < MLAT) {
                const int t = r % SEQ; const float pos = (float)((sub < 2) ? (t >> 6) : (t & 63));
#pragma unroll
                for (int i = 0; i < 16; ++i) {
                    const float other = __shfl_xor(v[i], 1);
                    const float invf = exp2f(-(float)i * (13.287712379549449f / 16.f));
                    const float ang = pos * invf; const float cs = cosf(ang), sn = sinf(ang);
                    v[i] = (sub & 1) ? (v[i] * cs + other * sn) : (v[i] * cs - other * sn);
                }
            }
            const float sc = isq ? QSCALE : 1.f;
            v4u o0, o1; o0.x = pk2(v[0] * sc, v[1] * sc); o0.y = pk2(v[2] * sc, v[3] * sc); o0.z = pk2(v[4] * sc, v[5] * sc); o0.w = pk2(v[6] * sc, v[7] * sc);
            o1.x = pk2(v[8] * sc, v[9] * sc); o1.y = pk2(v[10] * sc, v[11] * sc); o1.z = pk2(v[12] * sc, v[13] * sc); o1.w = pk2(v[14] * sc, v[15] * sc);
            *(v4u*)p = o0; *(v4u*)(p + 8) = o1;
        }
    #if !GDN_NAIVE
        __syncthreads();
        for (int u = bid; u < 2 * 8 * gdn::NSTEP; u += G) {
            const int bh = u / gdn::NSTEP, rem = u % gdn::NSTEP; const int sg = rem >= 4, cidx = sg ? rem - 4 : rem;
            gdn::t_unit(bh >> 3, bh & 7, sg, cidx, QKV, AB, a.conv_w, a.a_log, a.dt_bias, (unsigned short*)(ws + WS_T), (char*)lds);
        }
#endif
    }
    xcd_barrier(bar);

    {
        PHASE_IDS();
#if GDN_NAIVE
        for (int wu = gw; wu < 1024; wu += NGW) {
            const int chain = wu >> 5, sl = wu & 31; const int b = chain >> 4, h = (chain >> 1) & 7, d = chain & 1;
            const int g = lane >> 2, dv = sl * 4 + (lane & 3);
            const float Aexp = __expf(a.a_log[d * 8 + h]), dtb = a.dt_bias[d * 8 + h];
            float wq[5][8], wk[5][8], wv[5];
#pragma unroll
            for (int j = 0; j < 5; ++j) { wv[j] = a.conv_w[j * 3072 + 2048 + h * 128 + dv];
#pragma unroll
                for (int i = 0; i < 8; ++i) { wq[j][i] = a.conv_w[j * 3072 + h * 128 + g * 8 + i]; wk[j][i] = a.conv_w[j * 3072 + 1024 + h * 128 + g * 8 + i]; } }
            float S[8];
#pragma unroll
            for (int i = 0; i < 8; ++i) S[i] = 0.f;
            for (int seg = 0; seg < 2; ++seg) {
                const int Ls = seg == 0 ? LCTX : SEQ; const int r0 = seg == 0 ? MLAT + b * LCTX : b * SEQ;
                for (int step = 0; step < Ls; ++step) {
                    const int t = d ? (Ls - 1 - step) : step;
                    float q[8], k[8], v = 0.f;
#pragma unroll
                    for (int i = 0; i < 8; ++i) { q[i] = 0.f; k[i] = 0.f; }
#pragma unroll
                    for (int j = 0; j < 5; ++j) { const int tt = t + j - 2;
                        if (tt >= 0 && tt < Ls) { const bf16* rp = QKV + (size_t)(r0 + tt) * 3072 + h * 128;
                            const v4u qv = *(const v4u*)(rp + g * 8), kv = *(const v4u*)(rp + 1024 + g * 8);
                            v += bf2f(rp[2048 + dv]) * wv[j];
                            q[0] += bflo(qv.x) * wq[j][0]; q[1] += bfhi(qv.x) * wq[j][1]; q[2] += bflo(qv.y) * wq[j][2]; q[3] += bfhi(qv.y) * wq[j][3];
                            q[4] += bflo(qv.z) * wq[j][4]; q[5] += bfhi(qv.z) * wq[j][5]; q[6] += bflo(qv.w) * wq[j][6]; q[7] += bfhi(qv.w) * wq[j][7];
                            k[0] += bflo(kv.x) * wk[j][0]; k[1] += bfhi(kv.x) * wk[j][1]; k[2] += bflo(kv.y) * wk[j][2]; k[3] += bfhi(kv.y) * wk[j][3];
                            k[4] += bflo(kv.z) * wk[j][4]; k[5] += bfhi(kv.z) * wk[j][5]; k[6] += bflo(kv.w) * wk[j][6]; k[7] += bfhi(kv.w) * wk[j][7]; } }
                    v = silu_f(v); float sq = 0.f, sk = 0.f;
#pragma unroll
                    for (int i = 0; i < 8; ++i) { q[i] = silu_f(q[i]); k[i] = silu_f(k[i]); sq += q[i] * q[i]; sk += k[i] * k[i]; }
#pragma unroll
                    for (int o = 4; o < 64; o <<= 1) { sq += __shfl_xor(sq, o); sk += __shfl_xor(sk, o); }
                    const float rq = (1.f / sqrtf(sq + EPS)) * 0.08838834764831845f, rk = 1.f / sqrtf(sk + EPS);
                    const float araw = AB[(size_t)(r0 + t) * 32 + d * 8 + h], braw = AB[(size_t)(r0 + t) * 32 + 16 + d * 8 + h];
                    const float dec = __expf(-Aexp * softplus_f(araw + dtb)), beta = sigmoid_f(braw);
                    float kS = 0.f;
#pragma unroll
                    for (int i = 0; i < 8; ++i) { k[i] *= rk; S[i] *= dec; kS += k[i] * S[i]; }
#pragma unroll
                    for (int o = 4; o < 64; o <<= 1) kS += __shfl_xor(kS, o);
                    const float vn = beta * (v - kS); float oo = 0.f;
#pragma unroll
                    for (int i = 0; i < 8; ++i) { S[i] += k[i] * vn; oo += q[i] * rq * S[i]; }
#pragma unroll
                    for (int o = 4; o < 64; o <<= 1) oo += __shfl_xor(oo, o);
                    if (seg == 1 && lane < 4) atomicAdd(a.out + (size_t)(r0 + t) * 1024 + h * 128 + dv, oo);
                }
            }
        }
#else
        if (bid < 32) gdn::chain(bid >> 4, (bid >> 1) & 7, bid & 1, QKV, AB, a.conv_w, a.a_log, a.dt_bias, (const unsigned short*)(ws + WS_T), a.out, (char*)lds);
#endif
        __syncthreads();
        {
            float lam, negm;
            { float s1 = 0.f, s2 = 0.f, mq = 0.f, mk = 0.f; for (int i = 0; i < 64; ++i) { s1 += a.lq1[i] * a.lk1[i]; s2 += a.lq2[i] * a.lk2[i]; mq = fmaxf(mq, fabsf(a.q_norm_w[i])); mk = fmaxf(mk, fabsf(a.k_norm_w[i])); }
              lam = __expf(s1) - __expf(s2) + 0.2f; negm = -(8.f * mq * mk * 1.4426950408889634f); }
            volatile LAS unsigned* qslot = MISC + 16;
            for (int qq = 0; qq < 8; ++qq) { const int q = (bid + qq) & 7;
                for (;;) {
                    __syncthreads();
                    if (tid == 0) qslot[0] = __hip_atomic_fetch_add(ctl + 12288 + 64 * q, 1u, __ATOMIC_RELAXED, __HIP_MEMORY_SCOPE_AGENT);
                    __syncthreads();
                    const unsigned idx = qslot[0];
                    if (idx >= 128u) break;
                    const int unit = q * 128 + (int)idx; const int pair = unit >> 6, qb = unit & 63;
                    att::attn_unit(pair >> 3, pair & 7, qb, QB, KB, VB, a.diff_norm_w, lam, negm, (char*)lds);
                }
            }
        }
    }
    xcd_barrier(bar);

    {
        PHASE_IDS();
        for (int r = gw; r < MLAT; r += NGW) {
            const float* xr = a.x + (size_t)r * 1024; const int v = r / SEQ;
            f32x4 xv[4]; float ss = 0.f;
#pragma unroll
            for (int j = 0; j < 4; ++j) { xv[j] = ((const f32x4*)xr)[64 * j + lane]; ss += (xv[j].x * xv[j].x + xv[j].y * xv[j].y) + (xv[j].z * xv[j].z + xv[j].w * xv[j].w); }
            const float rstd = 1.f / sqrtf(wave_sum(ss) * (1.f / 1024.f) + EPS);
            const float* sh = MOD + v * 3072; const float* sc = sh + 1024;
#pragma unroll
            for (int j = 0; j < 4; ++j) { const int c0 = (64 * j + lane) * 4;
                const float h0 = xv[j].x * rstd * (1.f + sc[c0]) + sh[c0], h1 = xv[j].y * rstd * (1.f + sc[c0 + 1]) + sh[c0 + 1];
                const float h2 = xv[j].z * rstd * (1.f + sc[c0 + 2]) + sh[c0 + 2], h3 = xv[j].w * rstd * (1.f + sc[c0 + 3]) + sh[c0 + 3];
                v2u o; o.x = pk2(h0, h1); o.y = pk2(h2, h3); *(v2u*)(H2 + (size_t)r * 1024 + c0) = o; }
            const float* orow = a.out + (size_t)r * 1024 + lane * 16;
            f32x4 ov[4]; float s2 = 0.f;
#pragma unroll
            for (int j = 0; j < 4; ++j) { ov[j] = ((const f32x4*)orow)[j]; s2 += (ov[j].x * ov[j].x + ov[j].y * ov[j].y) + (ov[j].z * ov[j].z + ov[j].w * ov[j].w); }
            s2 += __shfl_xor(s2, 1); s2 += __shfl_xor(s2, 2); s2 += __shfl_xor(s2, 4);
            const float r2 = 1.f / sqrtf(s2 * (1.f / 128.f) + EPS);
            const float* gwp = a.gdn_norm_w + (lane & 7) * 16;
            v4u o0, o1;
            o0.x = pk2(ov[0].x * r2 * gwp[0], ov[0].y * r2 * gwp[1]); o0.y = pk2(ov[0].z * r2 * gwp[2], ov[0].w * r2 * gwp[3]);
            o0.z = pk2(ov[1].x * r2 * gwp[4], ov[1].y * r2 * gwp[5]); o0.w = pk2(ov[1].z * r2 * gwp[6], ov[1].w * r2 * gwp[7]);
            o1.x = pk2(ov[2].x * r2 * gwp[8], ov[2].y * r2 * gwp[9]); o1.y = pk2(ov[2].z * r2 * gwp[10], ov[2].w * r2 * gwp[11]);
            o1.z = pk2(ov[3].x * r2 * gwp[12], ov[3].y * r2 * gwp[13]); o1.w = pk2(ov[3].z * r2 * gwp[14], ov[3].w * r2 * gwp[15]);
            *(v4u*)(NA + (size_t)r * 1024 + lane * 16) = o0; *(v4u*)(NA + (size_t)r * 1024 + lane * 16 + 8) = o1;
        }
    }
    xcd_barrier(bar);


#if PG8_R2
    { pg8::Gemm g{H2, W2T, MLAT, 4096, 1024}; pg8::StaticOrder S; S.init(MLAT, 4096, G, bid); pg8::EpiR2 e{NA, QB, GATES, NA, QB};
      pg8::gemm_phase<pg8::EpiR2, pg8::StaticOrder, true, true>((LAS unsigned char*)lds, g, S, e); }
#else
    { EpiR2 e{NA, QB, GATES}; gemm_naive(lds, H2, W2T, MLAT, 4096, 1024, e); }
#endif
    xcd_barrier(bar);


#if PG8_F1
    { pg8::Gemm g{NA, W2T + (size_t)4096 * 1024, MLAT, 1024, 1024}; pg8::StaticOrder S; S.init(MLAT, 1024, G, bid); pg8::EpiF e{T1, T1, GATES, 0};
      pg8::gemm_phase<pg8::EpiF, pg8::StaticOrder, true, true>((LAS unsigned char*)lds, g, S, e); }
#else
    { EpiF1 e{T1, GATES}; gemm_naive(lds, NA, W2T + (size_t)4096 * 1024, MLAT, 1024, 1024, e); }
#endif


#if PG8_F2
    { pg8::Gemm g{QB, W2T + (size_t)5120 * 1024, MLAT, 1024, 1024}; pg8::StaticOrder S; S.init(MLAT, 1024, G, bid); pg8::EpiF e{MERGED, T1, GATES, 1};
      pg8::gemm_phase<pg8::EpiF, pg8::StaticOrder, true, true>((LAS unsigned char*)lds, g, S, e); }
#else
    { EpiF2 e{MERGED, T1, GATES}; gemm_naive(lds, QB, W2T + (size_t)5120 * 1024, MLAT, 1024, 1024, e); }
#endif

    xcd_barrier(bar);


#if PG8_G
    { pg8::Gemm g{MERGED, W2T + (size_t)6144 * 1024, MLAT, 1024, 1024}; pg8::StaticOrder S; S.init(MLAT, 1024, G, bid); pg8::EpiG e{a.out, a.x, MOD, SEQ / 256};
      pg8::gemm_phase<pg8::EpiG, pg8::StaticOrder, true, true>((LAS unsigned char*)lds, g, S, e); }
#else
    { EpiG e{a.out, a.x, MOD}; gemm_naive(lds, MERGED, W2T + (size_t)6144 * 1024, MLAT, 1024, 1024, e); }
#endif

}

extern "C" void kernel_launch(void* const* d_in, const int* in_sizes, int n_in, void* d_out, int out_size, void* d_ws, size_t ws_size, hipStream_t stream) {
    static int grid = 0;
    if (grid == 0) {
        if (n_in != 21 || in_sizes[0] != MLAT * DM || out_size != MLAT * DM || ws_size < WS_END) { fprintf(stderr, "kernel_launch: unexpected shapes n_in %d in0 %d out %d ws %zu\n", n_in, n_in > 0 ? in_sizes[0] : -1, out_size, ws_size); grid = -1; return; }
        int dev = 0, cus = 0, per_cu = 0;
        if (hipGetDevice(&dev) != hipSuccess || hipDeviceGetAttribute(&cus, hipDeviceAttributeMultiprocessorCount, dev) != hipSuccess) { grid = -1; return; }
        if (hipFuncSetAttribute((const void*)hybrid_fwd, hipFuncAttributeMaxDynamicSharedMemorySize, LDS_BYTES) != hipSuccess) { fprintf(stderr, "kernel_launch: hipFuncSetAttribute failed\n"); grid = -1; return; }
        if (hipOccupancyMaxActiveBlocksPerMultiprocessor(&per_cu, (const void*)hybrid_fwd, 512, LDS_BYTES) != hipSuccess || per_cu < 1) { fprintf(stderr, "kernel_launch: occupancy query says %d\n", per_cu); per_cu = 1; }
        (void)hipGetLastError();
        grid = cus;
    }
    if (grid < 0) return;
    (void)hipMemsetAsync((char*)d_ws + WS_CTL, 0, CTL_BYTES, stream);
    Args a{};
    a.x = (const float*)d_in[0]; a.c = (const float*)d_in[1]; a.ctx = (const float*)d_in[2]; a.c_ctx = (const float*)d_in[3]; a.w_ada = (const float*)d_in[4]; a.b_ada = (const float*)d_in[5];
    a.w_in = (const float*)d_in[6]; a.conv_w = (const float*)d_in[7]; a.a_log = (const float*)d_in[8]; a.dt_bias = (const float*)d_in[9]; a.gdn_norm_w = (const float*)d_in[10];
    a.q_norm_w = (const float*)d_in[11]; a.k_norm_w = (const float*)d_in[12]; a.lq1 = (const float*)d_in[13]; a.lk1 = (const float*)d_in[14]; a.lq2 = (const float*)d_in[15]; a.lk2 = (const float*)d_in[16];
    a.diff_norm_w = (const float*)d_in[17]; a.w_oa = (const float*)d_in[18]; a.w_ob = (const float*)d_in[19]; a.w_out = (const float*)d_in[20];
    a.out = (float*)d_out; a.ws = (unsigned char*)d_ws;
    hipLaunchKernelGGL(hybrid_fwd, dim3(grid), dim3(512), LDS_BYTES, stream, a);
    const hipError_t le = hipPeekAtLastError();
    if (le != hipSuccess) fprintf(stderr, "kernel_launch: launch failed: %s\n", hipGetErrorName(le));
}
```

```cpp
#include <hip/hip_runtime.h>
#include <cstdio>
#include <cstdint>
#define PG8_R1 1
#define PG8_R2 1
#define PG8_F1 1
#define PG8_F2 1
#define PG8_G 1
#define GDN_NAIVE 0
#define TIME_CHAIN2 0
#define DIAG_IDX 0
#define R2_SKIP_Z 0

#define GAS __attribute__((address_space(1)))
#define LAS __attribute__((address_space(3)))
typedef unsigned short bf16;
typedef unsigned v4u __attribute__((ext_vector_type(4)));
typedef unsigned v2u __attribute__((ext_vector_type(2)));
typedef float f32x4 __attribute__((ext_vector_type(4)));

constexpr int NB = 2, SEQ = 8192, DM = 1024, LCTX = 256, NH = 8;
constexpr int MLAT = NB * SEQ, MCTX = NB * LCTX, MTOT = MLAT + MCTX;
constexpr int IN_COLS = 10272;
constexpr int N1 = 6400, N2ALL = 7168;
constexpr float EPS = 1e-6f;
constexpr float QSCALE = 0.125f * 1.4426950408889634f;

constexpr size_t MiB = 1u << 20;
constexpr size_t WS_CTL = 0, CTL_BYTES = 1 * MiB;
constexpr size_t WS_MODP = 1 * MiB;
constexpr size_t WS_MOD = 2 * MiB;
constexpr size_t WS_W2T = 3 * MiB;
constexpr size_t WS_AB = 17 * MiB;
constexpr size_t WS_T = 20 * MiB;
constexpr size_t WS_QKV = 53 * MiB;
constexpr size_t WS_QB = 152 * MiB;
constexpr size_t WS_KB = 184 * MiB;
constexpr size_t WS_VB = 217 * MiB;
constexpr size_t WS_END = 250 * MiB;
constexpr size_t WS_MERGED = 20 * MiB;
constexpr size_t WS_H2 = 53 * MiB;
constexpr size_t WS_NA = 85 * MiB;
constexpr size_t WS_T1 = 117 * MiB;
constexpr size_t WS_GATES = 184 * MiB;
constexpr size_t DO_H = 0;
constexpr size_t DO_W1T = 33 * MiB;

constexpr int LDS_BYTES = 163840;
constexpr int MISC_OFF = 163840 - 256;

__device__ __forceinline__ unsigned f2bf(float f) { unsigned u = __builtin_bit_cast(unsigned, f); return (u + 0x7fffu + ((u >> 16) & 1u)) >> 16; }
typedef float f32x2_t __attribute__((ext_vector_type(2))); typedef __bf16 bf16x2_t __attribute__((ext_vector_type(2)));
__device__ __forceinline__ unsigned pk2(float lo, float hi) { f32x2_t v = {lo, hi}; bf16x2_t b = __builtin_convertvector(v, bf16x2_t); return __builtin_bit_cast(unsigned, b); }
__device__ __forceinline__ float bf2f(unsigned short h) { return __builtin_bit_cast(float, (unsigned)h << 16); }
__device__ __forceinline__ float bflo(unsigned w) { return __builtin_bit_cast(float, w << 16); }
__device__ __forceinline__ float bfhi(unsigned w) { return __builtin_bit_cast(float, w & 0xffff0000u); }
__device__ __forceinline__ float silu_f(float x) { return x / (1.f + __expf(-x)); }
__device__ __forceinline__ float sigmoid_f(float x) { return 1.f / (1.f + __expf(-x)); }
__device__ __forceinline__ float softplus_f(float x) { return fmaxf(x, 0.f) + log1pf(__expf(-fabsf(x))); }

#define XB_TMO      128
#define XB_XCNT(j)  (256  + 64 * (j))
#define XB_XSUB(j)  (1280 + 64 * (j))
#define XB_XGEN(j)  (2304 + 64 * (j))
#define XB_TOP      3328
#define XB_TOPGEN   3392
#define XCD_BAR_WORDS 3456
#define XB_SPIN_CAP (1u << 22)
__device__ __forceinline__ unsigned xb_ld(unsigned* p)              { return __hip_atomic_load(p, __ATOMIC_RELAXED, __HIP_MEMORY_SCOPE_AGENT); }
__device__ __forceinline__ unsigned xb_add(unsigned* p, unsigned v) { return __hip_atomic_fetch_add(p, v, __ATOMIC_RELAXED, __HIP_MEMORY_SCOPE_AGENT); }
__device__ __forceinline__ unsigned xb_xcc_id() { return (unsigned)__builtin_amdgcn_s_getreg((3 << 11) | 20) & 0xFu; }
#define XB_SPIN(cond, bar) do { unsigned _sp = 0; while (cond) { __builtin_amdgcn_s_sleep(1); \
    if ((++_sp & 255u) == 0u) { if (xb_ld(&(bar)[XB_TMO])) break; if (_sp > XB_SPIN_CAP) { atomicAdd(&(bar)[XB_TMO], 1u); break; } } } } while (0)
struct XcdBarrier { unsigned* bar; unsigned x; volatile LAS unsigned* st; };
__device__ __forceinline__ XcdBarrier xcd_barrier_post(unsigned* bar, volatile LAS unsigned* st) {
    XcdBarrier b; b.bar = bar; b.x = xb_xcc_id(); b.st = st;
    if (threadIdx.x == 0) (void)xb_add(&bar[XB_XCNT(b.x)], 1u);
    return b;
}
__device__ __forceinline__ void xcd_barrier_complete(unsigned* bar, unsigned x, unsigned& nloc, unsigned& nx) {
    const unsigned G = gridDim.x * gridDim.y * gridDim.z;
    unsigned sum, cnt, mine, sp = 0u;
    for (;;) {
        sum = 0u; cnt = 0u; mine = 0u;
#pragma unroll
        for (unsigned j = 0; j < 16; ++j) { const unsigned c = xb_ld(&bar[XB_XCNT(j)]); sum += c; cnt += (c > 0u) ? 1u : 0u; mine = (j == x) ? c : mine; }
        if (sum == G) break;
        __builtin_amdgcn_s_sleep(1);
        if ((++sp & 255u) == 0u) { if (xb_ld(&bar[XB_TMO])) break; if (sp > XB_SPIN_CAP) { atomicAdd(&bar[XB_TMO], 1u); break; } }
    }
    nloc = mine > 0u ? mine : 1u; nx = cnt > 0u ? cnt : 1u;
}
__device__ __forceinline__ void xcd_barrier(const XcdBarrier& b) {
    asm volatile("s_waitcnt vmcnt(0)" ::: "memory");
    __syncthreads();
    if (threadIdx.x == 0) {
        unsigned* bar = b.bar;
        __builtin_amdgcn_s_waitcnt(0);
        unsigned nloc = b.st[0], nx = b.st[1];
        if (nloc == 0u) { xcd_barrier_complete(bar, b.x, nloc, nx); b.st[0] = nloc; b.st[1] = nx; }
        const unsigned old = xb_add(&bar[XB_XSUB(b.x)], 1u);
        const unsigned gen = old / nloc;
        if (old + 1u == (gen + 1u) * nloc) {
            __builtin_amdgcn_fence(__ATOMIC_RELEASE, "agent");
            asm volatile("s_waitcnt vmcnt(0)" ::: "memory");
            const unsigned og = xb_add(&bar[XB_TOP], 1u);
            const unsigned tg = og / nx;
            if (og + 1u == (tg + 1u) * nx) xb_add(&bar[XB_TOPGEN], 1u);
            else XB_SPIN(xb_ld(&bar[XB_TOPGEN]) == tg, bar);
            __builtin_amdgcn_fence(__ATOMIC_ACQUIRE, "agent");
            xb_add(&bar[XB_XGEN(b.x)], 1u);
            asm volatile("s_waitcnt vmcnt(0)" ::: "memory");
        } else {
            XB_SPIN(xb_ld(&bar[XB_XGEN(b.x)]) == gen, bar);
            __builtin_amdgcn_fence(__ATOMIC_ACQUIRE, "agent");
            asm volatile("s_waitcnt vmcnt(0)" ::: "memory");
        }
    }
    __syncthreads();
    __builtin_amdgcn_fence(__ATOMIC_ACQUIRE, "agent");
    asm volatile("s_waitcnt vmcnt(0)" ::: "memory");
}

struct Args {
    const float* x; const float* c; const float* ctx; const float* c_ctx; const float* w_ada; const float* b_ada; const float* w_in; const float* conv_w;
    const float* a_log; const float* dt_bias; const float* gdn_norm_w; const float* q_norm_w; const float* k_norm_w;
    const float* lq1; const float* lk1; const float* lq2; const float* lk2; const float* diff_norm_w; const float* w_oa; const float* w_ob; const float* w_out;
    float* out; unsigned char* ws;
};

__device__ __forceinline__ float wave_sum(float v) {
#pragma unroll
    for (int o = 1; o < 64; o <<= 1) v += __shfl_xor(v, o);
    return v;
}

__device__ __forceinline__ int w1_src(int n) { if (n < 3072) return n; if (n < 4096) return 4128 + (n - 3072); if (n < 5120) return 5152 + (n - 4096); if (n < 6144) return 6176 + (n - 5120);
    if (n < 6176) return 4096 + (n - 6144); return -1; }
__device__ __forceinline__ int w2_src(int n) { if (n < 1024) return 3072 + n; if (n < 2048) return 7200 + (n - 1024); return 8224 + (n - 2048); }
__device__ __forceinline__ void transpose_item(const float* W, int ldw, int c0, bf16* WT, int n0, int k0, LAS float* scr, int lane) {
#pragma unroll 8
    for (int i = 0; i < 32; ++i) { const int kk = 2 * i + (lane >> 5); scr[kk * 33 + (lane & 31)] = (c0 >= 0) ? W[(size_t)(k0 + kk) * ldw + c0 + (lane & 31)] : 0.f; }
    asm volatile("s_waitcnt lgkmcnt(0)" ::: "memory");
    const int c = lane & 7;
#pragma unroll
    for (int j = 0; j < 4; ++j) { const int n = (lane >> 3) + 8 * j; const LAS float* s = scr + (8 * c) * 33 + n;
        v4u o; o.x = pk2(s[0 * 33], s[1 * 33]); o.y = pk2(s[2 * 33], s[3 * 33]); o.z = pk2(s[4 * 33], s[5 * 33]); o.w = pk2(s[6 * 33], s[7 * 33]);
        *(v4u*)(WT + (size_t)(n0 + n) * 1024 + k0 + 8 * c) = o; }
    asm volatile("s_waitcnt lgkmcnt(0)" ::: "memory");
}

template <class Epi>
__device__ __forceinline__ void gemm_naive(unsigned char* ldsg, const bf16* A, const bf16* Bt, int M, int N, int K, const Epi& epi) {
    float* As = (float*)ldsg; float* Bs = As + 32 * 132;
    const int tid = threadIdx.x, ty = tid >> 4, tx = tid & 15;
    const int nM = M / 128, nN = N / 128;
    for (int unit = blockIdx.x; unit < nM * nN; unit += gridDim.x) {
        const int pm = unit / nN, pn = unit % nN;
        float acc[4][8];
#pragma unroll
        for (int i = 0; i < 4; ++i)
#pragma unroll
            for (int j = 0; j < 8; ++j) acc[i][j] = 0.f;
        const int srow = tid >> 2, skc = (tid & 3) * 8;
        for (int k0 = 0; k0 < K; k0 += 32) {
            const v4u av = *(const v4u*)(A + (size_t)(pm * 128 + srow) * K + k0 + skc);
            const v4u bv = *(const v4u*)(Bt + (size_t)(pn * 128 + srow) * K + k0 + skc);
            As[(skc + 0) * 132 + srow] = bflo(av.x); As[(skc + 1) * 132 + srow] = bfhi(av.x); As[(skc + 2) * 132 + srow] = bflo(av.y); As[(skc + 3) * 132 + srow] = bfhi(av.y);
            As[(skc + 4) * 132 + srow] = bflo(av.z); As[(skc + 5) * 132 + srow] = bfhi(av.z); As[(skc + 6) * 132 + srow] = bflo(av.w); As[(skc + 7) * 132 + srow] = bfhi(av.w);
            Bs[(skc + 0) * 132 + srow] = bflo(bv.x); Bs[(skc + 1) * 132 + srow] = bfhi(bv.x); Bs[(skc + 2) * 132 + srow] = bflo(bv.y); Bs[(skc + 3) * 132 + srow] = bfhi(bv.y);
            Bs[(skc + 4) * 132 + srow] = bflo(bv.z); Bs[(skc + 5) * 132 + srow] = bfhi(bv.z); Bs[(skc + 6) * 132 + srow] = bflo(bv.w); Bs[(skc + 7) * 132 + srow] = bfhi(bv.w);
            __syncthreads();
#pragma unroll 8
            for (int kk = 0; kk < 32; ++kk) {
                const f32x4 a = *(const f32x4*)(As + kk * 132 + ty * 4);
                const f32x4 b0 = *(const f32x4*)(Bs + kk * 132 + tx * 8), b1 = *(const f32x4*)(Bs + kk * 132 + tx * 8 + 4);
#pragma unroll
                for (int i = 0; i < 4; ++i) { acc[i][0] += a[i] * b0[0]; acc[i][1] += a[i] * b0[1]; acc[i][2] += a[i] * b0[2]; acc[i][3] += a[i] * b0[3];
                    acc[i][4] += a[i] * b1[0]; acc[i][5] += a[i] * b1[1]; acc[i][6] += a[i] * b1[2]; acc[i][7] += a[i] * b1[3]; }
            }
            __syncthreads();
        }
#pragma unroll
        for (int i = 0; i < 4; ++i)
#pragma unroll
            for (int j = 0; j < 8; ++j) epi(pm * 128 + ty * 4 + i, pn * 128 + tx * 8 + j, acc[i][j]);
    }
}

struct EpiR1 { bf16* QKV; bf16* QB; bf16* KB; bf16* VB; float* AB;
    __device__ __forceinline__ void operator()(int r, int c, float v) const {
        if (c < 3072) QKV[(size_t)r * 3072 + c] = (bf16)f2bf(v);
        else if (c < 4096) { if (r < MLAT) QB[(size_t)r * 1024 + (c - 3072)] = (bf16)f2bf(v); }
        else if (c < 5120) KB[(size_t)r * 1024 + (c - 4096)] = (bf16)f2bf(v);
        else if (c < 6144) VB[(size_t)r * 1024 + (c - 5120)] = (bf16)f2bf(v);
        else if (c < 6176) AB[(size_t)r * 32 + (c - 6144)] = v;
    } };
struct EpiR2 { bf16* NA; bf16* QB; bf16* GATES;
    __device__ __forceinline__ void operator()(int r, int c, float v) const {
        if (c < 1024) { bf16* p = NA + (size_t)r * 1024 + c; *p = (bf16)f2bf(silu_f(v) * bf2f(*p)); }
        else if (c < 2048) { bf16* p = QB + (size_t)r * 1024 + (c - 1024); *p = (bf16)f2bf(0.8f * silu_f(v) * bf2f(*p)); }
        else GATES[(size_t)r * 2048 + (c - 2048)] = (bf16)f2bf(sigmoid_f(v));
    } };
struct EpiR2Chk { bf16* NA; bf16* QB; bf16* GATES; const bf16* YA2; const bf16* YB2; unsigned* cnt;
    __device__ __forceinline__ void operator()(int r, int c, float v) const {
        float ref, got;
        if (c < 1024) { bf16* p = NA + (size_t)r * 1024 + c; ref = silu_f(v) * bf2f(YA2[(size_t)r * 1024 + c]); got = bf2f(*p); *p = (bf16)f2bf(ref); if (fabsf(ref - got) > 0.02f * fabsf(ref) + 0.01f) atomicAdd(cnt + 0, 1u); }
        else if (c < 2048) { bf16* p = QB + (size_t)r * 1024 + (c - 1024); ref = 0.8f * silu_f(v) * bf2f(YB2[(size_t)r * 1024 + (c - 1024)]); got = bf2f(*p); *p = (bf16)f2bf(ref); if (fabsf(ref - got) > 0.02f * fabsf(ref) + 0.01f) atomicAdd(cnt + 1, 1u); }
        else { bf16* p = GATES + (size_t)r * 2048 + (c - 2048); ref = sigmoid_f(v); got = bf2f(*p); *p = (bf16)f2bf(ref); if (fabsf(ref - got) > 0.02f) atomicAdd(cnt + 2, 1u); }
    } };
struct EpiF1 { bf16* T1; const bf16* GATES;
    __device__ __forceinline__ void operator()(int r, int c, float v) const { T1[(size_t)r * 1024 + c] = (bf16)f2bf(v * bf2f(GATES[(size_t)r * 2048 + c])); } };
struct EpiF2 { bf16* MERGED; const bf16* T1; const bf16* GATES;
    __device__ __forceinline__ void operator()(int r, int c, float v) const { MERGED[(size_t)r * 1024 + c] = (bf16)f2bf(bf2f(T1[(size_t)r * 1024 + c]) + v * bf2f(GATES[(size_t)r * 2048 + 1024 + c])); } };
struct EpiG { float* out; const float* x; const float* mod;
    __device__ __forceinline__ void operator()(int r, int c, float v) const { const int b = r / SEQ; out[(size_t)r * 1024 + c] = x[(size_t)r * 1024 + c] + mod[b * 3072 + 2048 + c] * v; } };

namespace pg8 {
#define PG8_LAS __attribute__((address_space(3)))
typedef unsigned short bf16_t;
typedef short bf16x8 __attribute__((ext_vector_type(8)));
typedef float f32x4 __attribute__((ext_vector_type(4)));
typedef unsigned u32x4 __attribute__((ext_vector_type(4)));
constexpr int BM = 256, BK = 64, HALF = 128, HTB = HALF * BK * 2  , STAGE_BYTES = 8 * HTB, NXCD = 8, WGM = 8;

__host__ __device__ __forceinline__ int lds_byte(int r, int c) { const int st = (r >> 4) * 2 + (c >> 5), rr = r & 15, cc = c & 31, ob = rr * 64 + cc * 2; return st * 1024 + (ob ^ (((ob >> 9) & 1) << 5)); }
__host__ __device__ __forceinline__ void stage_rc(int b, int& R, int& C) { const int st = b / 1024, sb = b % 1024, swz = sb ^ (((sb >> 9) & 1) << 5); R = (st >> 1) * 16 + swz / 64; C = (st & 1) * 32 + (swz % 64) / 2; }
__host__ __device__ __forceinline__ int perm32(int rho) { const int n = rho >> 4, i = rho & 15; return 8 * (i >> 2) + 4 * n + (i & 3); }

struct Unit { int pm, pn; };
struct Gemm { const bf16_t* A; const bf16_t* Bt; int M, N, K; };

struct StaticOrder {
    int nM, nN, nwg, G, c;
    __host__ __device__ void init(int M, int N, int G_, int c_) { nM = M / BM; nN = N / BM; nwg = nM * nN; G = G_; c = c_; }
    __host__ __device__ bool next(int i, Unit& u) const {
        const long L = (long)i * G + c; if (L >= nwg) return false;
        int wgid = (int)L; { const int q = nwg / NXCD, r = nwg % NXCD, xcd = wgid % NXCD, off = wgid / NXCD; wgid = (xcd < r ? xcd * (q + 1) : r * (q + 1) + (xcd - r) * q) + off; }
        const int nig = WGM * nN, gid = wgid / nig, fm = gid * WGM, gsz = (nM - fm) < WGM ? (nM - fm) : WGM;
        u.pm = fm + ((wgid % nig) % gsz); u.pn = (wgid % nig) / gsz; return true;
    }
    __device__ __forceinline__ void a_ready(const Unit&) const {}
    __device__ __forceinline__ void done(const Unit&) const {}
};

__device__ __forceinline__ unsigned cvt_pk_bf16(float lo, float hi) { unsigned r; asm volatile("v_cvt_pk_bf16_f32 %0, %1, %2" : "=v"(r) : "v"(lo), "v"(hi)); return r; }
__device__ __forceinline__ float silu_e(float x) { return x * __builtin_amdgcn_rcpf(1.f + __expf(-x)); }
__device__ __forceinline__ float sigm_e(float x) { return __builtin_amdgcn_rcpf(1.f + __expf(-x)); }
__device__ __forceinline__ float blo(unsigned w) { return __builtin_bit_cast(float, w << 16); }
__device__ __forceinline__ float bhi(unsigned w) { return __builtin_bit_cast(float, w & 0xffff0000u); }
__device__ __forceinline__ u32x4 pack8(const f32x4 v0, const f32x4 v1) { u32x4 w; w.x = cvt_pk_bf16(v0[0], v0[1]); w.y = cvt_pk_bf16(v0[2], v0[3]); w.z = cvt_pk_bf16(v1[0], v1[1]); w.w = cvt_pk_bf16(v1[2], v1[3]); return w; }
struct EpiR1 {
    static constexpr bool PERM = true, AFTER_DRAIN = false;
    bf16_t* QKV; bf16_t* QB; bf16_t* KB; bf16_t* VB; float* AB; int mlat_tiles;
    __device__ __forceinline__ void operator()(const f32x4 (&acc)[2][2][4][2], const Unit& u, int wr, int wc, int fr, int fq) const {
        const int row0 = u.pm * BM + wr * 64 + fr, cl = wc * 32 + 8 * fq;
        bf16_t* base; int ldc, colt;
        if (u.pn < 12) { base = QKV; ldc = 3072; colt = u.pn * 256; }
        else if (u.pn < 16) { if (u.pm >= mlat_tiles) return; base = QB; ldc = 1024; colt = (u.pn - 12) * 256; }
        else if (u.pn < 20) { base = KB; ldc = 1024; colt = (u.pn - 16) * 256; }
        else if (u.pn < 24) { base = VB; ldc = 1024; colt = (u.pn - 20) * 256; }
        else {
            if (wc == 0) {
#pragma unroll
                for (int ai = 0; ai < 2; ++ai)
#pragma unroll
                    for (int m = 0; m < 4; ++m) { float* p = AB + (size_t)(row0 + ai * HALF + m * 16) * 32 + 8 * fq; *(f32x4*)p = acc[ai][0][m][0]; *(f32x4*)(p + 4) = acc[ai][0][m][1]; }
            }
            return;
        }
#pragma unroll
        for (int ai = 0; ai < 2; ++ai)
#pragma unroll
            for (int m = 0; m < 4; ++m) { bf16_t* rowp = base + (size_t)(row0 + ai * HALF + m * 16) * ldc + colt + cl;
#pragma unroll
                for (int bj = 0; bj < 2; ++bj) *(u32x4*)(rowp + bj * HALF) = pack8(acc[ai][bj][m][0], acc[ai][bj][m][1]); }
    }
};
struct EpiR2 {
    static constexpr bool PERM = true, AFTER_DRAIN = false;
    bf16_t* NA; bf16_t* QB; bf16_t* GATES; bf16_t* YA2; bf16_t* YB2;
    __device__ __forceinline__ void operator()(const f32x4 (&acc)[2][2][4][2], const Unit& u, int wr, int wc, int fr, int fq) const {
        const int row0 = u.pm * BM + wr * 64 + fr, cl = wc * 32 + 8 * fq;
        if (u.pn >= 8) {
            const int colt = (u.pn - 8) * 256;
#pragma unroll
            for (int ai = 0; ai < 2; ++ai)
#pragma unroll
                for (int m = 0; m < 4; ++m) { bf16_t* rowp = GATES + (size_t)(row0 + ai * HALF + m * 16) * 2048 + colt + cl;
#pragma unroll
                    for (int bj = 0; bj < 2; ++bj) { f32x4 v0 = acc[ai][bj][m][0], v1 = acc[ai][bj][m][1];
#pragma unroll
                        for (int i = 0; i < 4; ++i) { v0[i] = sigm_e(v0[i]); v1[i] = sigm_e(v1[i]); }
                        *(u32x4*)(rowp + bj * HALF) = pack8(v0, v1); } }
            return;
        }
        if (R2_SKIP_Z) return;
        bf16_t* base = (u.pn < 4) ? NA : QB; bf16_t* dst = (u.pn < 4) ? YA2 : YB2; const float sc = (u.pn < 4) ? 1.0f : 0.8f; const int colt = (u.pn & 3) * 256;
#pragma unroll
        for (int ai = 0; ai < 2; ++ai)
#pragma unroll
            for (int m = 0; m < 4; ++m) { bf16_t* rowp = base + (size_t)(row0 + ai * HALF + m * 16) * 1024 + colt + cl; bf16_t* rowd = dst + (size_t)(row0 + ai * HALF + m * 16) * 1024 + colt + cl;
#pragma unroll
                for (int bj = 0; bj < 2; ++bj) { const u32x4 old = *(const u32x4*)(rowp + bj * HALF); f32x4 v0 = acc[ai][bj][m][0], v1 = acc[ai][bj][m][1];
                    v0[0] = silu_e(v0[0]) * sc * blo(old.x); v0[1] = silu_e(v0[1]) * sc * bhi(old.x); v0[2] = silu_e(v0[2]) * sc * blo(old.y); v0[3] = silu_e(v0[3]) * sc * bhi(old.y);
                    v1[0] = silu_e(v1[0]) * sc * blo(old.z); v1[1] = silu_e(v1[1]) * sc * bhi(old.z); v1[2] = silu_e(v1[2]) * sc * blo(old.w); v1[3] = silu_e(v1[3]) * sc * bhi(old.w);
                    *(u32x4*)(rowd + bj * HALF) = pack8(v0, v1); } }
    }
};
struct EpiF {
    static constexpr bool PERM = true, AFTER_DRAIN = false;
    bf16_t* OUT; const bf16_t* T1; const bf16_t* GATES; int mode;
    __device__ __forceinline__ void operator()(const f32x4 (&acc)[2][2][4][2], const Unit& u, int wr, int wc, int fr, int fq) const {
        const int row0 = u.pm * BM + wr * 64 + fr, col0 = u.pn * BM + wc * 32 + 8 * fq;
#pragma unroll
        for (int ai = 0; ai < 2; ++ai)
#pragma unroll
            for (int m = 0; m < 4; ++m) { const size_t r = (size_t)(row0 + ai * HALF + m * 16);
#pragma unroll
                for (int bj = 0; bj < 2; ++bj) { const int c = col0 + bj * HALF;
                    const u32x4 g = *(const u32x4*)(GATES + r * 2048 + mode * 1024 + c); f32x4 v0 = acc[ai][bj][m][0], v1 = acc[ai][bj][m][1];
                    v0[0] *= blo(g.x); v0[1] *= bhi(g.x); v0[2] *= blo(g.y); v0[3] *= bhi(g.y); v1[0] *= blo(g.z); v1[1] *= bhi(g.z); v1[2] *= blo(g.w); v1[3] *= bhi(g.w);
                    if (mode) { const u32x4 t = *(const u32x4*)(T1 + r * 1024 + c);
                        v0[0] += blo(t.x); v0[1] += bhi(t.x); v0[2] += blo(t.y); v0[3] += bhi(t.y); v1[0] += blo(t.z); v1[1] += bhi(t.z); v1[2] += blo(t.w); v1[3] += bhi(t.w); }
                    *(u32x4*)(OUT + r * 1024 + c) = pack8(v0, v1); } }
    }
};
struct EpiG {
    static constexpr bool PERM = true, AFTER_DRAIN = false;
    float* out; const float* x; const float* mod; int tiles_per_batch;
    __device__ __forceinline__ void operator()(const f32x4 (&acc)[2][2][4][2], const Unit& u, int wr, int wc, int fr, int fq) const {
        const int row0 = u.pm * BM + wr * 64 + fr, col0 = u.pn * BM + wc * 32 + 8 * fq; const int b = u.pm / tiles_per_batch;
        f32x4 gv[2][2];
#pragma unroll
        for (int bj = 0; bj < 2; ++bj) { gv[bj][0] = *(const f32x4*)(mod + b * 3072 + 2048 + col0 + bj * HALF); gv[bj][1] = *(const f32x4*)(mod + b * 3072 + 2048 + col0 + bj * HALF + 4); }
#pragma unroll
        for (int ai = 0; ai < 2; ++ai)
#pragma unroll
            for (int m = 0; m < 4; ++m) { const size_t off = (size_t)(row0 + ai * HALF + m * 16) * 1024 + col0;
#pragma unroll
                for (int bj = 0; bj < 2; ++bj) { const f32x4 x0 = *(const f32x4*)(x + off + bj * HALF), x1 = *(const f32x4*)(x + off + bj * HALF + 4);
                    *(f32x4*)(out + off + bj * HALF) = x0 + gv[bj][0] * acc[ai][bj][m][0]; *(f32x4*)(out + off + bj * HALF + 4) = x1 + gv[bj][1] * acc[ai][bj][m][1]; } }
    }
};
template <class Epi, class Sched, bool ALIGN_EPI = false, bool SP2 = false>
__device__ __forceinline__ void gemm_phase(PG8_LAS unsigned char* lds, const Gemm g, const Sched& S, const Epi& E) {
    int tid_ = threadIdx.x; asm volatile("" : "+v"(tid_));
    const int tid = tid_, wid = __builtin_amdgcn_readfirstlane(tid >> 6), lane = tid & 63, wr = wid >> 2, wc = wid & 3, fr = lane & 15, fq = lane >> 4;
    const int K = g.K, nt = K / BK;
    unsigned voffA[2], voffB[2];
#pragma unroll
    for (int i = 0; i < 2; ++i) { int R, C; stage_rc(tid * 16 + i * 8192, R, C); const int Rb = Epi::PERM ? ((R & ~31) + perm32(R & 31)) : R;
        voffA[i] = (unsigned)(R * K + C) * 2u; voffB[i] = (unsigned)(Rb * K + C) * 2u; }
    const size_t kstep = (size_t)(BK * 2);
    const size_t hstep = (size_t)HALF * K * 2;
    const size_t tstep = 2 * hstep;
    const unsigned ldsw = (unsigned)wid * 1024u;
    const int aoff = lds_byte(wr * 64 + fr, fq * 8), boff = lds_byte(wc * 32 + fr, fq * 8);
#define PG8_SA(b, h) (((b) * 2 + (h)) * HTB)
#define PG8_SB(b, h) ((4 + (b) * 2 + (h)) * HTB)
#define PG8_STAGE(bufoff, gbase, voff) do { _Pragma("unroll") for (int _i = 0; _i < 2; ++_i) \
        __builtin_amdgcn_global_load_lds((const unsigned*)((const char*)(gbase) + (voff)[_i]), (PG8_LAS unsigned*)(lds + (bufoff) + ldsw + _i * 8192), 16, 0, 0); } while (0)
#define PG8_LDA(dst, b, h) do { _Pragma("unroll") for (int m = 0; m < 4; ++m) _Pragma("unroll") for (int k = 0; k < 2; ++k) dst[m][k] = *(const PG8_LAS bf16x8*)(lds + PG8_SA(b, h) + aoff + m * 2048 + k * 1024); } while (0)
#define PG8_LDB(dst, b, h) do { _Pragma("unroll") for (int n = 0; n < 2; ++n) _Pragma("unroll") for (int k = 0; k < 2; ++k) dst[n][k] = *(const PG8_LAS bf16x8*)(lds + PG8_SB(b, h) + boff + n * 2048 + k * 1024); } while (0)
#define PG8_MMA(ai, bj, At, Bt) do { __builtin_amdgcn_s_setprio(1); _Pragma("unroll") for (int m = 0; m < 4; ++m) _Pragma("unroll") for (int n = 0; n < 2; ++n) _Pragma("unroll") for (int k = 0; k < 2; ++k) \
        acc[ai][bj][m][n] = __builtin_amdgcn_mfma_f32_16x16x32_bf16(Bt[n][k], At[m][k], acc[ai][bj][m][n], 0, 0, 0); __builtin_amdgcn_s_setprio(0); } while (0)
#define PG8_WAIT_V(n) asm volatile("s_waitcnt vmcnt(" #n ")" ::: "memory")
#define PG8_WAIT_L(n) asm volatile("s_waitcnt lgkmcnt(" #n ")" ::: "memory")
#define PG8_BAR __builtin_amdgcn_s_barrier()
#define PG8_SCHED __builtin_amdgcn_sched_barrier(0)
    Unit cur, nxt; int ui = 0;
    if (!S.next(0, cur)) return;
    f32x4 acc[2][2][4][2];
#pragma unroll
    for (int a = 0; a < 2; ++a)
#pragma unroll
        for (int b = 0; b < 2; ++b)
#pragma unroll
            for (int m = 0; m < 4; ++m)
#pragma unroll
                for (int n = 0; n < 2; ++n) acc[a][b][m][n] = (f32x4){0.f, 0.f, 0.f, 0.f};
    bf16x8 At[4][2], B0[2][2], B1[2][2];
    const char* cA = (const char*)g.A + (size_t)cur.pm * tstep; const char* cB = (const char*)g.Bt + (size_t)cur.pn * tstep;
    S.a_ready(cur);
    if constexpr (SP2) {
        PG8_STAGE(PG8_SB(0, 0), cB, voffB); PG8_STAGE(PG8_SB(0, 1), cB + hstep, voffB); PG8_STAGE(PG8_SA(0, 0), cA, voffA); PG8_STAGE(PG8_SA(0, 1), cA + hstep, voffA);
        if (wr == 1) PG8_BAR;
        PG8_WAIT_V(2); PG8_BAR;
        PG8_STAGE(PG8_SB(1, 0), cB + kstep, voffB); PG8_STAGE(PG8_SA(1, 0), cA + kstep, voffA); PG8_STAGE(PG8_SB(1, 1), cB + hstep + kstep, voffB);
        PG8_WAIT_V(6); PG8_BAR;
    } else {
        PG8_STAGE(PG8_SB(0, 0), cB, voffB); PG8_STAGE(PG8_SA(0, 0), cA, voffA); PG8_STAGE(PG8_SB(0, 1), cB + hstep, voffB); PG8_STAGE(PG8_SA(0, 1), cA + hstep, voffA);
        if (wr == 1) PG8_BAR;
        PG8_WAIT_V(4); PG8_BAR;
        PG8_STAGE(PG8_SB(1, 0), cB + kstep, voffB); PG8_STAGE(PG8_SA(1, 0), cA + kstep, voffA); PG8_STAGE(PG8_SB(1, 1), cB + hstep + kstep, voffB);
        PG8_WAIT_V(6); PG8_BAR;
    }
    for (;;) {
        const bool has_next = S.next(ui + 1, nxt);
        const char* nA = has_next ? (const char*)g.A + (size_t)nxt.pm * tstep : cA; const char* nB = has_next ? (const char*)g.Bt + (size_t)nxt.pn * tstep : cB;
        for (int t = 0; t < nt; t += 2) {
            const bool last = (t == nt - 2);
            const char* a1 = cA + (size_t)(t + 1) * kstep;
            const char* a2 = last ? nA : cA + (size_t)(t + 2) * kstep; const char* b2 = last ? nB : cB + (size_t)(t + 2) * kstep;
            const char* a3 = a2 + kstep; const char* b3 = b2 + kstep;
            if (last && has_next) S.a_ready(nxt);
            if constexpr (SP2) {
            PG8_LDB(B0, 0, 0); PG8_LDB(B1, 0, 1); PG8_SCHED; PG8_LDA(At, 0, 0); PG8_STAGE(PG8_SA(1, 1), a1 + hstep, voffA);
            PG8_WAIT_V(8); PG8_WAIT_L(0); PG8_BAR; PG8_MMA(0, 0, At, B0); PG8_MMA(0, 1, At, B1); PG8_BAR; PG8_SCHED;
            PG8_LDA(At, 0, 1); PG8_STAGE(PG8_SB(0, 0), b2, voffB); PG8_STAGE(PG8_SB(0, 1), b2 + hstep, voffB); PG8_STAGE(PG8_SA(0, 0), a2, voffA);
            PG8_WAIT_V(8); PG8_WAIT_L(0); PG8_BAR; PG8_MMA(1, 0, At, B0); PG8_MMA(1, 1, At, B1); PG8_BAR; PG8_SCHED;
            PG8_LDB(B0, 1, 0); PG8_LDB(B1, 1, 1); PG8_SCHED; PG8_LDA(At, 1, 0); PG8_STAGE(PG8_SA(0, 1), a2 + hstep, voffA);
            PG8_WAIT_V(8); PG8_WAIT_L(0); PG8_BAR; PG8_MMA(0, 0, At, B0); PG8_MMA(0, 1, At, B1); PG8_BAR; PG8_SCHED;
            PG8_LDA(At, 1, 1); PG8_STAGE(PG8_SB(1, 0), b3, voffB); PG8_STAGE(PG8_SB(1, 1), b3 + hstep, voffB); PG8_STAGE(PG8_SA(1, 0), a3, voffA);
            PG8_WAIT_V(8); PG8_WAIT_L(0); PG8_BAR; PG8_MMA(1, 0, At, B0); PG8_MMA(1, 1, At, B1); PG8_BAR; PG8_SCHED;
            } else {
            PG8_LDB(B0, 0, 0); PG8_SCHED; PG8_LDA(At, 0, 0); PG8_STAGE(PG8_SA(1, 1), a1 + hstep, voffA);
            PG8_WAIT_L(8); PG8_BAR; PG8_WAIT_L(0); PG8_MMA(0, 0, At, B0); PG8_BAR; PG8_SCHED;
            PG8_LDB(B1, 0, 1); PG8_STAGE(PG8_SB(0, 0), b2, voffB);
            PG8_BAR; PG8_WAIT_L(0); PG8_MMA(0, 1, At, B1); PG8_BAR;
            PG8_LDA(At, 0, 1); PG8_STAGE(PG8_SA(0, 0), a2, voffA);
            PG8_BAR; PG8_WAIT_L(0); PG8_MMA(1, 0, At, B0); PG8_BAR; PG8_SCHED;
            PG8_STAGE(PG8_SB(0, 1), b2 + hstep, voffB);
            PG8_WAIT_V(6); PG8_BAR; PG8_MMA(1, 1, At, B1); PG8_BAR;
            PG8_LDB(B0, 1, 0); PG8_SCHED; PG8_LDA(At, 1, 0); PG8_STAGE(PG8_SA(0, 1), a2 + hstep, voffA);
            PG8_WAIT_L(8); PG8_BAR; PG8_WAIT_L(0); PG8_MMA(0, 0, At, B0); PG8_BAR; PG8_SCHED;
            PG8_LDB(B1, 1, 1); PG8_STAGE(PG8_SB(1, 0), b3, voffB);
            PG8_BAR; PG8_WAIT_L(0); PG8_MMA(0, 1, At, B1); PG8_BAR;
            PG8_LDA(At, 1, 1); PG8_STAGE(PG8_SA(1, 0), a3, voffA);
            PG8_BAR; PG8_WAIT_L(0); PG8_MMA(1, 0, At, B0); PG8_BAR; PG8_SCHED;
            PG8_STAGE(PG8_SB(1, 1), b3 + hstep, voffB);
            PG8_WAIT_V(6); PG8_BAR; PG8_MMA(1, 1, At, B1); PG8_BAR;
            }
        }
        if constexpr (ALIGN_EPI) { if (wr == 0) PG8_BAR; }
        if constexpr (!Epi::AFTER_DRAIN) { E(acc, cur, wr, wc, fr, fq); S.done(cur); }
        if (!has_next) break;
#pragma unroll
        for (int a = 0; a < 2; ++a)
#pragma unroll
            for (int b = 0; b < 2; ++b)
#pragma unroll
                for (int m = 0; m < 4; ++m)
#pragma unroll
                    for (int n = 0; n < 2; ++n) acc[a][b][m][n] = (f32x4){0.f, 0.f, 0.f, 0.f};
        cur = nxt; cA = nA; cB = nB; ++ui;
        if constexpr (ALIGN_EPI) { if (wr == 1) PG8_BAR; }
    }
    PG8_WAIT_V(0);
    if constexpr (!ALIGN_EPI) { if (wr == 0) PG8_BAR; }
    PG8_BAR;
    if constexpr (Epi::AFTER_DRAIN) { E.fused(acc, cur, wr, wc, fr, fq, lds, wid, lane); S.done(cur); }
#undef PG8_SA
#undef PG8_SB
#undef PG8_STAGE
#undef PG8_LDA
#undef PG8_LDB
#undef PG8_MMA
#undef PG8_WAIT_V
#undef PG8_WAIT_L
#undef PG8_BAR
#undef PG8_SCHED
}
}

namespace att {
using bf16x8 = __attribute__((ext_vector_type(8))) short;
using s16x4  = __attribute__((ext_vector_type(4))) short;
using f32x16 = __attribute__((ext_vector_type(16))) float;
using u32x4  = __attribute__((ext_vector_type(4))) unsigned;
constexpr int KVBLK = 64, NTILES = (LCTX + SEQ) / KVBLK;
constexpr int SHM_V = KVBLK * 128 * 2, SHM_K = KVBLK * 128 * 2;
constexpr int LDS_WS = 2 * SHM_V + 2 * SHM_K;
#define KSWZ(row, colB) ((row) * 256 + ((colB) ^ (((row) & 7) << 4)))
#define SBAR() __builtin_amdgcn_sched_barrier(0)
__device__ __forceinline__ int crow(int r, int hi) { return (r & 3) + 8 * (r >> 2) + 4 * hi; }
__device__ __forceinline__ unsigned cvtpk(float lo, float hi) { unsigned r; asm volatile("v_cvt_pk_bf16_f32 %0, %1, %2" : "=v"(r) : "v"(lo), "v"(hi)); return r; }
__device__ __forceinline__ int v_st(int k, int c) { const int kk = (k & ~0xC) | ((k & 4) << 1) | ((k & 8) >> 1); return ((kk >> 3) * 4 + (c >> 5)) * 512 + ((kk & 7) * 32 + (c & 31)) * 2; }
__device__ __forceinline__ int v_rd_base(int lane) { return ((lane & 3) << 3) | (((lane >> 2) & 3) << 6) | (((lane >> 4) & 1) << 5) | (((lane >> 5) & 1) << 8); }
constexpr int v_rd_off(int d0, int ks, int half) { return d0 * 512 + ks * 4096 + half * 2048; }
template <int OFF> __device__ __forceinline__ s16x4 tr_read(int vb) { s16x4 r; asm volatile("ds_read_b64_tr_b16 %0, %1 offset:%2" : "=&v"(r) : "v"(vb), "i"(OFF) : "memory"); return r; }
template <int D0> __device__ __forceinline__ void pv_one(f32x16& od, int vb, bf16x8 pa0, bf16x8 pa1, bf16x8 pa2, bf16x8 pa3) {
  const s16x4 l0 = tr_read<v_rd_off(D0, 0, 0)>(vb), h0 = tr_read<v_rd_off(D0, 0, 1)>(vb), l1 = tr_read<v_rd_off(D0, 1, 0)>(vb), h1 = tr_read<v_rd_off(D0, 1, 1)>(vb);
  const s16x4 l2 = tr_read<v_rd_off(D0, 2, 0)>(vb), h2 = tr_read<v_rd_off(D0, 2, 1)>(vb), l3 = tr_read<v_rd_off(D0, 3, 0)>(vb), h3 = tr_read<v_rd_off(D0, 3, 1)>(vb);
  asm volatile("s_waitcnt lgkmcnt(0)" ::: "memory"); SBAR();
#define PK(L, H) (bf16x8){L[0], L[1], L[2], L[3], H[0], H[1], H[2], H[3]}
  od = __builtin_amdgcn_mfma_f32_32x32x16_bf16(pa0, PK(l0, h0), od, 0, 0, 0);
  od = __builtin_amdgcn_mfma_f32_32x32x16_bf16(pa1, PK(l1, h1), od, 0, 0, 0);
  od = __builtin_amdgcn_mfma_f32_32x32x16_bf16(pa2, PK(l2, h2), od, 0, 0, 0);
  od = __builtin_amdgcn_mfma_f32_32x32x16_bf16(pa3, PK(l3, h3), od, 0, 0, 0);
#undef PK
}
__device__ __forceinline__ void pv_d0(f32x16* o, int vb, bf16x8 pa0, bf16x8 pa1, bf16x8 pa2, bf16x8 pa3) {
  pv_one<0>(o[0], vb, pa0, pa1, pa2, pa3); pv_one<1>(o[1], vb, pa0, pa1, pa2, pa3); pv_one<2>(o[2], vb, pa0, pa1, pa2, pa3); pv_one<3>(o[3], vb, pa0, pa1, pa2, pa3);
}
__device__ __forceinline__ void qkt(f32x16& p0, f32x16& p1, const char* Ks, const bf16x8* qr, int comp, int r32, int hi, float negm) {
#pragma unroll
  for (int r = 0; r < 16; ++r) { p0[r] = negm; p1[r] = negm; }
#pragma unroll
  for (int d0 = 0; d0 < 4; ++d0) { const int cb = ((comp * 4 + d0) * 16 + hi * 8) * 2;
    const bf16x8 b0 = *reinterpret_cast<const bf16x8*>(Ks + KSWZ(r32, cb));
    const bf16x8 b1 = *reinterpret_cast<const bf16x8*>(Ks + KSWZ(32 + r32, cb));
    p0 = __builtin_amdgcn_mfma_f32_32x32x16_bf16(b0, qr[d0], p0, 0, 0, 0);
    p1 = __builtin_amdgcn_mfma_f32_32x32x16_bf16(b1, qr[d0], p1, 0, 0, 0); }
}
__device__ __forceinline__ void partialSM(f32x16& p0) {
#pragma unroll
  for (int r = 0; r < 16; ++r) p0[r] = __builtin_amdgcn_exp2f(p0[r]);
}
__device__ __forceinline__ void finishSM(f32x16& p0, f32x16& p1, float& l_reg, bf16x8& pa0, bf16x8& pa1, bf16x8& pa2, bf16x8& pa3) {
#pragma unroll
  for (int r = 0; r < 16; ++r) p1[r] = __builtin_amdgcn_exp2f(p1[r]);
  float ps = 0.f;
#pragma unroll
  for (int r = 0; r < 16; ++r) ps += p0[r];
#pragma unroll
  for (int r = 0; r < 16; ++r) ps += p1[r];
  l_reg += ps;
#define PK4(P, BASE, OUT) do { unsigned a0 = cvtpk(P[BASE + 0], P[BASE + 1]), a1 = cvtpk(P[BASE + 2], P[BASE + 3]);   \
    unsigned b0 = cvtpk(P[BASE + 4], P[BASE + 5]), b1 = cvtpk(P[BASE + 6], P[BASE + 7]);                              \
    auto r0 = __builtin_amdgcn_permlane32_swap(a0, b0, false, false); auto r1 = __builtin_amdgcn_permlane32_swap(a1, b1, false, false); \
    u32x4 w = {r0[0], r1[0], r0[1], r1[1]}; OUT = *reinterpret_cast<bf16x8*>(&w); } while (0)
  PK4(p0, 0, pa0); PK4(p0, 8, pa1); PK4(p1, 0, pa2); PK4(p1, 8, pa3);
#undef PK4
}
__device__ __forceinline__ long tile_row(int b, int t) { return t < LCTX / KVBLK ? (long)(MLAT + b * LCTX + t * KVBLK) : (long)(b * SEQ + (t - LCTX / KVBLK) * KVBLK); }

__device__ __forceinline__ void attn_unit(int b, int h, int qb, unsigned short* QBm, const unsigned short* __restrict__ KBm, const unsigned short* __restrict__ VBm,
                                          const float* dnw, float lam, float negm, char* lds) {
  const int tid = threadIdx.x, wid = __builtin_amdgcn_readfirstlane(tid >> 6), lane = tid & 63, r32 = lane & 31, hi = lane >> 5, comp = wid >> 2, g = wid & 3;
  char* V_lds = lds; char* K_lds = lds + 2 * SHM_V;
  float* wsf = (float*)(lds + LDS_WS) + wid * 64;
  float l_reg = 0.f; f32x16 o[4] = {}; bf16x8 qr[4];
  const long qrow0 = (long)b * SEQ + qb * 128 + g * 32;
  const unsigned short* Qw = QBm + (qrow0 + r32) * 1024 + h * 128 + comp * 64 + hi * 8;
#pragma unroll
  for (int d0 = 0; d0 < 4; ++d0) qr[d0] = *reinterpret_cast<const bf16x8*>(Qw + d0 * 16);
  const int sr = tid >> 4, sc = (tid & 15) * 8, vst0 = v_st(sr, sc), vst1 = v_st(32 + sr, sc);
  const int vb0 = (int)(uintptr_t)V_lds + v_rd_base(lane);
  const unsigned short* Kh = KBm + h * 128 + sc; const unsigned short* Vh = VBm + h * 128 + sc;
  struct { bf16x8 vs0, vs1, ks0, ks1; } sr_[1];
#define SLOAD(i, t) do { const long _r = tile_row(b, (t)) + sr; sr_[i].vs0 = *reinterpret_cast<const bf16x8*>(Vh + _r * 1024); sr_[i].vs1 = *reinterpret_cast<const bf16x8*>(Vh + (_r + 32) * 1024); \
    sr_[i].ks0 = *reinterpret_cast<const bf16x8*>(Kh + _r * 1024); sr_[i].ks1 = *reinterpret_cast<const bf16x8*>(Kh + (_r + 32) * 1024); } while (0)
#define SWRITE(bb, i) do { *(bf16x8*)(V_lds + (bb) * SHM_V + vst0) = sr_[i].vs0; *(bf16x8*)(V_lds + (bb) * SHM_V + vst1) = sr_[i].vs1; const int kc = sc * 2; \
    *(bf16x8*)(K_lds + (bb) * SHM_K + KSWZ(sr, kc)) = sr_[i].ks0; *(bf16x8*)(K_lds + (bb) * SHM_K + KSWZ(32 + sr, kc)) = sr_[i].ks1; } while (0)
#define SWAIT() asm volatile("s_waitcnt vmcnt(0)" ::: "memory")
  f32x16 pA0, pA1, pB0, pB1; bf16x8 pa0, pa1, pa2, pa3; constexpr int NT = NTILES;
  constexpr int SE = 0, SO = 0;
  SLOAD(SE, 0); asm volatile("s_waitcnt vmcnt(0)" ::: "memory"); SWRITE(0, SE); __syncthreads();
  qkt(pA0, pA1, K_lds, qr, comp, r32, hi, negm); partialSM(pA0);
  SLOAD(SO, 1);
  SWAIT(); SWRITE(1, SO); __syncthreads();
  for (int j = 1; j + 1 < NT; j += 2) {
    SBAR(); qkt(pB0, pB1, K_lds + SHM_K, qr, comp, r32, hi, negm);
    finishSM(pA0, pA1, l_reg, pa0, pa1, pa2, pa3); SBAR();
    SLOAD(SE, j + 1); SBAR();
    pv_d0(o, vb0, pa0, pa1, pa2, pa3); partialSM(pB0);
    __syncthreads(); SWAIT(); SWRITE(0, SE);
    __syncthreads();
    SBAR(); qkt(pA0, pA1, K_lds, qr, comp, r32, hi, negm);
    finishSM(pB0, pB1, l_reg, pa0, pa1, pa2, pa3); SBAR();
    SLOAD(SO, j + 2); SBAR();
    pv_d0(o, vb0 + SHM_V, pa0, pa1, pa2, pa3); partialSM(pA0);
    __syncthreads(); SWAIT(); SWRITE(1, SO);
    __syncthreads();
  }
  SBAR(); qkt(pB0, pB1, K_lds + SHM_K, qr, comp, r32, hi, negm);
  finishSM(pA0, pA1, l_reg, pa0, pa1, pa2, pa3); SBAR();
  pv_d0(o, vb0, pa0, pa1, pa2, pa3); partialSM(pB0);
  finishSM(pB0, pB1, l_reg, pa0, pa1, pa2, pa3); SBAR();
  pv_d0(o, vb0 + SHM_V, pa0, pa1, pa2, pa3);
  asm volatile("s_waitcnt vmcnt(0)" ::: "memory");
  { auto rr = __builtin_amdgcn_permlane32_swap(__float_as_uint(l_reg), __float_as_uint(l_reg), false, false); l_reg = __uint_as_float(rr[0]) + __uint_as_float(rr[1]); }
  if (hi == 0) wsf[r32] = l_reg;
  asm volatile("s_waitcnt lgkmcnt(0)" ::: "memory");
  float rli[16];
#pragma unroll
  for (int r = 0; r < 16; ++r) rli[r] = __builtin_amdgcn_rcpf(wsf[crow(r, hi)]);
  __syncthreads();
  float* X = (float*)lds + g * 32 * 128;
  if (comp == 1) {
#pragma unroll
    for (int r = 0; r < 16; ++r) { const int row = crow(r, hi);
#pragma unroll
      for (int d0 = 0; d0 < 4; ++d0) X[row * 128 + d0 * 32 + r32] = o[d0][r] * rli[r] * lam; }
  }
  __syncthreads();
  if (comp == 0) {
    float ss[16];
#pragma unroll
    for (int r = 0; r < 16; ++r) { const int row = crow(r, hi); float s = 0.f;
#pragma unroll
      for (int d0 = 0; d0 < 4; ++d0) { const float v = o[d0][r] * rli[r] - X[row * 128 + d0 * 32 + r32]; o[d0][r] = v; s += v * v; }
      ss[r] = s; }
#pragma unroll
    for (int m = 1; m < 32; m <<= 1) {
#pragma unroll
      for (int r = 0; r < 16; ++r) ss[r] += __shfl_xor(ss[r], m);
    }
    float dw[4];
#pragma unroll
    for (int d0 = 0; d0 < 4; ++d0) dw[d0] = dnw[d0 * 32 + r32];
    unsigned short* Ow = QBm + qrow0 * 1024 + h * 128;
#pragma unroll
    for (int r = 0; r < 16; ++r) { const float rstd = 1.f / sqrtf(ss[r] * (1.f / 128.f) + EPS); const int row = crow(r, hi);
#pragma unroll
      for (int d0 = 0; d0 < 4; ++d0) Ow[(long)row * 1024 + d0 * 32 + r32] = (unsigned short)f2bf(o[d0][r] * rstd * dw[d0]); }
  }
  __syncthreads();
#undef SLOAD
#undef SWRITE
#undef SWAIT
}
#undef KSWZ
#undef SBAR
}

namespace gdn {
using bf16x8 = __attribute__((ext_vector_type(8))) short;
using f32x16 = __attribute__((ext_vector_type(16))) float;
using u32x4  = __attribute__((ext_vector_type(4))) unsigned;
using u32x2  = __attribute__((ext_vector_type(2))) unsigned;
constexpr int LK = 136, LT = 72;
constexpr int L_KBN = 0, L_QD = 17408, L_KDT = 34816, L_QK = 53248, L_VB = 62464, L_SBF = 79872, L_RBF = 114688, L_VNBF = 133120, L_SM = 151552, L_END = 152832;
constexpr int NSTEP = (LCTX + SEQ) / 64;
__device__ __forceinline__ int crow(int r, int hi) { return (r & 3) + 8 * (r >> 2) + 4 * hi; }
__device__ __forceinline__ f32x16 mma(bf16x8 a, bf16x8 b, f32x16 c) { return __builtin_amdgcn_mfma_f32_32x32x16_bf16(a, b, c, 0, 0, 0); }
#define GFRAG(base, ld, tile, ks) (*(const bf16x8*)((base) + ((32 * (tile) + r32) * (ld) + 16 * (ks) + 8 * hi) * 2))

__device__ __forceinline__ void conv_load(v4u (&raw)[12], const unsigned short* src, int t0, int Ls) {
#pragma unroll
    for (int rr = 0; rr < 12; ++rr) { const int t = t0 - 2 + rr; const int tc = (t >= 0 && t < Ls) ? t : t0; raw[rr] = *(const v4u*)(src + (size_t)tc * 3072); }
}
__device__ __forceinline__ void conv_compute(float (&acc)[8][8], const v4u (&raw)[12], const float* w, int t0, int Ls) {
    float wv[5][8];
#pragma unroll
    for (int j = 0; j < 5; ++j) { const f32x4 a = *(const f32x4*)(w + j * 3072), b = *(const f32x4*)(w + j * 3072 + 4);
        wv[j][0] = a[0]; wv[j][1] = a[1]; wv[j][2] = a[2]; wv[j][3] = a[3]; wv[j][4] = b[0]; wv[j][5] = b[1]; wv[j][6] = b[2]; wv[j][7] = b[3]; }
#pragma unroll
    for (int tt = 0; tt < 8; ++tt)
#pragma unroll
        for (int i = 0; i < 8; ++i) acc[tt][i] = 0.f;
#pragma unroll
    for (int rr = 0; rr < 12; ++rr) {
        const int t = t0 - 2 + rr; const bool ok = (t >= 0) && (t < Ls);
        v4u xv = raw[rr];
        xv.x = ok ? xv.x : 0u; xv.y = ok ? xv.y : 0u; xv.z = ok ? xv.z : 0u; xv.w = ok ? xv.w : 0u;
        const float x[8] = {bflo(xv.x), bfhi(xv.x), bflo(xv.y), bfhi(xv.y), bflo(xv.z), bfhi(xv.z), bflo(xv.w), bfhi(xv.w)};
#pragma unroll
        for (int tt = 0; tt < 8; ++tt) { const int j = rr - tt;
            if (j >= 0 && j <= 4) {
#pragma unroll
                for (int i = 0; i < 8; ++i) acc[tt][i] += x[i] * wv[j][i]; } }
    }
#pragma unroll
    for (int tt = 0; tt < 8; ++tt)
#pragma unroll
        for (int i = 0; i < 8; ++i) acc[tt][i] = acc[tt][i] * __builtin_amdgcn_rcpf(1.f + __expf(-acc[tt][i]));
}
__device__ __forceinline__ void conv8(float (&acc)[8][8], const unsigned short* src, const float* w, int t0, int Ls) { v4u raw[12]; conv_load(raw, src, t0, Ls); conv_compute(acc, raw, w, t0, Ls); }
__device__ __forceinline__ void conv4(float (&acc)[4][8], const unsigned short* src, const float (&wv)[5][8], int t0, int Ls) {
    v4u raw[8];
#pragma unroll
    for (int rr = 0; rr < 8; ++rr) { const int t = t0 - 2 + rr; const int tc = (t >= 0 && t < Ls) ? t : t0; raw[rr] = *(const v4u*)(src + (size_t)tc * 3072); }
#pragma unroll
    for (int tt = 0; tt < 4; ++tt)
#pragma unroll
        for (int i = 0; i < 8; ++i) acc[tt][i] = 0.f;
#pragma unroll
    for (int rr = 0; rr < 8; ++rr) {
        const int t = t0 - 2 + rr; const bool ok = (t >= 0) && (t < Ls);
        v4u xv = raw[rr];
        xv.x = ok ? xv.x : 0u; xv.y = ok ? xv.y : 0u; xv.z = ok ? xv.z : 0u; xv.w = ok ? xv.w : 0u;
        const float x[8] = {bflo(xv.x), bfhi(xv.x), bflo(xv.y), bfhi(xv.y), bflo(xv.z), bfhi(xv.z), bflo(xv.w), bfhi(xv.w)};
#pragma unroll
        for (int tt = 0; tt < 4; ++tt) { const int j = rr - tt;
            if (j >= 0 && j <= 4) {
#pragma unroll
                for (int i = 0; i < 8; ++i) acc[tt][i] += x[i] * wv[j][i]; } }
    }
#pragma unroll
    for (int tt = 0; tt < 4; ++tt)
#pragma unroll
        for (int i = 0; i < 8; ++i) acc[tt][i] = acc[tt][i] * __builtin_amdgcn_rcpf(1.f + __expf(-acc[tt][i]));
}
__device__ __forceinline__ void l2scale4(float (&acc)[4][8], float mul) {
#pragma unroll
    for (int tt = 0; tt < 4; ++tt) { float s = 0.f;
#pragma unroll
        for (int i = 0; i < 8; ++i) s += acc[tt][i] * acc[tt][i];
        s += __shfl_xor(s, 1); s += __shfl_xor(s, 2); s += __shfl_xor(s, 4); s += __shfl_xor(s, 8);
        const float rs = mul * __builtin_amdgcn_rsqf(s + EPS);
#pragma unroll
        for (int i = 0; i < 8; ++i) acc[tt][i] *= rs; }
}
__device__ __forceinline__ u32x4 scale_pk(const u32x4 w, float s) { u32x4 o; o.x = pk2(bflo(w.x) * s, bfhi(w.x) * s); o.y = pk2(bflo(w.y) * s, bfhi(w.y) * s); o.z = pk2(bflo(w.z) * s, bfhi(w.z) * s); o.w = pk2(bflo(w.w) * s, bfhi(w.w) * s); return o; }
__device__ __forceinline__ float pk_elem(const u32x4 w, int i) { const unsigned u = (i >> 1) == 0 ? w.x : (i >> 1) == 1 ? w.y : (i >> 1) == 2 ? w.z : w.w; return (i & 1) ? bfhi(u) : bflo(u); }
__device__ __forceinline__ void l2scale8(float (&acc)[8][8], float mul) {
#pragma unroll
    for (int tt = 0; tt < 8; ++tt) { float s = 0.f;
#pragma unroll
        for (int i = 0; i < 8; ++i) s += acc[tt][i] * acc[tt][i];
        s += __shfl_xor(s, 1); s += __shfl_xor(s, 2); s += __shfl_xor(s, 4); s += __shfl_xor(s, 8);
        const float rs = mul * __builtin_amdgcn_rsqf(s + EPS);
#pragma unroll
        for (int i = 0; i < 8; ++i) acc[tt][i] *= rs; }
}
__device__ __forceinline__ u32x4 pack8s(const float (&v)[8], float s) { u32x4 w; w.x = pk2(v[0] * s, v[1] * s); w.y = pk2(v[2] * s, v[3] * s); w.z = pk2(v[4] * s, v[5] * s); w.w = pk2(v[6] * s, v[7] * s); return w; }

__device__ __forceinline__ void gates_wave(float* sm, const float* AB, long r0, int c0, int d, int h, float Aexp, float dtb, int lane) {
    const int t = d ? (c0 + 63 - lane) : (c0 + lane);
    const float araw = AB[(r0 + t) * 32 + d * 8 + h], braw = AB[(r0 + t) * 32 + 16 + d * 8 + h];
    float gc = -Aexp * softplus_f(araw + dtb); const float beta = sigmoid_f(braw);
#pragma unroll
    for (int o = 1; o < 64; o <<= 1) { const float u = __shfl_up(gc, o); if (lane >= o) gc += u; }
    const float g63 = __shfl(gc, 63);
    sm[lane] = gc; sm[64 + lane] = beta; sm[128 + lane] = __expf(gc); sm[192 + lane] = __expf(g63 - gc);
    if (lane == 0) sm[256] = __expf(g63);
}

__device__ __forceinline__ void t_unit(int b, int h, int seg, int cidx, const unsigned short* QKV, const float* AB, const float* conv_w, const float* a_log, const float* dt_bias,
                                       unsigned short* Tbuf, char* lds) {
    const int tid = threadIdx.x, lane = tid & 63, wid = __builtin_amdgcn_readfirstlane(tid >> 6), r32 = lane & 31, hi = lane >> 5;
    const int Ls = seg ? SEQ : LCTX, nch = Ls / 64, c0 = cidx * 64; const long r0 = seg ? (long)b * SEQ : (long)MLAT + b * LCTX;
    char* Kn = lds; float* KK = (float*)(lds + 17408); float* Ap = (float*)(lds + 33792); float* sm = (float*)(lds + 66560);
    if (tid < 128) {
        const int co = tid & 15, tg = tid >> 4; float acc[8][8];
        conv8(acc, QKV + r0 * 3072 + 1024 + h * 128 + co * 8, conv_w + 1024 + h * 128 + co * 8, c0 + tg * 8, Ls);
        l2scale8(acc, 1.f);
#pragma unroll
        for (int tt = 0; tt < 8; ++tt) *(u32x4*)(Kn + ((tg * 8 + tt) * LK + co * 8) * 2) = pack8s(acc[tt], 1.f);
    } else if (wid == 2 || wid == 3) { const int d = wid - 2; gates_wave(sm + d * 260, AB, r0, c0, d, h, __expf(a_log[d * 8 + h]), dt_bias[d * 8 + h], lane); }
    __syncthreads();
    if (wid < 4) {
        const int mt = wid >> 1, nt = wid & 1; f32x16 acc = {};
#pragma unroll
        for (int ks = 0; ks < 8; ++ks) acc = mma(GFRAG(Kn, LK, mt, ks), GFRAG(Kn, LK, nt, ks), acc);
#pragma unroll
        for (int r = 0; r < 16; ++r) KK[(32 * mt + crow(r, hi)) * 64 + 32 * nt + r32] = acc[r];
    }
    __syncthreads();
    for (int e = tid; e < 8192; e += 512) { const int d = e >> 12, i = (e >> 6) & 63, j = e & 63; const float* s = sm + d * 260;
        const int ti = d ? 63 - i : i, tj = d ? 63 - j : j;
        Ap[e] = (j < i) ? s[64 + i] * KK[ti * 64 + tj] * __expf(s[i] - s[j]) : 0.f; }
    __syncthreads();
    if (wid < 2) {
        const int d = wid; const float* A = Ap + d * 4096; float T[64];
#pragma unroll
        for (int i = 0; i < 64; ++i) { int ln = lane; asm volatile("" : "+v"(ln)); float acc = (ln == i) ? 1.f : 0.f;
#pragma unroll
            for (int j4 = 0; j4 < (i + 3) / 4; ++j4) { const f32x4 a = *(const f32x4*)(A + i * 64 + j4 * 4);
#pragma unroll
                for (int q = 0; q < 4; ++q) if (j4 * 4 + q < i) acc -= a[q] * T[j4 * 4 + q]; }
            T[i] = acc; }
        const int sidx = seg ? 4 + (d ? nch - 1 - cidx : cidx) : (d ? nch - 1 - cidx : cidx);
        unsigned short* Tg = Tbuf + ((size_t)((b * 8 + h) * 2 + d) * NSTEP + sidx) * 4096;
#pragma unroll
        for (int i = 0; i < 64; ++i) Tg[i * 64 + lane] = (unsigned short)f2bf(T[i]);
    }
    __syncthreads();
}

__device__ __forceinline__ void chain(int b, int h, int d, const unsigned short* QKV, const float* AB, const float* conv_w, const float* a_log, const float* dt_bias,
                                      const unsigned short* Tbuf, float* o_a, char* lds, int dummy = 0) {
    const int tid0 = threadIdx.x, wid = __builtin_amdgcn_readfirstlane(tid0 >> 6);
    const int nt = wid & 3, mh = wid >> 2;
    char* Kbn = lds + L_KBN; char* Qd = lds + L_QD; char* KdT = lds + L_KDT; char* QKb = lds + L_QK; char* Vb = lds + L_VB; char* Sbf = lds + L_SBF; char* Rbf = lds + L_RBF; char* VNbf = lds + L_VNBF;
    float* sm = (float*)(lds + L_SM);
    for (int e = tid0; e < 128 * LK / 2; e += 512) ((unsigned*)Sbf)[e] = 0u;
    f32x16 S0 = {}, S1 = {};
    const unsigned short* Tchain = Tbuf + (size_t)((b * 8 + h) * 2 + d) * NSTEP * 4096;
    __syncthreads();
    for (int sidx = 0; sidx < NSTEP; ++sidx) {
        int tid_ = threadIdx.x; asm volatile("" : "+v"(tid_));
        const int tid = tid_, lane = tid & 63, r32 = lane & 31, hi = lane >> 5;
        const int tensor = wid >> 1, tg = (tid >> 4) & 7, c8 = (tid & 15) * 8;
        const int seg = sidx >= 4, n = seg ? sidx - 4 : sidx, Ls = seg ? SEQ : LCTX, nch = Ls / 64, cidx = d ? nch - 1 - n : n, c0 = cidx * 64;
        const long r0 = seg ? (long)b * SEQ : (long)MLAT + b * LCTX;
        u32x4 pk[8];
        if (tid < 384) {
            float wv[5][8];
            { const float* w = conv_w + tensor * 1024 + h * 128 + c8;
#pragma unroll
              for (int j = 0; j < 5; ++j) { const f32x4 wa = *(const f32x4*)(w + j * 3072), wb = *(const f32x4*)(w + j * 3072 + 4);
                  wv[j][0] = wa[0]; wv[j][1] = wa[1]; wv[j][2] = wa[2]; wv[j][3] = wa[3]; wv[j][4] = wb[0]; wv[j][5] = wb[1]; wv[j][6] = wb[2]; wv[j][7] = wb[3]; } }
#pragma unroll
            for (int half = 0; half < 2; ++half) { float acc[4][8];
                conv4(acc, QKV + r0 * 3072 + tensor * 1024 + h * 128 + c8, wv, c0 + tg * 8 + 4 * half, Ls);
                if (tensor < 2) l2scale4(acc, tensor == 0 ? 0.08838834764831845f : 1.f);
#pragma unroll
                for (int tt = 0; tt < 4; ++tt) pk[4 * half + tt] = pack8s(acc[tt], 1.f); }
        } else if (wid == 7) gates_wave(sm, AB, r0, c0, d, h, __expf(a_log[d * 8 + h]), dt_bias[d * 8 + h], lane);
        __syncthreads();
        if (tid < 384) {
#pragma unroll
            for (int tt = 0; tt < 8; ++tt) { const int il = d ? 63 - tg * 8 - tt : tg * 8 + tt;
                if (tensor == 0) *(u32x4*)(Qd + (il * LK + c8) * 2) = pk[tt];
                else if (tensor == 1) *(u32x4*)(Kbn + (il * LK + c8) * 2) = pk[tt];
                else *(u32x4*)(Vb + (il * LK + c8) * 2) = scale_pk(pk[tt], sm[64 + il]); }
        }
        __syncthreads();
        { const int dk = tid & 127, tq = tid >> 7; float v[16];
#pragma unroll
          for (int p = 0; p < 16; ++p) v[p] = bf2f(*(const unsigned short*)(Kbn + ((16 * tq + p) * LK + dk) * 2)) * sm[192 + 16 * tq + p];
          u32x4 w0, w1; w0.x = pk2(v[0], v[1]); w0.y = pk2(v[2], v[3]); w0.z = pk2(v[4], v[5]); w0.w = pk2(v[6], v[7]); w1.x = pk2(v[8], v[9]); w1.y = pk2(v[10], v[11]); w1.z = pk2(v[12], v[13]); w1.w = pk2(v[14], v[15]);
          *(u32x4*)(KdT + (dk * LT + 16 * tq) * 2) = w0; *(u32x4*)(KdT + (dk * LT + 16 * tq + 8) * 2) = w1; }
        if (seg && wid < 3) {
            const int mt = wid > 0, ntq = wid > 1; f32x16 a = {};
#pragma unroll
            for (int ks = 0; ks < 8; ++ks) a = mma(GFRAG(Qd, LK, mt, ks), GFRAG(Kbn, LK, ntq, ks), a);
            const int j = 32 * ntq + r32; const float gj = sm[j];
#pragma unroll
            for (int r = 0; r < 16; ++r) { const int i = 32 * mt + crow(r, hi); const float v = (i >= j) ? a[r] * __expf(sm[i] - gj) : 0.f;
                *(unsigned short*)(QKb + (i * LT + j) * 2) = (unsigned short)f2bf(v); }
        }
        __syncthreads();
        if (tid < 384 && tensor < 2) {
#pragma unroll
            for (int tt = 0; tt < 8; ++tt) { const int il = d ? 63 - tg * 8 - tt : tg * 8 + tt;
                if (tensor == 0) *(u32x4*)(Qd + (il * LK + c8) * 2) = scale_pk(pk[tt], sm[128 + il]);
                else if (tensor == 1) *(u32x4*)(Kbn + (il * LK + c8) * 2) = scale_pk(pk[tt], -sm[64 + il] * sm[128 + il]); }
        }
        bf16x8 Tf[4];
        { const unsigned short* Tg = Tchain + (size_t)sidx * 4096 + (32 * mh + r32) * 64 + 8 * hi;
#pragma unroll
          for (int ks = 0; ks < 4; ++ks) Tf[ks] = *(const bf16x8*)(Tg + 16 * ks); }
        unsigned pf = 0u;
        if (tid < 408 && sidx + 1 < NSTEP) {
            const int s2 = sidx + 1, seg2 = s2 >= 4, n2 = seg2 ? s2 - 4 : s2, Ls2 = seg2 ? SEQ : LCTX, cidx2 = d ? Ls2 / 64 - 1 - n2 : n2; const long r02 = seg2 ? (long)b * SEQ : (long)MLAT + b * LCTX;
            int trow = cidx2 * 64 - 2 + tid / 6; trow = trow < 0 ? 0 : (trow >= Ls2 ? Ls2 - 1 : trow); const int k6 = tid % 6;
            pf = *(const unsigned*)(QKV + (r02 + trow) * 3072 + (k6 >> 1) * 1024 + h * 128 + (k6 & 1) * 64); }
        __syncthreads();
        f32x16 rr, oo = {};
#pragma unroll
        for (int r = 0; r < 16; ++r) rr[r] = bf2f(*(const unsigned short*)(Vb + ((32 * mh + crow(r, hi)) * LK + 32 * nt + r32) * 2));
#pragma unroll
        for (int ks = 0; ks < 8; ++ks) { const bf16x8 sb = GFRAG(Sbf, LK, nt, ks); rr = mma(GFRAG(Kbn, LK, mh, ks), sb, rr); if (seg) oo = mma(GFRAG(Qd, LK, mh, ks), sb, oo); }
#pragma unroll
        for (int q4 = 0; q4 < 4; ++q4) { u32x2 w; w.x = pk2(rr[4 * q4], rr[4 * q4 + 1]); w.y = pk2(rr[4 * q4 + 2], rr[4 * q4 + 3]);
            *(u32x2*)(Rbf + ((32 * nt + r32) * LT + 32 * mh + 8 * q4 + 4 * hi) * 2) = w; }
        __syncthreads();
        f32x16 vn = {};
#pragma unroll
        for (int ks = 0; ks < 4; ++ks) if (mh == 1 || ks < 2) vn = mma(Tf[ks], GFRAG(Rbf, LT, nt, ks), vn);
#pragma unroll
        for (int q4 = 0; q4 < 4; ++q4) { u32x2 w; w.x = pk2(vn[4 * q4], vn[4 * q4 + 1]); w.y = pk2(vn[4 * q4 + 2], vn[4 * q4 + 3]);
            *(u32x2*)(VNbf + ((32 * nt + r32) * LT + 32 * mh + 8 * q4 + 4 * hi) * 2) = w; }
        __syncthreads();
        if (seg) {
#pragma unroll
            for (int ks = 0; ks < 4; ++ks) if (mh == 1 || ks < 2) oo = mma(GFRAG(QKb, LT, mh, ks), GFRAG(VNbf, LT, nt, ks), oo);
#pragma unroll
            for (int r = 0; r < 16; ++r) { const int il = 32 * mh + crow(r, hi); const int t = d ? c0 + 63 - il : c0 + il;
                atomicAdd(o_a + (dummy ? (size_t)il * 1024 : (size_t)(r0 + t) * 1024) + h * 128 + 32 * nt + r32, oo[r]); }
        }
        { const float gam = sm[256];
#pragma unroll
          for (int r = 0; r < 16; ++r) { S0[r] *= gam; S1[r] *= gam; }
#pragma unroll
          for (int ks = 0; ks < 4; ++ks) { const bf16x8 vb = GFRAG(VNbf, LT, nt, ks); S0 = mma(GFRAG(KdT, LT, 2 * mh, ks), vb, S0); S1 = mma(GFRAG(KdT, LT, 2 * mh + 1, ks), vb, S1); }
#pragma unroll
          for (int q4 = 0; q4 < 4; ++q4) { u32x2 w0, w1; w0.x = pk2(S0[4 * q4], S0[4 * q4 + 1]); w0.y = pk2(S0[4 * q4 + 2], S0[4 * q4 + 3]); w1.x = pk2(S1[4 * q4], S1[4 * q4 + 1]); w1.y = pk2(S1[4 * q4 + 2], S1[4 * q4 + 3]);
              *(u32x2*)(Sbf + ((32 * nt + r32) * LK + 64 * mh + 8 * q4 + 4 * hi) * 2) = w0; *(u32x2*)(Sbf + ((32 * nt + r32) * LK + 64 * mh + 32 + 8 * q4 + 4 * hi) * 2) = w1; } }
        asm volatile("" :: "v"(pf));
        __syncthreads();
    }
}
#undef GFRAG
}

__global__ void __launch_bounds__(512, 2) hybrid_fwd(Args a) {
    extern __shared__ __attribute__((aligned(16))) unsigned char lds[];
    const int tid0 = threadIdx.x, wave = __builtin_amdgcn_readfirstlane(tid0 >> 6);
#define PHASE_IDS() int tid = threadIdx.x; asm volatile("" : "+v"(tid)); const int lane = tid & 63; (void)lane
    const int G = gridDim.x, bid = blockIdx.x;
    const int gw = bid * 8 + wave, NGW = G * 8;
    unsigned char* ws = a.ws;
    unsigned* ctl = (unsigned*)(ws + WS_CTL);
    volatile LAS unsigned* MISC = (volatile LAS unsigned*)((LAS unsigned char*)lds + MISC_OFF);
    for (int u = tid0; u < (LDS_BYTES - 131072) / 4; u += 512) ((LAS unsigned*)((LAS unsigned char*)lds + 131072))[u] = 0u;
    __syncthreads();
    (void)xcd_barrier_post(ctl + 4096, MISC + 8);
#define GRID_BAR() do { XcdBarrier b_; b_.bar = (unsigned*)(a.ws + WS_CTL) + 4096; b_.x = xb_xcc_id(); b_.st = (volatile LAS unsigned*)((LAS unsigned char*)lds + MISC_OFF) + 8; xcd_barrier(b_); } while (0)

#define MODP ((float*)(a.ws + WS_MODP))
#define MOD ((float*)(a.ws + WS_MOD))
#define W2T ((bf16*)(a.ws + WS_W2T))
#define AB ((float*)(a.ws + WS_AB))
#define QKV ((bf16*)(a.ws + WS_QKV))
#define QB ((bf16*)(a.ws + WS_QB))
#define KB ((bf16*)(a.ws + WS_KB))
#define VB ((bf16*)(a.ws + WS_VB))
#define MERGED ((bf16*)(a.ws + WS_MERGED))
#define H2 ((bf16*)(a.ws + WS_H2))
#define NA ((bf16*)(a.ws + WS_NA))
#define T1 ((bf16*)(a.ws + WS_T1))
#define GATES ((bf16*)(a.ws + WS_GATES))
#define H ((bf16*)((unsigned char*)a.out + DO_H))
#define W1T ((bf16*)((unsigned char*)a.out + DO_W1T))


#define THRASH() do { f32x4 _s = {0.f,0.f,0.f,0.f}; for (size_t _i = (size_t)bid * 512 + tid; _i < (size_t)MLAT * 1024 / 4; _i += (size_t)G * 512) { const f32x4 _v = ((const f32x4*)a.x)[_i]; _s += _v; } \
    ((f32x4*)(ws + WS_END))[(size_t)bid * 512 + tid] = _s; } while (0)
    {
        PHASE_IDS();
        for (int u = bid; u < 48; u += G) {
            const int ks = u / 6, nb = u % 6, n = nb * 512 + tid;
            float s0 = 0.f, s1 = 0.f, s2 = 0.f;
            for (int k = ks * 128; k < ks * 128 + 128; ++k) {
                const float w = a.w_ada[(size_t)k * 3072 + n];
                s0 += silu_f(a.c[k]) * w; s1 += silu_f(a.c[1024 + k]) * w; s2 += silu_f(a.c_ctx[k]) * w;
            }
            MODP[(ks * 3 + 0) * 3072 + n] = s0; MODP[(ks * 3 + 1) * 3072 + n] = s1; MODP[(ks * 3 + 2) * 3072 + n] = s2;
        }
        LAS float* scr = (LAS float*)((LAS unsigned char*)lds + wave * 16384);
        constexpr int NB1 = N1 / 32, NB2 = N2ALL / 32, NIT = 16 * (NB1 + NB2);
        for (int it = gw; it < NIT; it += NGW) {
            const int kb = it & 15, nbi = it >> 4;
            if (nbi < NB1) { const int n0 = nbi * 32; transpose_item(a.w_in, IN_COLS, w1_src(n0), W1T, n0, kb * 64, scr, lane); }
            else { const int n0 = (nbi - NB1) * 32;
                if (n0 < 4096) transpose_item(a.w_in, IN_COLS, w2_src(n0), W2T, n0, kb * 64, scr, lane);
                else if (n0 < 5120) transpose_item(a.w_oa, 1024, n0 - 4096, W2T, n0, kb * 64, scr, lane);
                else if (n0 < 6144) transpose_item(a.w_ob, 1024, n0 - 5120, W2T, n0, kb * 64, scr, lane);
                else transpose_item(a.w_out, 1024, n0 - 6144, W2T, n0, kb * 64, scr, lane); }
        }
    }
    GRID_BAR();

    {
        PHASE_IDS();
        float* modl = (float*)lds;
        for (int i = tid; i < 9216; i += 512) { const int n = i % 3072; float s = a.b_ada[n];
#pragma unroll
            for (int ks = 0; ks < 8; ++ks) s += MODP[ks * 9216 + i];
            modl[i] = s; if (bid == 0) MOD[i] = s; }
        __syncthreads();
        for (int r = gw; r < MTOT; r += NGW) {
            const float* xr; int v;
            if (r < MLAT) { xr = a.x + (size_t)r * 1024; v = r / SEQ; } else { xr = a.ctx + (size_t)(r - MLAT) * 1024; v = 2; }
            f32x4 xv[4]; float ss = 0.f;
#pragma unroll
            for (int j = 0; j < 4; ++j) { xv[j] = ((const f32x4*)xr)[64 * j + lane]; ss += (xv[j].x * xv[j].x + xv[j].y * xv[j].y) + (xv[j].z * xv[j].z + xv[j].w * xv[j].w); }
            const float rstd = 1.f / sqrtf(wave_sum(ss) * (1.f / 1024.f) + EPS);
            const float* sh = modl + v * 3072; const float* sc = sh + 1024;
#pragma unroll
            for (int j = 0; j < 4; ++j) { const int c0 = (64 * j + lane) * 4;
                const float h0 = xv[j].x * rstd * (1.f + sc[c0]) + sh[c0], h1 = xv[j].y * rstd * (1.f + sc[c0 + 1]) + sh[c0 + 1];
                const float h2 = xv[j].z * rstd * (1.f + sc[c0 + 2]) + sh[c0 + 2], h3 = xv[j].w * rstd * (1.f + sc[c0 + 3]) + sh[c0 + 3];
                v2u o; o.x = pk2(h0, h1); o.y = pk2(h2, h3); *(v2u*)(H + (size_t)r * 1024 + c0) = o; }
        }
    }
    GRID_BAR();


#if PG8_R1
    { pg8::Gemm g{H, W1T, MTOT, N1, 1024}; pg8::StaticOrder S; S.init(MTOT, N1, G, bid); pg8::EpiR1 e{QKV, QB, KB, VB, AB, MLAT / 256};
      pg8::gemm_phase<pg8::EpiR1, pg8::StaticOrder, true, true>((LAS unsigned char*)lds, g, S, e); }
#else
    { EpiR1 e{QKV, QB, KB, VB, AB}; gemm_naive(lds, H, W1T, MTOT, N1, 1024, e); }
#endif

    GRID_BAR();

    {
        PHASE_IDS();
        for (size_t i = (size_t)bid * 512 + tid; i < (size_t)MLAT * 1024 / 4; i += (size_t)G * 512) ((f32x4*)a.out)[i] = (f32x4){0.f, 0.f, 0.f, 0.f};
        for (int it = gw; it < MLAT + MTOT; it += NGW) {
            const bool isq = it < MLAT; const int r = isq ? it : it - MLAT;
            bf16* p = (isq ? QB : KB) + (size_t)r * 1024 + lane * 16;
            const float* gw_ = isq ? a.q_norm_w : a.k_norm_w;
            const v4u w0 = *(const v4u*)p, w1 = *(const v4u*)(p + 8);
            float v[16] = {bflo(w0.x), bfhi(w0.x), bflo(w0.y), bfhi(w0.y), bflo(w0.z), bfhi(w0.z), bflo(w0.w), bfhi(w0.w),
                           bflo(w1.x), bfhi(w1.x), bflo(w1.y), bfhi(w1.y), bflo(w1.z), bfhi(w1.z), bflo(w1.w), bfhi(w1.w)};
            float ss = 0.f;
#pragma unroll
            for (int i = 0; i < 16; ++i) ss += v[i] * v[i];
            ss += __shfl_xor(ss, 1); ss += __shfl_xor(ss, 2);
            const float rstd = 1.f / sqrtf(ss * (1.f / 64.f) + EPS);
            const int sub = lane & 3;
#pragma unroll
            for (int i = 0; i < 16; ++i) v[i] = v[i] * rstd * gw_[sub * 16 + i];
            if (r < MLAT) {
                const int t = r % SEQ; const float pos = (float)((sub < 2) ? (t >> 6) : (t & 63));
#pragma unroll
                for (int i = 0; i < 16; ++i) {
                    const float other = __shfl_xor(v[i], 1);
                    const float invf = exp2f(-(float)i * (13.287712379549449f / 16.f));
                    const float ang = pos * invf; const float cs = cosf(ang), sn = sinf(ang);
                    v[i] = (sub & 1) ? (v[i] * cs + other * sn) : (v[i] * cs - other * sn);
                }
            }
            const float sc = isq ? QSCALE : 1.f;
            v4u o0, o1; o0.x = pk2(v[0] * sc, v[1] * sc); o0.y = pk2(v[2] * sc, v[3] * sc); o0.z = pk2(v[4] * sc, v[5] * sc); o0.w = pk2(v[6] * sc, v[7] * sc);
            o1.x = pk2(v[8] * sc, v[9] * sc); o1.y = pk2(v[10] * sc, v[11] * sc); o1.z = pk2(v[12] * sc, v[13] * sc); o1.w = pk2(v[14] * sc, v[15] * sc);
            *(v4u*)p = o0; *(v4u*)(p + 8) = o1;
        }
    #if !GDN_NAIVE
        __syncthreads();
        for (int u = bid; u < 2 * 8 * gdn::NSTEP; u += G) {
            const int bh = u / gdn::NSTEP, rem = u % gdn::NSTEP; const int sg = rem >= 4, cidx = sg ? rem - 4 : rem;
            gdn::t_unit(bh >> 3, bh & 7, sg, cidx, QKV, AB, a.conv_w, a.a_log, a.dt_bias, (unsigned short*)(ws + WS_T), (char*)lds);
        }
#endif
    }
    GRID_BAR();

    {
        PHASE_IDS();
#if GDN_NAIVE
        for (int wu = gw; wu < 1024; wu += NGW) {
            const int chain = wu >> 5, sl = wu & 31; const int b = chain >> 4, h = (chain >> 1) & 7, d = chain & 1;
            const int g = lane >> 2, dv = sl * 4 + (lane & 3);
            const float Aexp = __expf(a.a_log[d * 8 + h]), dtb = a.dt_bias[d * 8 + h];
            float wq[5][8], wk[5][8], wv[5];
#pragma unroll
            for (int j = 0; j < 5; ++j) { wv[j] = a.conv_w[j * 3072 + 2048 + h * 128 + dv];
#pragma unroll
                for (int i = 0; i < 8; ++i) { wq[j][i] = a.conv_w[j * 3072 + h * 128 + g * 8 + i]; wk[j][i] = a.conv_w[j * 3072 + 1024 + h * 128 + g * 8 + i]; } }
            float S[8];
#pragma unroll
            for (int i = 0; i < 8; ++i) S[i] = 0.f;
            for (int seg = 0; seg < 2; ++seg) {
                const int Ls = seg == 0 ? LCTX : SEQ; const int r0 = seg == 0 ? MLAT + b * LCTX : b * SEQ;
                for (int step = 0; step < Ls; ++step) {
                    const int t = d ? (Ls - 1 - step) : step;
                    float q[8], k[8], v = 0.f;
#pragma unroll
                    for (int i = 0; i < 8; ++i) { q[i] = 0.f; k[i] = 0.f; }
#pragma unroll
                    for (int j = 0; j < 5; ++j) { const int tt = t + j - 2;
                        if (tt >= 0 && tt < Ls) { const bf16* rp = QKV + (size_t)(r0 + tt) * 3072 + h * 128;
                            const v4u qv = *(const v4u*)(rp + g * 8), kv = *(const v4u*)(rp + 1024 + g * 8);
                            v += bf2f(rp[2048 + dv]) * wv[j];
                            q[0] += bflo(qv.x) * wq[j][0]; q[1] += bfhi(qv.x) * wq[j][1]; q[2] += bflo(qv.y) * wq[j][2]; q[3] += bfhi(qv.y) * wq[j][3];
                            q[4] += bflo(qv.z) * wq[j][4]; q[5] += bfhi(qv.z) * wq[j][5]; q[6] += bflo(qv.w) * wq[j][6]; q[7] += bfhi(qv.w) * wq[j][7];
                            k[0] += bflo(kv.x) * wk[j][0]; k[1] += bfhi(kv.x) * wk[j][1]; k[2] += bflo(kv.y) * wk[j][2]; k[3] += bfhi(kv.y) * wk[j][3];
                            k[4] += bflo(kv.z) * wk[j][4]; k[5] += bfhi(kv.z) * wk[j][5]; k[6] += bflo(kv.w) * wk[j][6]; k[7] += bfhi(kv.w) * wk[j][7]; } }
                    v = silu_f(v); float sq = 0.f, sk = 0.f;
#pragma unroll
                    for (int i = 0; i < 8; ++i) { q[i] = silu_f(q[i]); k[i] = silu_f(k[i]); sq += q[i] * q[i]; sk += k[i] * k[i]; }
#pragma unroll
                    for (int o = 4; o < 64; o <<= 1) { sq += __shfl_xor(sq, o); sk += __shfl_xor(sk, o); }
                    const float rq = (1.f / sqrtf(sq + EPS)) * 0.08838834764831845f, rk = 1.f / sqrtf(sk + EPS);
                    const float araw = AB[(size_t)(r0 + t) * 32 + d * 8 + h], braw = AB[(size_t)(r0 + t) * 32 + 16 + d * 8 + h];
                    const float dec = __expf(-Aexp * softplus_f(araw + dtb)), beta = sigmoid_f(braw);
                    float kS = 0.f;
#pragma unroll
                    for (int i = 0; i < 8; ++i) { k[i] *= rk; S[i] *= dec; kS += k[i] * S[i]; }
#pragma unroll
                    for (int o = 4; o < 64; o <<= 1) kS += __shfl_xor(kS, o);
                    const float vn = beta * (v - kS); float oo = 0.f;
#pragma unroll
                    for (int i = 0; i < 8; ++i) { S[i] += k[i] * vn; oo += q[i] * rq * S[i]; }
#pragma unroll
                    for (int o = 4; o < 64; o <<= 1) oo += __shfl_xor(oo, o);
                    if (seg == 1 && lane < 4) atomicAdd(a.out + (size_t)(r0 + t) * 1024 + h * 128 + dv, oo);
                }
            }
        }
#else
        if (bid < 32) gdn::chain(bid >> 4, (bid >> 1) & 7, bid & 1, QKV, AB, a.conv_w, a.a_log, a.dt_bias, (const unsigned short*)(ws + WS_T), a.out, (char*)lds);
        if (bid < 32 && TIME_CHAIN2) gdn::chain(bid >> 4, (bid >> 1) & 7, bid & 1, QKV, AB, a.conv_w, a.a_log, a.dt_bias, (const unsigned short*)(ws + WS_T), (float*)(ws + WS_END), (char*)lds, 1);
#endif
        __syncthreads();
        {
            float lam, negm;
            { float s1 = 0.f, s2 = 0.f, mq = 0.f, mk = 0.f; for (int i = 0; i < 64; ++i) { s1 += a.lq1[i] * a.lk1[i]; s2 += a.lq2[i] * a.lk2[i]; mq = fmaxf(mq, fabsf(a.q_norm_w[i])); mk = fmaxf(mk, fabsf(a.k_norm_w[i])); }
              lam = __expf(s1) - __expf(s2) + 0.2f; negm = -(8.f * mq * mk * 1.4426950408889634f);
              lam = __uint_as_float(__builtin_amdgcn_readfirstlane(__float_as_uint(lam))); negm = __uint_as_float(__builtin_amdgcn_readfirstlane(__float_as_uint(negm))); }
            volatile LAS unsigned* qslot = MISC + 16;
            for (int qq = 0; qq < 8; ++qq) { const int q = (bid + qq) & 7;
                for (;;) {
                    __syncthreads();
                    if (tid == 0) qslot[0] = __hip_atomic_fetch_add(ctl + 12288 + 64 * q, 1u, __ATOMIC_RELAXED, __HIP_MEMORY_SCOPE_AGENT);
                    __syncthreads();
                    const unsigned idx = qslot[0];
                    if (idx >= 128u) break;
                    const int unit = q * 128 + (int)idx; const int pair = unit >> 6, qb = unit & 63;
                    att::attn_unit(pair >> 3, pair & 7, qb, QB, KB, VB, a.diff_norm_w, lam, negm, (char*)lds);
                }
            }
        }
    }
    GRID_BAR();

    {
        PHASE_IDS();
        for (int r = gw; r < MLAT; r += NGW) {
            const float* xr = a.x + (size_t)r * 1024; const int v = r / SEQ;
            f32x4 xv[4]; float ss = 0.f;
#pragma unroll
            for (int j = 0; j < 4; ++j) { xv[j] = ((const f32x4*)xr)[64 * j + lane]; ss += (xv[j].x * xv[j].x + xv[j].y * xv[j].y) + (xv[j].z * xv[j].z + xv[j].w * xv[j].w); }
            const float rstd = 1.f / sqrtf(wave_sum(ss) * (1.f / 1024.f) + EPS);
            const float* sh = MOD + v * 3072; const float* sc = sh + 1024;
#pragma unroll
            for (int j = 0; j < 4; ++j) { const int c0 = (64 * j + lane) * 4;
                const float h0 = xv[j].x * rstd * (1.f + sc[c0]) + sh[c0], h1 = xv[j].y * rstd * (1.f + sc[c0 + 1]) + sh[c0 + 1];
                const float h2 = xv[j].z * rstd * (1.f + sc[c0 + 2]) + sh[c0 + 2], h3 = xv[j].w * rstd * (1.f + sc[c0 + 3]) + sh[c0 + 3];
                v2u o; o.x = pk2(h0, h1); o.y = pk2(h2, h3); *(v2u*)(H2 + (size_t)r * 1024 + c0) = o; }
            const float* orow = a.out + (size_t)r * 1024 + lane * 16;
            f32x4 ov[4]; float s2 = 0.f;
#pragma unroll
            for (int j = 0; j < 4; ++j) { ov[j] = ((const f32x4*)orow)[j]; s2 += (ov[j].x * ov[j].x + ov[j].y * ov[j].y) + (ov[j].z * ov[j].z + ov[j].w * ov[j].w); }
            s2 += __shfl_xor(s2, 1); s2 += __shfl_xor(s2, 2); s2 += __shfl_xor(s2, 4);
            const float r2 = 1.f / sqrtf(s2 * (1.f / 128.f) + EPS);
            const float* gwp = a.gdn_norm_w + (lane & 7) * 16;
            v4u o0, o1;
            o0.x = pk2(ov[0].x * r2 * gwp[0], ov[0].y * r2 * gwp[1]); o0.y = pk2(ov[0].z * r2 * gwp[2], ov[0].w * r2 * gwp[3]);
            o0.z = pk2(ov[1].x * r2 * gwp[4], ov[1].y * r2 * gwp[5]); o0.w = pk2(ov[1].z * r2 * gwp[6], ov[1].w * r2 * gwp[7]);
            o1.x = pk2(ov[2].x * r2 * gwp[8], ov[2].y * r2 * gwp[9]); o1.y = pk2(ov[2].z * r2 * gwp[10], ov[2].w * r2 * gwp[11]);
            o1.z = pk2(ov[3].x * r2 * gwp[12], ov[3].y * r2 * gwp[13]); o1.w = pk2(ov[3].z * r2 * gwp[14], ov[3].w * r2 * gwp[15]);
            *(v4u*)(NA + (size_t)r * 1024 + lane * 16) = o0; *(v4u*)(NA + (size_t)r * 1024 + lane * 16 + 8) = o1;
        }
    }
    GRID_BAR();


#if PG8_R2
    { pg8::Gemm g{H2, W2T, MLAT, 4096, 1024}; pg8::StaticOrder S; S.init(MLAT, 4096, G, bid); pg8::EpiR2 e{NA, QB, GATES, NA, QB};
      pg8::gemm_phase<pg8::EpiR2, pg8::StaticOrder, true, true>((LAS unsigned char*)lds, g, S, e); }
#else
    { EpiR2 e{NA, QB, GATES}; gemm_naive(lds, H2, W2T, MLAT, 4096, 1024, e); }
#endif
    GRID_BAR();


#if PG8_F1
    { pg8::Gemm g{NA, W2T + (size_t)4096 * 1024, MLAT, 1024, 1024}; pg8::StaticOrder S; S.init(MLAT, 1024, G, bid); pg8::EpiF e{T1, T1, GATES, 0};
      pg8::gemm_phase<pg8::EpiF, pg8::StaticOrder, true, true>((LAS unsigned char*)lds, g, S, e); }
#else
    { EpiF1 e{T1, GATES}; gemm_naive(lds, NA, W2T + (size_t)4096 * 1024, MLAT, 1024, 1024, e); }
#endif


#if PG8_F2
    { pg8::Gemm g{QB, W2T + (size_t)5120 * 1024, MLAT, 1024, 1024}; pg8::StaticOrder S; S.init(MLAT, 1024, G, bid); pg8::EpiF e{MERGED, T1, GATES, 1};
      pg8::gemm_phase<pg8::EpiF, pg8::StaticOrder, true, true>((LAS unsigned char*)lds, g, S, e); }
#else
    { EpiF2 e{MERGED, T1, GATES}; gemm_naive(lds, QB, W2T + (size_t)5120 * 1024, MLAT, 1024, 1024, e); }
#endif

    GRID_BAR();


#if PG8_G
    { pg8::Gemm g{MERGED, W2T + (size_t)6144 * 1024, MLAT, 1024, 1024}; pg8::StaticOrder S; S.init(MLAT, 1024, G, bid); pg8::EpiG e{a.out, a.x, MOD, SEQ / 256};
      pg8::gemm_phase<pg8::EpiG, pg8::StaticOrder, true, true>((LAS unsigned char*)lds, g, S, e); }
#else
    { EpiG e{a.out, a.x, MOD}; gemm_naive(lds, MERGED, W2T + (size_t)6144 * 1024, MLAT, 1024, 1024, e); }
#endif

}

extern "C" void kernel_launch(void* const* d_in, const int* in_sizes, int n_in, void* d_out, int out_size, void* d_ws, size_t ws_size, hipStream_t stream) {
    static int grid = 0;
    if (grid == 0) {
        if (n_in != 21 || in_sizes[0] != MLAT * DM || out_size != MLAT * DM || ws_size < WS_END) { fprintf(stderr, "kernel_launch: unexpected shapes n_in %d in0 %d out %d ws %zu\n", n_in, n_in > 0 ? in_sizes[0] : -1, out_size, ws_size); grid = -1; return; }
        int dev = 0, cus = 0, per_cu = 0;
        if (hipGetDevice(&dev) != hipSuccess || hipDeviceGetAttribute(&cus, hipDeviceAttributeMultiprocessorCount, dev) != hipSuccess) { grid = -1; return; }
        if (hipFuncSetAttribute((const void*)hybrid_fwd, hipFuncAttributeMaxDynamicSharedMemorySize, LDS_BYTES) != hipSuccess) { fprintf(stderr, "kernel_launch: hipFuncSetAttribute failed\n"); grid = -1; return; }
        if (hipOccupancyMaxActiveBlocksPerMultiprocessor(&per_cu, (const void*)hybrid_fwd, 512, LDS_BYTES) != hipSuccess || per_cu < 1) { fprintf(stderr, "kernel_launch: occupancy query says %d\n", per_cu); per_cu = 1; }
        (void)hipGetLastError();
        grid = cus;
    }
    if (grid < 0) return;
    (void)hipMemsetAsync((char*)d_ws + WS_CTL, 0, CTL_BYTES, stream);
    Args a{};
    a.x = (const float*)d_in[0]; a.c = (const float*)d_in[1]; a.ctx = (const float*)d_in[2]; a.c_ctx = (const float*)d_in[3]; a.w_ada = (const float*)d_in[4]; a.b_ada = (const float*)d_in[5];
    a.w_in = (const float*)d_in[6]; a.conv_w = (const float*)d_in[7]; a.a_log = (const float*)d_in[8]; a.dt_bias = (const float*)d_in[9]; a.gdn_norm_w = (const float*)d_in[10];
    a.q_norm_w = (const float*)d_in[11]; a.k_norm_w = (const float*)d_in[12]; a.lq1 = (const float*)d_in[13]; a.lk1 = (const float*)d_in[14]; a.lq2 = (const float*)d_in[15]; a.lk2 = (const float*)d_in[16];
    a.diff_norm_w = (const float*)d_in[17]; a.w_oa = (const float*)d_in[18]; a.w_ob = (const float*)d_in[19]; a.w_out = (const float*)d_in[20];
    a.out = (float*)d_out; a.ws = (unsigned char*)d_ws;
    hipLaunchKernelGGL(hybrid_fwd, dim3(grid), dim3(512), LDS_BYTES, stream, a);
    const hipError_t le = hipPeekAtLastError();
    if (le != hipSuccess) fprintf(stderr, "kernel_launch: launch failed: %s\n", hipGetErrorName(le));
}
```

```cpp
#include <hip/hip_runtime.h>
#include <cstdio>
#include <cstdint>
#define PG8_R1 1
#define PG8_R2 1
#define PG8_F1 1
#define PG8_F2 1
#define PG8_G 1
#define GDN_NAIVE 0
#define TIME_CHAIN2 0
#define TIME_ATT2 0
#define DIAG_IDX 0
#define R2_SKIP_Z 0

#define GAS __attribute__((address_space(1)))
#define LAS __attribute__((address_space(3)))
typedef unsigned short bf16;
typedef unsigned v4u __attribute__((ext_vector_type(4)));
typedef unsigned v2u __attribute__((ext_vector_type(2)));
typedef float f32x4 __attribute__((ext_vector_type(4)));

constexpr int NB = 2, SEQ = 8192, DM = 1024, LCTX = 256, NH = 8;
constexpr int MLAT = NB * SEQ, MCTX = NB * LCTX, MTOT = MLAT + MCTX;
constexpr int IN_COLS = 10272;
constexpr int N1 = 6400, N2ALL = 7168;
constexpr float EPS = 1e-6f;
constexpr float QSCALE = 0.125f * 1.4426950408889634f;

constexpr size_t MiB = 1u << 20;
constexpr size_t WS_CTL = 0, CTL_BYTES = 1 * MiB;
constexpr size_t WS_MODP = 1 * MiB;
constexpr size_t WS_MOD = 2 * MiB;
constexpr size_t WS_W2T = 3 * MiB;
constexpr size_t WS_AB = 17 * MiB;
constexpr size_t WS_T = 20 * MiB;
constexpr size_t WS_HALO = 45 * MiB;
constexpr size_t WS_QKV = 53 * MiB;
constexpr size_t WS_QB = 152 * MiB;
constexpr size_t WS_KB = 184 * MiB;
constexpr size_t WS_VB = 217 * MiB;
constexpr size_t WS_END = 250 * MiB;
constexpr size_t WS_MERGED = 20 * MiB;
constexpr size_t WS_H2 = 53 * MiB;
constexpr size_t WS_NA = 85 * MiB;
constexpr size_t WS_T1 = 117 * MiB;
constexpr size_t WS_GATES = 184 * MiB;
constexpr size_t DO_H = 0;
constexpr size_t DO_W1T = 33 * MiB;

constexpr int LDS_BYTES = 163840;
constexpr int MISC_OFF = 163840 - 256;

__device__ __forceinline__ unsigned f2bf(float f) { unsigned u = __builtin_bit_cast(unsigned, f); return (u + 0x7fffu + ((u >> 16) & 1u)) >> 16; }
typedef float f32x2_t __attribute__((ext_vector_type(2))); typedef __bf16 bf16x2_t __attribute__((ext_vector_type(2)));
__device__ __forceinline__ unsigned pk2(float lo, float hi) { f32x2_t v = {lo, hi}; bf16x2_t b = __builtin_convertvector(v, bf16x2_t); return __builtin_bit_cast(unsigned, b); }
__device__ __forceinline__ int lane_id() { int l; asm volatile("v_mbcnt_lo_u32_b32 %0, -1, 0\n\tv_mbcnt_hi_u32_b32 %0, -1, %0" : "=v"(l)); return l; }
__device__ __forceinline__ float bf2f(unsigned short h) { return __builtin_bit_cast(float, (unsigned)h << 16); }
__device__ __forceinline__ float bflo(unsigned w) { return __builtin_bit_cast(float, w << 16); }
__device__ __forceinline__ float bfhi(unsigned w) { return __builtin_bit_cast(float, w & 0xffff0000u); }
__device__ __forceinline__ float silu_f(float x) { return x / (1.f + __expf(-x)); }
__device__ __forceinline__ float sigmoid_f(float x) { return 1.f / (1.f + __expf(-x)); }
__device__ __forceinline__ float softplus_f(float x) { return fmaxf(x, 0.f) + log1pf(__expf(-fabsf(x))); }

#define XB_TMO      128
#define XB_XCNT(j)  (256  + 64 * (j))
#define XB_XSUB(j)  (1280 + 64 * (j))
#define XB_XGEN(j)  (2304 + 64 * (j))
#define XB_TOP      3328
#define XB_TOPGEN   3392
#define XCD_BAR_WORDS 3456
#define XB_SPIN_CAP (1u << 22)
__device__ __forceinline__ unsigned xb_ld(unsigned* p)              { return __hip_atomic_load(p, __ATOMIC_RELAXED, __HIP_MEMORY_SCOPE_AGENT); }
__device__ __forceinline__ unsigned xb_add(unsigned* p, unsigned v) { return __hip_atomic_fetch_add(p, v, __ATOMIC_RELAXED, __HIP_MEMORY_SCOPE_AGENT); }
__device__ __forceinline__ unsigned xb_xcc_id() { return (unsigned)__builtin_amdgcn_s_getreg((3 << 11) | 20) & 0xFu; }
#define XB_SPIN(cond, bar) do { unsigned _sp = 0; while (cond) { __builtin_amdgcn_s_sleep(1); \
    if ((++_sp & 255u) == 0u) { if (xb_ld(&(bar)[XB_TMO])) break; if (_sp > XB_SPIN_CAP) { atomicAdd(&(bar)[XB_TMO], 1u); break; } } } } while (0)
struct XcdBarrier { unsigned* bar; unsigned x; volatile LAS unsigned* st; int wv; };
__device__ __forceinline__ XcdBarrier xcd_barrier_post(unsigned* bar, volatile LAS unsigned* st, int wv) {
    XcdBarrier b; b.bar = bar; b.x = xb_xcc_id(); b.st = st; b.wv = wv;
    if (wv == 0 && lane_id() == 0) (void)xb_add(&bar[XB_XCNT(b.x)], 1u);
    return b;
}
__device__ __forceinline__ void xcd_barrier_complete(unsigned* bar, unsigned x, unsigned& nloc, unsigned& nx) {
    const unsigned G = gridDim.x * gridDim.y * gridDim.z;
    unsigned sum, cnt, mine, sp = 0u;
    for (;;) {
        sum = 0u; cnt = 0u; mine = 0u;
#pragma unroll
        for (unsigned j = 0; j < 16; ++j) { const unsigned c = xb_ld(&bar[XB_XCNT(j)]); sum += c; cnt += (c > 0u) ? 1u : 0u; mine = (j == x) ? c : mine; }
        if (sum == G) break;
        __builtin_amdgcn_s_sleep(1);
        if ((++sp & 255u) == 0u) { if (xb_ld(&bar[XB_TMO])) break; if (sp > XB_SPIN_CAP) { atomicAdd(&bar[XB_TMO], 1u); break; } }
    }
    nloc = mine > 0u ? mine : 1u; nx = cnt > 0u ? cnt : 1u;
}
__device__ __forceinline__ void xcd_barrier(const XcdBarrier& b) {
    asm volatile("s_waitcnt vmcnt(0)" ::: "memory");
    __syncthreads();
    if (b.wv == 0 && lane_id() == 0) {
        unsigned* bar = b.bar;
        __builtin_amdgcn_s_waitcnt(0);
        unsigned nloc = b.st[0], nx = b.st[1];
        if (nloc == 0u) { xcd_barrier_complete(bar, b.x, nloc, nx); b.st[0] = nloc; b.st[1] = nx; }
        const unsigned old = xb_add(&bar[XB_XSUB(b.x)], 1u);
        const unsigned gen = old / nloc;
        if (old + 1u == (gen + 1u) * nloc) {
            __builtin_amdgcn_fence(__ATOMIC_RELEASE, "agent");
            asm volatile("s_waitcnt vmcnt(0)" ::: "memory");
            const unsigned og = xb_add(&bar[XB_TOP], 1u);
            const unsigned tg = og / nx;
            if (og + 1u == (tg + 1u) * nx) xb_add(&bar[XB_TOPGEN], 1u);
            else XB_SPIN(xb_ld(&bar[XB_TOPGEN]) == tg, bar);
            __builtin_amdgcn_fence(__ATOMIC_ACQUIRE, "agent");
            xb_add(&bar[XB_XGEN(b.x)], 1u);
            asm volatile("s_waitcnt vmcnt(0)" ::: "memory");
        } else {
            XB_SPIN(xb_ld(&bar[XB_XGEN(b.x)]) == gen, bar);
            __builtin_amdgcn_fence(__ATOMIC_ACQUIRE, "agent");
            asm volatile("s_waitcnt vmcnt(0)" ::: "memory");
        }
    }
    __syncthreads();
    __builtin_amdgcn_fence(__ATOMIC_ACQUIRE, "agent");
    asm volatile("s_waitcnt vmcnt(0)" ::: "memory");
}

struct Args {
    const float* x; const float* c; const float* ctx; const float* c_ctx; const float* w_ada; const float* b_ada; const float* w_in; const float* conv_w;
    const float* a_log; const float* dt_bias; const float* gdn_norm_w; const float* q_norm_w; const float* k_norm_w;
    const float* lq1; const float* lk1; const float* lq2; const float* lk2; const float* diff_norm_w; const float* w_oa; const float* w_ob; const float* w_out;
    float* out; unsigned char* ws;
};

template <int M> __device__ __forceinline__ float xorv(float v) { static_assert(M >= 1 && M <= 16, "xorv: 1..16"); return __int_as_float(__builtin_amdgcn_ds_swizzle(__float_as_int(v), (M << 10) | 0x1f)); }
__device__ __forceinline__ float sum_x32(float v) { auto r = __builtin_amdgcn_permlane32_swap(__float_as_uint(v), __float_as_uint(v), false, false); return __uint_as_float(r[0]) + __uint_as_float(r[1]); }
__device__ __forceinline__ float wave_sum(float v) {
    v += xorv<1>(v); v += xorv<2>(v); v += xorv<4>(v); v += xorv<8>(v); v += xorv<16>(v);
    return sum_x32(v);
}

__device__ __forceinline__ int w1_src(int n) { if (n < 3072) return n; if (n < 4096) return 4128 + (n - 3072); if (n < 5120) return 5152 + (n - 4096); if (n < 6144) return 6176 + (n - 5120);
    if (n < 6176) return 4096 + (n - 6144); return -1; }
__device__ __forceinline__ int w2_src(int n) { if (n < 1024) return 3072 + n; if (n < 2048) return 7200 + (n - 1024); return 8224 + (n - 2048); }
__device__ __forceinline__ void transpose_item(const float* W, int ldw, int c0, bf16* WT, int n0, int k0, LAS float* scr, int lane) {
#pragma unroll 8
    for (int i = 0; i < 32; ++i) { const int kk = 2 * i + (lane >> 5); scr[kk * 33 + (lane & 31)] = (c0 >= 0) ? W[(size_t)(k0 + kk) * ldw + c0 + (lane & 31)] : 0.f; }
    asm volatile("s_waitcnt lgkmcnt(0)" ::: "memory");
    const int c = lane & 7;
#pragma unroll
    for (int j = 0; j < 4; ++j) { const int n = (lane >> 3) + 8 * j; const LAS float* s = scr + (8 * c) * 33 + n;
        v4u o; o.x = pk2(s[0 * 33], s[1 * 33]); o.y = pk2(s[2 * 33], s[3 * 33]); o.z = pk2(s[4 * 33], s[5 * 33]); o.w = pk2(s[6 * 33], s[7 * 33]);
        *(v4u*)(WT + (size_t)(n0 + n) * 1024 + k0 + 8 * c) = o; }
    asm volatile("s_waitcnt lgkmcnt(0)" ::: "memory");
}

template <class Epi>
__device__ __forceinline__ void gemm_naive(unsigned char* ldsg, const bf16* A, const bf16* Bt, int M, int N, int K, const Epi& epi) {
    float* As = (float*)ldsg; float* Bs = As + 32 * 132;
    const int tid = threadIdx.x, ty = tid >> 4, tx = tid & 15;
    const int nM = M / 128, nN = N / 128;
    for (int unit = blockIdx.x; unit < nM * nN; unit += gridDim.x) {
        const int pm = unit / nN, pn = unit % nN;
        float acc[4][8];
#pragma unroll
        for (int i = 0; i < 4; ++i)
#pragma unroll
            for (int j = 0; j < 8; ++j) acc[i][j] = 0.f;
        const int srow = tid >> 2, skc = (tid & 3) * 8;
        for (int k0 = 0; k0 < K; k0 += 32) {
            const v4u av = *(const v4u*)(A + (size_t)(pm * 128 + srow) * K + k0 + skc);
            const v4u bv = *(const v4u*)(Bt + (size_t)(pn * 128 + srow) * K + k0 + skc);
            As[(skc + 0) * 132 + srow] = bflo(av.x); As[(skc + 1) * 132 + srow] = bfhi(av.x); As[(skc + 2) * 132 + srow] = bflo(av.y); As[(skc + 3) * 132 + srow] = bfhi(av.y);
            As[(skc + 4) * 132 + srow] = bflo(av.z); As[(skc + 5) * 132 + srow] = bfhi(av.z); As[(skc + 6) * 132 + srow] = bflo(av.w); As[(skc + 7) * 132 + srow] = bfhi(av.w);
            Bs[(skc + 0) * 132 + srow] = bflo(bv.x); Bs[(skc + 1) * 132 + srow] = bfhi(bv.x); Bs[(skc + 2) * 132 + srow] = bflo(bv.y); Bs[(skc + 3) * 132 + srow] = bfhi(bv.y);
            Bs[(skc + 4) * 132 + srow] = bflo(bv.z); Bs[(skc + 5) * 132 + srow] = bfhi(bv.z); Bs[(skc + 6) * 132 + srow] = bflo(bv.w); Bs[(skc + 7) * 132 + srow] = bfhi(bv.w);
            __syncthreads();
#pragma unroll 8
            for (int kk = 0; kk < 32; ++kk) {
                const f32x4 a = *(const f32x4*)(As + kk * 132 + ty * 4);
                const f32x4 b0 = *(const f32x4*)(Bs + kk * 132 + tx * 8), b1 = *(const f32x4*)(Bs + kk * 132 + tx * 8 + 4);
#pragma unroll
                for (int i = 0; i < 4; ++i) { acc[i][0] += a[i] * b0[0]; acc[i][1] += a[i] * b0[1]; acc[i][2] += a[i] * b0[2]; acc[i][3] += a[i] * b0[3];
                    acc[i][4] += a[i] * b1[0]; acc[i][5] += a[i] * b1[1]; acc[i][6] += a[i] * b1[2]; acc[i][7] += a[i] * b1[3]; }
            }
            __syncthreads();
        }
#pragma unroll
        for (int i = 0; i < 4; ++i)
#pragma unroll
            for (int j = 0; j < 8; ++j) epi(pm * 128 + ty * 4 + i, pn * 128 + tx * 8 + j, acc[i][j]);
    }
}

struct EpiR1 { bf16* QKV; bf16* QB; bf16* KB; bf16* VB; float* AB;
    __device__ __forceinline__ void operator()(int r, int c, float v) const {
        if (c < 3072) QKV[(size_t)r * 3072 + c] = (bf16)f2bf(v);
        else if (c < 4096) { if (r < MLAT) QB[(size_t)r * 1024 + (c - 3072)] = (bf16)f2bf(v); }
        else if (c < 5120) KB[(size_t)r * 1024 + (c - 4096)] = (bf16)f2bf(v);
        else if (c < 6144) VB[(size_t)r * 1024 + (c - 5120)] = (bf16)f2bf(v);
        else if (c < 6176) AB[(size_t)r * 32 + (c - 6144)] = v;
    } };
struct EpiR2 { bf16* NA; bf16* QB; bf16* GATES;
    __device__ __forceinline__ void operator()(int r, int c, float v) const {
        if (c < 1024) { bf16* p = NA + (size_t)r * 1024 + c; *p = (bf16)f2bf(silu_f(v) * bf2f(*p)); }
        else if (c < 2048) { bf16* p = QB + (size_t)r * 1024 + (c - 1024); *p = (bf16)f2bf(0.8f * silu_f(v) * bf2f(*p)); }
        else GATES[(size_t)r * 2048 + (c - 2048)] = (bf16)f2bf(sigmoid_f(v));
    } };
struct EpiR2Chk { bf16* NA; bf16* QB; bf16* GATES; const bf16* YA2; const bf16* YB2; unsigned* cnt;
    __device__ __forceinline__ void operator()(int r, int c, float v) const {
        float ref, got;
        if (c < 1024) { bf16* p = NA + (size_t)r * 1024 + c; ref = silu_f(v) * bf2f(YA2[(size_t)r * 1024 + c]); got = bf2f(*p); *p = (bf16)f2bf(ref); if (fabsf(ref - got) > 0.02f * fabsf(ref) + 0.01f) atomicAdd(cnt + 0, 1u); }
        else if (c < 2048) { bf16* p = QB + (size_t)r * 1024 + (c - 1024); ref = 0.8f * silu_f(v) * bf2f(YB2[(size_t)r * 1024 + (c - 1024)]); got = bf2f(*p); *p = (bf16)f2bf(ref); if (fabsf(ref - got) > 0.02f * fabsf(ref) + 0.01f) atomicAdd(cnt + 1, 1u); }
        else { bf16* p = GATES + (size_t)r * 2048 + (c - 2048); ref = sigmoid_f(v); got = bf2f(*p); *p = (bf16)f2bf(ref); if (fabsf(ref - got) > 0.02f) atomicAdd(cnt + 2, 1u); }
    } };
struct EpiF1 { bf16* T1; const bf16* GATES;
    __device__ __forceinline__ void operator()(int r, int c, float v) const { T1[(size_t)r * 1024 + c] = (bf16)f2bf(v * bf2f(GATES[(size_t)r * 2048 + c])); } };
struct EpiF2 { bf16* MERGED; const bf16* T1; const bf16* GATES;
    __device__ __forceinline__ void operator()(int r, int c, float v) const { MERGED[(size_t)r * 1024 + c] = (bf16)f2bf(bf2f(T1[(size_t)r * 1024 + c]) + v * bf2f(GATES[(size_t)r * 2048 + 1024 + c])); } };
struct EpiG { float* out; const float* x; const float* mod;
    __device__ __forceinline__ void operator()(int r, int c, float v) const { const int b = r / SEQ; out[(size_t)r * 1024 + c] = x[(size_t)r * 1024 + c] + mod[b * 3072 + 2048 + c] * v; } };

namespace pg8 {
#define PG8_LAS __attribute__((address_space(3)))
typedef unsigned short bf16_t;
typedef short bf16x8 __attribute__((ext_vector_type(8)));
typedef float f32x4 __attribute__((ext_vector_type(4)));
typedef unsigned u32x4 __attribute__((ext_vector_type(4)));
constexpr int BM = 256, BK = 64, HALF = 128, HTB = HALF * BK * 2  , STAGE_BYTES = 8 * HTB, NXCD = 8, WGM = 8;

__host__ __device__ __forceinline__ int lds_byte(int r, int c) { const int st = (r >> 4) * 2 + (c >> 5), rr = r & 15, cc = c & 31, ob = rr * 64 + cc * 2; return st * 1024 + (ob ^ (((ob >> 9) & 1) << 5)); }
__host__ __device__ __forceinline__ void stage_rc(int b, int& R, int& C) { const int st = b / 1024, sb = b % 1024, swz = sb ^ (((sb >> 9) & 1) << 5); R = (st >> 1) * 16 + swz / 64; C = (st & 1) * 32 + (swz % 64) / 2; }
__host__ __device__ __forceinline__ int perm32(int rho) { const int n = rho >> 4, i = rho & 15; return 8 * (i >> 2) + 4 * n + (i & 3); }

struct Unit { int pm, pn; };
struct Gemm { const bf16_t* A; const bf16_t* Bt; int M, N, K; };

struct StaticOrder {
    int nM, nN, nwg, G, c;
    __host__ __device__ void init(int M, int N, int G_, int c_) { nM = M / BM; nN = N / BM; nwg = nM * nN; G = G_; c = c_; }
    __host__ __device__ bool next(int i, Unit& u) const {
        const long L = (long)i * G + c; if (L >= nwg) return false;
        int wgid = (int)L; { const int q = nwg / NXCD, r = nwg % NXCD, xcd = wgid % NXCD, off = wgid / NXCD; wgid = (xcd < r ? xcd * (q + 1) : r * (q + 1) + (xcd - r) * q) + off; }
        const int nig = WGM * nN, gid = wgid / nig, fm = gid * WGM, gsz = (nM - fm) < WGM ? (nM - fm) : WGM;
        u.pm = fm + ((wgid % nig) % gsz); u.pn = (wgid % nig) / gsz; return true;
    }
    __device__ __forceinline__ void a_ready(const Unit&) const {}
    __device__ __forceinline__ void done(const Unit&) const {}
};

__device__ __forceinline__ unsigned cvt_pk_bf16(float lo, float hi) { unsigned r; asm volatile("v_cvt_pk_bf16_f32 %0, %1, %2" : "=v"(r) : "v"(lo), "v"(hi)); return r; }
__device__ __forceinline__ float silu_e(float x) { return x * __builtin_amdgcn_rcpf(1.f + __expf(-x)); }
__device__ __forceinline__ float sigm_e(float x) { return __builtin_amdgcn_rcpf(1.f + __expf(-x)); }
__device__ __forceinline__ float blo(unsigned w) { return __builtin_bit_cast(float, w << 16); }
__device__ __forceinline__ float bhi(unsigned w) { return __builtin_bit_cast(float, w & 0xffff0000u); }
__device__ __forceinline__ u32x4 pack8(const f32x4 v0, const f32x4 v1) { u32x4 w; w.x = cvt_pk_bf16(v0[0], v0[1]); w.y = cvt_pk_bf16(v0[2], v0[3]); w.z = cvt_pk_bf16(v1[0], v1[1]); w.w = cvt_pk_bf16(v1[2], v1[3]); return w; }
struct EpiR1 {
    static constexpr bool PERM = true, AFTER_DRAIN = false;
    bf16_t* QKV; bf16_t* QB; bf16_t* KB; bf16_t* VB; float* AB; int mlat_tiles; bf16_t* HALO;
    __device__ __forceinline__ void operator()(const f32x4 (&acc)[2][2][4][2], const Unit& u, int wr, int wc, int fr, int fq) const {
        const int row0 = u.pm * BM + wr * 64 + fr, cl = wc * 32 + 8 * fq;
        bf16_t* base; int ldc, colt;
        if (u.pn < 12) { base = QKV; ldc = 3072; colt = u.pn * 256; }
        else if (u.pn < 16) { if (u.pm >= mlat_tiles) return; base = QB; ldc = 1024; colt = (u.pn - 12) * 256; }
        else if (u.pn < 20) { base = KB; ldc = 1024; colt = (u.pn - 16) * 256; }
        else if (u.pn < 24) { base = VB; ldc = 1024; colt = (u.pn - 20) * 256; }
        else {
            if (wc == 0) {
#pragma unroll
                for (int ai = 0; ai < 2; ++ai)
#pragma unroll
                    for (int m = 0; m < 4; ++m) { float* p = AB + (size_t)(row0 + ai * HALF + m * 16) * 32 + 8 * fq; *(f32x4*)p = acc[ai][0][m][0]; *(f32x4*)(p + 4) = acc[ai][0][m][1]; }
            }
            return;
        }
#pragma unroll
        for (int ai = 0; ai < 2; ++ai)
#pragma unroll
            for (int m = 0; m < 4; ++m) { bf16_t* rowp = base + (size_t)(row0 + ai * HALF + m * 16) * ldc + colt + cl;
#pragma unroll
                for (int bj = 0; bj < 2; ++bj) *(u32x4*)(rowp + bj * HALF) = pack8(acc[ai][bj][m][0], acc[ai][bj][m][1]);
                if (u.pn < 12 && (m == 0 || m == 3)) {
                    const bool hrow = (m == 0) ? (fr < 2) : (fr >= 14);
                    if (hrow) { const int r = row0 + ai * HALF + m * 16; const int slot = (m == 0) ? fr : fr - 12;
                        bf16_t* hp = HALO + ((size_t)(r >> 6) * 4 + slot) * 3072 + colt + cl;
#pragma unroll
                        for (int bj = 0; bj < 2; ++bj) *(u32x4*)(hp + bj * HALF) = pack8(acc[ai][bj][m][0], acc[ai][bj][m][1]); } }
            }
    }
};
struct EpiR2 {
    static constexpr bool PERM = true, AFTER_DRAIN = false;
    bf16_t* NA; bf16_t* QB; bf16_t* GATES; bf16_t* YA2; bf16_t* YB2;
    __device__ __forceinline__ void operator()(const f32x4 (&acc)[2][2][4][2], const Unit& u, int wr, int wc, int fr, int fq) const {
        const int row0 = u.pm * BM + wr * 64 + fr, cl = wc * 32 + 8 * fq;
        if (u.pn >= 8) {
            const int colt = (u.pn - 8) * 256;
#pragma unroll
            for (int ai = 0; ai < 2; ++ai)
#pragma unroll
                for (int m = 0; m < 4; ++m) { bf16_t* rowp = GATES + (size_t)(row0 + ai * HALF + m * 16) * 2048 + colt + cl;
#pragma unroll
                    for (int bj = 0; bj < 2; ++bj) { f32x4 v0 = acc[ai][bj][m][0], v1 = acc[ai][bj][m][1];
#pragma unroll
                        for (int i = 0; i < 4; ++i) { v0[i] = sigm_e(v0[i]); v1[i] = sigm_e(v1[i]); }
                        *(u32x4*)(rowp + bj * HALF) = pack8(v0, v1); } }
            return;
        }
        if (R2_SKIP_Z) return;
        bf16_t* base = (u.pn < 4) ? NA : QB; bf16_t* dst = (u.pn < 4) ? YA2 : YB2; const float sc = (u.pn < 4) ? 1.0f : 0.8f; const int colt = (u.pn & 3) * 256;
#pragma unroll
        for (int ai = 0; ai < 2; ++ai)
#pragma unroll
            for (int m = 0; m < 4; ++m) { bf16_t* rowp = base + (size_t)(row0 + ai * HALF + m * 16) * 1024 + colt + cl; bf16_t* rowd = dst + (size_t)(row0 + ai * HALF + m * 16) * 1024 + colt + cl;
#pragma unroll
                for (int bj = 0; bj < 2; ++bj) { const u32x4 old = *(const u32x4*)(rowp + bj * HALF); f32x4 v0 = acc[ai][bj][m][0], v1 = acc[ai][bj][m][1];
                    v0[0] = silu_e(v0[0]) * sc * blo(old.x); v0[1] = silu_e(v0[1]) * sc * bhi(old.x); v0[2] = silu_e(v0[2]) * sc * blo(old.y); v0[3] = silu_e(v0[3]) * sc * bhi(old.y);
                    v1[0] = silu_e(v1[0]) * sc * blo(old.z); v1[1] = silu_e(v1[1]) * sc * bhi(old.z); v1[2] = silu_e(v1[2]) * sc * blo(old.w); v1[3] = silu_e(v1[3]) * sc * bhi(old.w);
                    *(u32x4*)(rowd + bj * HALF) = pack8(v0, v1); } }
    }
};
struct EpiF {
    static constexpr bool PERM = true, AFTER_DRAIN = false;
    bf16_t* OUT; const bf16_t* T1; const bf16_t* GATES; int mode;
    __device__ __forceinline__ void operator()(const f32x4 (&acc)[2][2][4][2], const Unit& u, int wr, int wc, int fr, int fq) const {
        const int row0 = u.pm * BM + wr * 64 + fr, col0 = u.pn * BM + wc * 32 + 8 * fq;
#pragma unroll
        for (int ai = 0; ai < 2; ++ai)
#pragma unroll
            for (int m = 0; m < 4; ++m) { const size_t r = (size_t)(row0 + ai * HALF + m * 16);
#pragma unroll
                for (int bj = 0; bj < 2; ++bj) { const int c = col0 + bj * HALF;
                    const u32x4 g = *(const u32x4*)(GATES + r * 2048 + mode * 1024 + c); f32x4 v0 = acc[ai][bj][m][0], v1 = acc[ai][bj][m][1];
                    v0[0] *= blo(g.x); v0[1] *= bhi(g.x); v0[2] *= blo(g.y); v0[3] *= bhi(g.y); v1[0] *= blo(g.z); v1[1] *= bhi(g.z); v1[2] *= blo(g.w); v1[3] *= bhi(g.w);
                    if (mode) { const u32x4 t = *(const u32x4*)(T1 + r * 1024 + c);
                        v0[0] += blo(t.x); v0[1] += bhi(t.x); v0[2] += blo(t.y); v0[3] += bhi(t.y); v1[0] += blo(t.z); v1[1] += bhi(t.z); v1[2] += blo(t.w); v1[3] += bhi(t.w); }
                    *(u32x4*)(OUT + r * 1024 + c) = pack8(v0, v1); } }
    }
};
struct EpiG {
    static constexpr bool PERM = true, AFTER_DRAIN = false;
    float* out; const float* x; const float* mod; int tiles_per_batch;
    __device__ __forceinline__ void operator()(const f32x4 (&acc)[2][2][4][2], const Unit& u, int wr, int wc, int fr, int fq) const {
        const int row0 = u.pm * BM + wr * 64 + fr, col0 = u.pn * BM + wc * 32 + 8 * fq; const int b = u.pm / tiles_per_batch;
        f32x4 gv[2][2];
#pragma unroll
        for (int bj = 0; bj < 2; ++bj) { gv[bj][0] = *(const f32x4*)(mod + b * 3072 + 2048 + col0 + bj * HALF); gv[bj][1] = *(const f32x4*)(mod + b * 3072 + 2048 + col0 + bj * HALF + 4); }
#pragma unroll
        for (int ai = 0; ai < 2; ++ai)
#pragma unroll
            for (int m = 0; m < 4; ++m) { const size_t off = (size_t)(row0 + ai * HALF + m * 16) * 1024 + col0;
#pragma unroll
                for (int bj = 0; bj < 2; ++bj) { const f32x4 x0 = *(const f32x4*)(x + off + bj * HALF), x1 = *(const f32x4*)(x + off + bj * HALF + 4);
                    *(f32x4*)(out + off + bj * HALF) = x0 + gv[bj][0] * acc[ai][bj][m][0]; *(f32x4*)(out + off + bj * HALF + 4) = x1 + gv[bj][1] * acc[ai][bj][m][1]; } }
    }
};
template <class Epi, class Sched, bool ALIGN_EPI = false, bool SP2 = false>
__device__ __forceinline__ void gemm_phase(PG8_LAS unsigned char* lds, const Gemm g, const Sched& S, const Epi& E, int wv) {
    int tid_ = wv * 64 + lane_id(); asm volatile("" : "+v"(tid_));
    const int tid = tid_, wid = __builtin_amdgcn_readfirstlane(tid >> 6), lane = tid & 63, wr = wid >> 2, wc = wid & 3, fr = lane & 15, fq = lane >> 4;
    const int K = g.K, nt = K / BK;
    unsigned voffA[2], voffB[2];
#pragma unroll
    for (int i = 0; i < 2; ++i) { int R, C; stage_rc(tid * 16 + i * 8192, R, C); const int Rb = Epi::PERM ? ((R & ~31) + perm32(R & 31)) : R;
        voffA[i] = (unsigned)(R * K + C) * 2u; voffB[i] = (unsigned)(Rb * K + C) * 2u; }
    const size_t kstep = (size_t)(BK * 2);
    const size_t hstep = (size_t)HALF * K * 2;
    const size_t tstep = 2 * hstep;
    const unsigned ldsw = (unsigned)wid * 1024u;
    const int aoff = lds_byte(wr * 64 + fr, fq * 8), boff = lds_byte(wc * 32 + fr, fq * 8);
#define PG8_SA(b, h) (((b) * 2 + (h)) * HTB)
#define PG8_SB(b, h) ((4 + (b) * 2 + (h)) * HTB)
#define PG8_STAGE(bufoff, gbase, voff) do { _Pragma("unroll") for (int _i = 0; _i < 2; ++_i) \
        __builtin_amdgcn_global_load_lds((const unsigned*)((const char*)(gbase) + (voff)[_i]), (PG8_LAS unsigned*)(lds + (bufoff) + ldsw + _i * 8192), 16, 0, 0); } while (0)
#define PG8_LDA(dst, b, h) do { _Pragma("unroll") for (int m = 0; m < 4; ++m) _Pragma("unroll") for (int k = 0; k < 2; ++k) dst[m][k] = *(const PG8_LAS bf16x8*)(lds + PG8_SA(b, h) + aoff + m * 2048 + k * 1024); } while (0)
#define PG8_LDB(dst, b, h) do { _Pragma("unroll") for (int n = 0; n < 2; ++n) _Pragma("unroll") for (int k = 0; k < 2; ++k) dst[n][k] = *(const PG8_LAS bf16x8*)(lds + PG8_SB(b, h) + boff + n * 2048 + k * 1024); } while (0)
#define PG8_MMA(ai, bj, At, Bt) do { __builtin_amdgcn_s_setprio(1); _Pragma("unroll") for (int m = 0; m < 4; ++m) _Pragma("unroll") for (int n = 0; n < 2; ++n) _Pragma("unroll") for (int k = 0; k < 2; ++k) \
        acc[ai][bj][m][n] = __builtin_amdgcn_mfma_f32_16x16x32_bf16(Bt[n][k], At[m][k], acc[ai][bj][m][n], 0, 0, 0); __builtin_amdgcn_s_setprio(0); } while (0)
#define PG8_WAIT_V(n) asm volatile("s_waitcnt vmcnt(" #n ")" ::: "memory")
#define PG8_WAIT_L(n) asm volatile("s_waitcnt lgkmcnt(" #n ")" ::: "memory")
#define PG8_BAR __builtin_amdgcn_s_barrier()
#define PG8_SCHED __builtin_amdgcn_sched_barrier(0)
    Unit cur, nxt; int ui = 0;
    if (!S.next(0, cur)) return;
    f32x4 acc[2][2][4][2];
#pragma unroll
    for (int a = 0; a < 2; ++a)
#pragma unroll
        for (int b = 0; b < 2; ++b)
#pragma unroll
            for (int m = 0; m < 4; ++m)
#pragma unroll
                for (int n = 0; n < 2; ++n) acc[a][b][m][n] = (f32x4){0.f, 0.f, 0.f, 0.f};
    bf16x8 At[4][2], B0[2][2], B1[2][2];
    const char* cA = (const char*)g.A + (size_t)cur.pm * tstep; const char* cB = (const char*)g.Bt + (size_t)cur.pn * tstep;
    S.a_ready(cur);
    if constexpr (SP2) {
        PG8_STAGE(PG8_SB(0, 0), cB, voffB); PG8_STAGE(PG8_SB(0, 1), cB + hstep, voffB); PG8_STAGE(PG8_SA(0, 0), cA, voffA); PG8_STAGE(PG8_SA(0, 1), cA + hstep, voffA);
        if (wr == 1) PG8_BAR;
        PG8_WAIT_V(2); PG8_BAR;
        PG8_STAGE(PG8_SB(1, 0), cB + kstep, voffB); PG8_STAGE(PG8_SA(1, 0), cA + kstep, voffA); PG8_STAGE(PG8_SB(1, 1), cB + hstep + kstep, voffB);
        PG8_WAIT_V(6); PG8_BAR;
    } else {
        PG8_STAGE(PG8_SB(0, 0), cB, voffB); PG8_STAGE(PG8_SA(0, 0), cA, voffA); PG8_STAGE(PG8_SB(0, 1), cB + hstep, voffB); PG8_STAGE(PG8_SA(0, 1), cA + hstep, voffA);
        if (wr == 1) PG8_BAR;
        PG8_WAIT_V(4); PG8_BAR;
        PG8_STAGE(PG8_SB(1, 0), cB + kstep, voffB); PG8_STAGE(PG8_SA(1, 0), cA + kstep, voffA); PG8_STAGE(PG8_SB(1, 1), cB + hstep + kstep, voffB);
        PG8_WAIT_V(6); PG8_BAR;
    }
    for (;;) {
        const bool has_next = S.next(ui + 1, nxt);
        const char* nA = has_next ? (const char*)g.A + (size_t)nxt.pm * tstep : cA; const char* nB = has_next ? (const char*)g.Bt + (size_t)nxt.pn * tstep : cB;
        for (int t = 0; t < nt; t += 2) {
            const bool last = (t == nt - 2);
            const char* a1 = cA + (size_t)(t + 1) * kstep;
            const char* a2 = last ? nA : cA + (size_t)(t + 2) * kstep; const char* b2 = last ? nB : cB + (size_t)(t + 2) * kstep;
            const char* a3 = a2 + kstep; const char* b3 = b2 + kstep;
            if (last && has_next) S.a_ready(nxt);
            if constexpr (SP2) {
            PG8_LDB(B0, 0, 0); PG8_LDB(B1, 0, 1); PG8_SCHED; PG8_LDA(At, 0, 0); PG8_STAGE(PG8_SA(1, 1), a1 + hstep, voffA);
            PG8_WAIT_V(8); PG8_WAIT_L(0); PG8_BAR; PG8_MMA(0, 0, At, B0); PG8_MMA(0, 1, At, B1); PG8_BAR; PG8_SCHED;
            PG8_LDA(At, 0, 1); PG8_STAGE(PG8_SB(0, 0), b2, voffB); PG8_STAGE(PG8_SB(0, 1), b2 + hstep, voffB); PG8_STAGE(PG8_SA(0, 0), a2, voffA);
            PG8_WAIT_V(8); PG8_WAIT_L(0); PG8_BAR; PG8_MMA(1, 0, At, B0); PG8_MMA(1, 1, At, B1); PG8_BAR; PG8_SCHED;
            PG8_LDB(B0, 1, 0); PG8_LDB(B1, 1, 1); PG8_SCHED; PG8_LDA(At, 1, 0); PG8_STAGE(PG8_SA(0, 1), a2 + hstep, voffA);
            PG8_WAIT_V(8); PG8_WAIT_L(0); PG8_BAR; PG8_MMA(0, 0, At, B0); PG8_MMA(0, 1, At, B1); PG8_BAR; PG8_SCHED;
            PG8_LDA(At, 1, 1); PG8_STAGE(PG8_SB(1, 0), b3, voffB); PG8_STAGE(PG8_SB(1, 1), b3 + hstep, voffB); PG8_STAGE(PG8_SA(1, 0), a3, voffA);
            PG8_WAIT_V(8); PG8_WAIT_L(0); PG8_BAR; PG8_MMA(1, 0, At, B0); PG8_MMA(1, 1, At, B1); PG8_BAR; PG8_SCHED;
            } else {
            PG8_LDB(B0, 0, 0); PG8_SCHED; PG8_LDA(At, 0, 0); PG8_STAGE(PG8_SA(1, 1), a1 + hstep, voffA);
            PG8_WAIT_L(8); PG8_BAR; PG8_WAIT_L(0); PG8_MMA(0, 0, At, B0); PG8_BAR; PG8_SCHED;
            PG8_LDB(B1, 0, 1); PG8_STAGE(PG8_SB(0, 0), b2, voffB);
            PG8_BAR; PG8_WAIT_L(0); PG8_MMA(0, 1, At, B1); PG8_BAR;
            PG8_LDA(At, 0, 1); PG8_STAGE(PG8_SA(0, 0), a2, voffA);
            PG8_BAR; PG8_WAIT_L(0); PG8_MMA(1, 0, At, B0); PG8_BAR; PG8_SCHED;
            PG8_STAGE(PG8_SB(0, 1), b2 + hstep, voffB);
            PG8_WAIT_V(6); PG8_BAR; PG8_MMA(1, 1, At, B1); PG8_BAR;
            PG8_LDB(B0, 1, 0); PG8_SCHED; PG8_LDA(At, 1, 0); PG8_STAGE(PG8_SA(0, 1), a2 + hstep, voffA);
            PG8_WAIT_L(8); PG8_BAR; PG8_WAIT_L(0); PG8_MMA(0, 0, At, B0); PG8_BAR; PG8_SCHED;
            PG8_LDB(B1, 1, 1); PG8_STAGE(PG8_SB(1, 0), b3, voffB);
            PG8_BAR; PG8_WAIT_L(0); PG8_MMA(0, 1, At, B1); PG8_BAR;
            PG8_LDA(At, 1, 1); PG8_STAGE(PG8_SA(1, 0), a3, voffA);
            PG8_BAR; PG8_WAIT_L(0); PG8_MMA(1, 0, At, B0); PG8_BAR; PG8_SCHED;
            PG8_STAGE(PG8_SB(1, 1), b3 + hstep, voffB);
            PG8_WAIT_V(6); PG8_BAR; PG8_MMA(1, 1, At, B1); PG8_BAR;
            }
        }
        if constexpr (ALIGN_EPI) { if (wr == 0) PG8_BAR; }
        if constexpr (!Epi::AFTER_DRAIN) { E(acc, cur, wr, wc, fr, fq); S.done(cur); }
        if (!has_next) break;
#pragma unroll
        for (int a = 0; a < 2; ++a)
#pragma unroll
            for (int b = 0; b < 2; ++b)
#pragma unroll
                for (int m = 0; m < 4; ++m)
#pragma unroll
                    for (int n = 0; n < 2; ++n) acc[a][b][m][n] = (f32x4){0.f, 0.f, 0.f, 0.f};
        cur = nxt; cA = nA; cB = nB; ++ui;
        if constexpr (ALIGN_EPI) { if (wr == 1) PG8_BAR; }
    }
    PG8_WAIT_V(0);
    if constexpr (!ALIGN_EPI) { if (wr == 0) PG8_BAR; }
    PG8_BAR;
    if constexpr (Epi::AFTER_DRAIN) { E.fused(acc, cur, wr, wc, fr, fq, lds, wid, lane); S.done(cur); }
#undef PG8_SA
#undef PG8_SB
#undef PG8_STAGE
#undef PG8_LDA
#undef PG8_LDB
#undef PG8_MMA
#undef PG8_WAIT_V
#undef PG8_WAIT_L
#undef PG8_BAR
#undef PG8_SCHED
}
}

namespace att {
using bf16x8 = __attribute__((ext_vector_type(8))) short;
using s16x4  = __attribute__((ext_vector_type(4))) short;
using f32x16 = __attribute__((ext_vector_type(16))) float;
using u32x4  = __attribute__((ext_vector_type(4))) unsigned;
constexpr int KVBLK = 64, NTILES = (LCTX + SEQ) / KVBLK;
constexpr int SHM_V = KVBLK * 128 * 2, SHM_K = KVBLK * 128 * 2;
constexpr int LDS_WS = 3 * SHM_V + 3 * SHM_K;
#define KSWZ(row, colB) ((row) * 256 + ((colB) ^ (((row) & 7) << 4)))
#define SBAR() __builtin_amdgcn_sched_barrier(0)
__device__ __forceinline__ int crow(int r, int hi) { return (r & 3) + 8 * (r >> 2) + 4 * hi; }
__device__ __forceinline__ unsigned cvtpk(float lo, float hi) { unsigned r; asm volatile("v_cvt_pk_bf16_f32 %0, %1, %2" : "=v"(r) : "v"(lo), "v"(hi)); return r; }
__device__ __forceinline__ int v_st(int k, int c) { const int kk = (k & ~0xC) | ((k & 4) << 1) | ((k & 8) >> 1); return ((kk >> 3) * 4 + (c >> 5)) * 512 + ((kk & 7) * 32 + (c & 31)) * 2; }
__device__ __forceinline__ int v_rd_base(int lane) { return ((lane & 3) << 3) | (((lane >> 2) & 3) << 6) | (((lane >> 4) & 1) << 5) | (((lane >> 5) & 1) << 8); }
constexpr int v_rd_off(int d0, int ks, int half) { return d0 * 512 + ks * 4096 + half * 2048; }
template <int OFF> __device__ __forceinline__ s16x4 tr_read(int vb) { s16x4 r; asm volatile("ds_read_b64_tr_b16 %0, %1 offset:%2" : "=&v"(r) : "v"(vb), "i"(OFF) : "memory"); return r; }
template <int D0> __device__ __forceinline__ void pv_one(f32x16& od, int vb, bf16x8 pa0, bf16x8 pa1, bf16x8 pa2, bf16x8 pa3) {
  const s16x4 l0 = tr_read<v_rd_off(D0, 0, 0)>(vb), h0 = tr_read<v_rd_off(D0, 0, 1)>(vb), l1 = tr_read<v_rd_off(D0, 1, 0)>(vb), h1 = tr_read<v_rd_off(D0, 1, 1)>(vb);
  const s16x4 l2 = tr_read<v_rd_off(D0, 2, 0)>(vb), h2 = tr_read<v_rd_off(D0, 2, 1)>(vb), l3 = tr_read<v_rd_off(D0, 3, 0)>(vb), h3 = tr_read<v_rd_off(D0, 3, 1)>(vb);
  asm volatile("s_waitcnt lgkmcnt(0)" ::: "memory"); SBAR();
#define PK(L, H) (bf16x8){L[0], L[1], L[2], L[3], H[0], H[1], H[2], H[3]}
  od = __builtin_amdgcn_mfma_f32_32x32x16_bf16(pa0, PK(l0, h0), od, 0, 0, 0);
  od = __builtin_amdgcn_mfma_f32_32x32x16_bf16(pa1, PK(l1, h1), od, 0, 0, 0);
  od = __builtin_amdgcn_mfma_f32_32x32x16_bf16(pa2, PK(l2, h2), od, 0, 0, 0);
  od = __builtin_amdgcn_mfma_f32_32x32x16_bf16(pa3, PK(l3, h3), od, 0, 0, 0);
#undef PK
}
__device__ __forceinline__ void pv_d0(f32x16* o, int vb, bf16x8 pa0, bf16x8 pa1, bf16x8 pa2, bf16x8 pa3) {
  pv_one<0>(o[0], vb, pa0, pa1, pa2, pa3); pv_one<1>(o[1], vb, pa0, pa1, pa2, pa3); pv_one<2>(o[2], vb, pa0, pa1, pa2, pa3); pv_one<3>(o[3], vb, pa0, pa1, pa2, pa3);
}
__device__ __forceinline__ void qkt(f32x16& p0, f32x16& p1, const char* Ks, const char* qr, int comp, int r32, int hi, float negm_) {
  float negm = __uint_as_float(__builtin_amdgcn_readfirstlane(__float_as_uint(negm_)));
#pragma unroll
  for (int r = 0; r < 16; ++r) { p0[r] = negm; p1[r] = negm; }
#pragma unroll
  for (int d0 = 0; d0 < 4; ++d0) { const int cb = ((comp * 4 + d0) * 16 + hi * 8) * 2;
    const bf16x8 b0 = *reinterpret_cast<const bf16x8*>(Ks + KSWZ(r32, cb));
    const bf16x8 b1 = *reinterpret_cast<const bf16x8*>(Ks + KSWZ(32 + r32, cb));
    const bf16x8 qf = *reinterpret_cast<const bf16x8*>(qr + d0 * 1024);
    p0 = __builtin_amdgcn_mfma_f32_32x32x16_bf16(b0, qf, p0, 0, 0, 0);
    p1 = __builtin_amdgcn_mfma_f32_32x32x16_bf16(b1, qf, p1, 0, 0, 0); }
}
__device__ __forceinline__ void partialSM(f32x16& p0) {
#pragma unroll
  for (int r = 0; r < 16; ++r) p0[r] = __builtin_amdgcn_exp2f(p0[r]);
}
__device__ __forceinline__ void finishSM(f32x16& p0, f32x16& p1, float& l_reg, bf16x8& pa0, bf16x8& pa1, bf16x8& pa2, bf16x8& pa3) {
#pragma unroll
  for (int r = 0; r < 16; ++r) p1[r] = __builtin_amdgcn_exp2f(p1[r]);
  float ps = 0.f;
#pragma unroll
  for (int r = 0; r < 16; ++r) ps += p0[r];
#pragma unroll
  for (int r = 0; r < 16; ++r) ps += p1[r];
  l_reg += ps;
#define PK4(P, BASE, OUT) do { unsigned a0 = cvtpk(P[BASE + 0], P[BASE + 1]), a1 = cvtpk(P[BASE + 2], P[BASE + 3]);   \
    unsigned b0 = cvtpk(P[BASE + 4], P[BASE + 5]), b1 = cvtpk(P[BASE + 6], P[BASE + 7]);                              \
    auto r0 = __builtin_amdgcn_permlane32_swap(a0, b0, false, false); auto r1 = __builtin_amdgcn_permlane32_swap(a1, b1, false, false); \
    u32x4 w = {r0[0], r1[0], r0[1], r1[1]}; OUT = *reinterpret_cast<bf16x8*>(&w); } while (0)
  PK4(p0, 0, pa0); PK4(p0, 8, pa1); PK4(p1, 0, pa2); PK4(p1, 8, pa3);
#undef PK4
}
__device__ __forceinline__ long tile_row(int b, int t) { return t < LCTX / KVBLK ? (long)(MLAT + b * LCTX + t * KVBLK) : (long)(b * SEQ + (t - LCTX / KVBLK) * KVBLK); }

__device__ __forceinline__ void attn_unit(int b, int h, int qb, unsigned short* QBm, const unsigned short* __restrict__ KBm, const unsigned short* __restrict__ VBm,
                                          const float* dnw, float lam, float negm, char* lds, int wv, unsigned short* dummy_out = nullptr) {
  int tid_ = wv * 64 + lane_id(); asm volatile("" : "+v"(tid_));
  const int tid = tid_, wid = wv, lane = tid & 63, r32 = lane & 31, hi = lane >> 5, comp = wid >> 2, g = wid & 3;
  constexpr int RING = 3 * SHM_K;
  char* K_lds = lds; char* V_lds = lds + RING;
  float* wsf = (float*)(lds + 2 * RING) + wid * 64;
  float l_reg = 0.f; f32x16 o[4] = {};
  const long qrow0 = (long)b * SEQ + qb * 128 + g * 32;
  char* qs = lds + 2 * RING + 2048 + wid * 4096 + lane * 16;
  { const unsigned short* Qw = QBm + (qrow0 + r32) * 1024 + h * 128 + comp * 64 + hi * 8;
#pragma unroll
    for (int d0 = 0; d0 < 4; ++d0) *reinterpret_cast<bf16x8*>(qs + d0 * 1024) = *reinterpret_cast<const bf16x8*>(Qw + d0 * 16); }
  const char* qr = qs;
  const int vb0 = (int)(uintptr_t)V_lds + v_rd_base(lane);
  int ksrc[2], vsrc[2];
#pragma unroll
  for (int k = 0; k < 2; ++k) { const int q = 2 * wid + k, s = 64 * q + lane;
    { const int row = s >> 4, chunk = (s & 15) ^ (row & 7); ksrc[k] = row * 1024 + h * 128 + chunk * 8; }
    { const int kk = ((s >> 7) << 3) | ((s >> 2) & 7), cb = (s >> 5) & 3, cc = s & 3; const int key = (kk & ~0xC) | ((kk & 4) << 1) | ((kk & 8) >> 1);
      vsrc[k] = key * 1024 + h * 128 + cb * 32 + cc * 8; } }
  const unsigned ldsK = (unsigned)(uintptr_t)K_lds, ldsV = (unsigned)(uintptr_t)V_lds;
#define GLDS16(gsrc, ldsdst) do { unsigned keep_; asm volatile("s_mov_b32 %0, m0\n\ts_mov_b32 m0, %2\n\ts_nop 0\n\tglobal_load_lds_dwordx4 %1, off\n\ts_mov_b32 m0, %0" : "=&s"(keep_) : "v"(gsrc), "s"(ldsdst) : "memory"); } while (0)
#define STAGE(t, slotoff) do { const long _r = tile_row(b, (t)) * 1024; \
    _Pragma("unroll") for (int k_ = 0; k_ < 2; ++k_) { \
      GLDS16(KBm + _r + ksrc[k_], (unsigned)__builtin_amdgcn_readfirstlane(ldsK + (slotoff) + (2 * wid + k_) * 1024)); \
      GLDS16(VBm + _r + vsrc[k_], (unsigned)__builtin_amdgcn_readfirstlane(ldsV + (slotoff) + (2 * wid + k_) * 1024)); } } while (0)
#define DRAIN_SYNC() do { asm volatile("s_waitcnt vmcnt(0)" ::: "memory"); __syncthreads(); } while (0)
  f32x16 pA0, pA1, pB0, pB1; bf16x8 pa0, pa1, pa2, pa3; constexpr int NT = NTILES;
  int sl_prev = 0, sl_cur = 0, sl_next = SHM_K;
#define ROT() do { sl_prev = sl_cur; sl_cur = sl_next; sl_next = (sl_next == 2 * SHM_K) ? 0 : sl_next + SHM_K; } while (0)
  STAGE(0, 0); DRAIN_SYNC();
  STAGE(1, SHM_K);
  qkt(pA0, pA1, K_lds, qr, comp, r32, hi, negm); partialSM(pA0);
  DRAIN_SYNC();
  ROT();
  for (int t = 1; t + 1 < NT; t += 2) {
    STAGE(t + 1, sl_next);
    SBAR(); qkt(pB0, pB1, K_lds + sl_cur, qr, comp, r32, hi, negm);
    finishSM(pA0, pA1, l_reg, pa0, pa1, pa2, pa3); SBAR();
    pv_d0(o, vb0 + sl_prev, pa0, pa1, pa2, pa3); partialSM(pB0);
    DRAIN_SYNC(); ROT();
    if (t + 2 < NT) STAGE(t + 2, sl_next);
    SBAR(); qkt(pA0, pA1, K_lds + sl_cur, qr, comp, r32, hi, negm);
    finishSM(pB0, pB1, l_reg, pa0, pa1, pa2, pa3); SBAR();
    pv_d0(o, vb0 + sl_prev, pa0, pa1, pa2, pa3); partialSM(pA0);
    DRAIN_SYNC(); ROT();
  }
  SBAR(); qkt(pB0, pB1, K_lds + sl_cur, qr, comp, r32, hi, negm);
  finishSM(pA0, pA1, l_reg, pa0, pa1, pa2, pa3); SBAR();
  pv_d0(o, vb0 + sl_prev, pa0, pa1, pa2, pa3); partialSM(pB0);
  finishSM(pB0, pB1, l_reg, pa0, pa1, pa2, pa3); SBAR();
  pv_d0(o, vb0 + sl_cur, pa0, pa1, pa2, pa3);
#undef STAGE
#undef ROT
#undef GLDS16
#undef DRAIN_SYNC
  asm volatile("s_waitcnt vmcnt(0)" ::: "memory");
  { auto rr = __builtin_amdgcn_permlane32_swap(__float_as_uint(l_reg), __float_as_uint(l_reg), false, false); l_reg = __uint_as_float(rr[0]) + __uint_as_float(rr[1]); }
  if (hi == 0) wsf[r32] = l_reg;
  asm volatile("s_waitcnt lgkmcnt(0)" ::: "memory");
  float rli[16];
#pragma unroll
  for (int r = 0; r < 16; ++r) rli[r] = __builtin_amdgcn_rcpf(wsf[crow(r, hi)]);
  __syncthreads();
  float* X = (float*)lds + g * 32 * 128;
  lam = __uint_as_float(__builtin_amdgcn_readfirstlane(__float_as_uint(lam)));
  if (comp == 1) {
#pragma unroll
    for (int r = 0; r < 16; ++r) { const int row = crow(r, hi);
#pragma unroll
      for (int d0 = 0; d0 < 4; ++d0) X[row * 128 + d0 * 32 + r32] = o[d0][r] * rli[r] * lam; }
  }
  __syncthreads();
  if (comp == 0) {
    float ss[16];
#pragma unroll
    for (int r = 0; r < 16; ++r) { const int row = crow(r, hi); float s = 0.f;
#pragma unroll
      for (int d0 = 0; d0 < 4; ++d0) { const float v = o[d0][r] * rli[r] - X[row * 128 + d0 * 32 + r32]; o[d0][r] = v; s += v * v; }
      ss[r] = s; }
#pragma unroll
    for (int r = 0; r < 16; ++r) { float t_ = ss[r]; t_ += xorv<1>(t_); t_ += xorv<2>(t_); t_ += xorv<4>(t_); t_ += xorv<8>(t_); t_ += xorv<16>(t_); ss[r] = t_; }
    float dw[4];
#pragma unroll
    for (int d0 = 0; d0 < 4; ++d0) dw[d0] = dnw[d0 * 32 + r32];
    unsigned short* Ow = dummy_out ? dummy_out + (size_t)(g * 32) * 1024 + h * 128 : QBm + qrow0 * 1024 + h * 128;
#pragma unroll
    for (int r = 0; r < 16; ++r) { const float rstd = 1.f / sqrtf(ss[r] * (1.f / 128.f) + EPS); const int row = crow(r, hi);
#pragma unroll
      for (int d0 = 0; d0 < 4; ++d0) Ow[(long)row * 1024 + d0 * 32 + r32] = (unsigned short)f2bf(o[d0][r] * rstd * dw[d0]); }
  }
  __syncthreads();
}
#undef KSWZ
#undef SBAR
}

namespace gdn {
using bf16x8 = __attribute__((ext_vector_type(8))) short;
using f32x16 = __attribute__((ext_vector_type(16))) float;
using u32x4  = __attribute__((ext_vector_type(4))) unsigned;
using u32x2  = __attribute__((ext_vector_type(2))) unsigned;
constexpr int LK = 136, LT = 72;
constexpr int L_KH = 0, L_QH = 17408, L_KDT = 34816, L_QK = 53248, L_VH = 62464, L_SBF = 79872, L_RBF = 114688, L_VNBF = 133120, L_SM = 151552, L_END = 153088;
constexpr int NSTEP = (LCTX + SEQ) / 64;
constexpr int TUNIT = 3 * 1024;
__device__ __forceinline__ int crow(int r, int hi) { return (r & 3) + 8 * (r >> 2) + 4 * hi; }
__device__ __forceinline__ f32x16 mma(bf16x8 a, bf16x8 b, f32x16 c) { return __builtin_amdgcn_mfma_f32_32x32x16_bf16(a, b, c, 0, 0, 0); }
#define GFRAG(base, ld, tile, ks) (*(const bf16x8*)((base) + ((32 * (tile) + r32) * (ld) + 16 * (ks) + 8 * hi) * 2))

__device__ __forceinline__ int halo_slot(int rr) { return rr < 2 ? rr : rr - 60; }

__device__ __forceinline__ void conv_compute(float (&acc)[8][8], const v4u (&raw)[12], const float* w, int t0, int Ls) {
    float wv[5][8];
#pragma unroll
    for (int j = 0; j < 5; ++j) { const f32x4 a = *(const f32x4*)(w + j * 3072), b = *(const f32x4*)(w + j * 3072 + 4);
        wv[j][0] = a[0]; wv[j][1] = a[1]; wv[j][2] = a[2]; wv[j][3] = a[3]; wv[j][4] = b[0]; wv[j][5] = b[1]; wv[j][6] = b[2]; wv[j][7] = b[3]; }
#pragma unroll
    for (int tt = 0; tt < 8; ++tt)
#pragma unroll
        for (int i = 0; i < 8; ++i) acc[tt][i] = 0.f;
#pragma unroll
    for (int rr = 0; rr < 12; ++rr) {
        const int t = t0 - 2 + rr; const bool ok = (t >= 0) && (t < Ls);
        v4u xv = raw[rr];
        xv.x = ok ? xv.x : 0u; xv.y = ok ? xv.y : 0u; xv.z = ok ? xv.z : 0u; xv.w = ok ? xv.w : 0u;
        const float x[8] = {bflo(xv.x), bfhi(xv.x), bflo(xv.y), bfhi(xv.y), bflo(xv.z), bfhi(xv.z), bflo(xv.w), bfhi(xv.w)};
#pragma unroll
        for (int tt = 0; tt < 8; ++tt) { const int j = rr - tt;
            if (j >= 0 && j <= 4) {
#pragma unroll
                for (int i = 0; i < 8; ++i) acc[tt][i] += x[i] * wv[j][i]; } }
    }
#pragma unroll
    for (int tt = 0; tt < 8; ++tt)
#pragma unroll
        for (int i = 0; i < 8; ++i) acc[tt][i] = acc[tt][i] * __builtin_amdgcn_rcpf(1.f + __expf(-acc[tt][i]));
}
__device__ __forceinline__ void l2scale8(float (&acc)[8][8], float mul) {
#pragma unroll
    for (int tt = 0; tt < 8; ++tt) { float s = 0.f;
#pragma unroll
        for (int i = 0; i < 8; ++i) s += acc[tt][i] * acc[tt][i];
        s += xorv<1>(s); s += xorv<2>(s); s += xorv<4>(s); s += xorv<8>(s);
        const float rs = mul * __builtin_amdgcn_rsqf(s + EPS);
#pragma unroll
        for (int i = 0; i < 8; ++i) acc[tt][i] *= rs; }
}
template <int HALF_> __device__ __forceinline__ void conv_half(float (&acc)[4][8], const v4u (&raw)[12], const float (&wv)[5][8], int t0, int Ls) {
#pragma unroll
    for (int tt = 0; tt < 4; ++tt)
#pragma unroll
        for (int i = 0; i < 8; ++i) acc[tt][i] = 0.f;
#pragma unroll
    for (int rr = 4 * HALF_; rr < 4 * HALF_ + 8; ++rr) {
        const int t = t0 - 2 + rr; const bool ok = (t >= 0) && (t < Ls);
        v4u xv = raw[rr];
        xv.x = ok ? xv.x : 0u; xv.y = ok ? xv.y : 0u; xv.z = ok ? xv.z : 0u; xv.w = ok ? xv.w : 0u;
        const float x[8] = {bflo(xv.x), bfhi(xv.x), bflo(xv.y), bfhi(xv.y), bflo(xv.z), bfhi(xv.z), bflo(xv.w), bfhi(xv.w)};
#pragma unroll
        for (int tt = 0; tt < 4; ++tt) { const int j = rr - (4 * HALF_ + tt);
            if (j >= 0 && j <= 4) {
#pragma unroll
                for (int i = 0; i < 8; ++i) acc[tt][i] += x[i] * wv[j][i]; } }
    }
#pragma unroll
    for (int tt = 0; tt < 4; ++tt)
#pragma unroll
        for (int i = 0; i < 8; ++i) acc[tt][i] = acc[tt][i] * __builtin_amdgcn_rcpf(1.f + __expf(-acc[tt][i]));
}
__device__ __forceinline__ void l2scale4(float (&acc)[4][8], float mul) {
#pragma unroll
    for (int tt = 0; tt < 4; ++tt) { float s = 0.f;
#pragma unroll
        for (int i = 0; i < 8; ++i) s += acc[tt][i] * acc[tt][i];
        s += xorv<1>(s); s += xorv<2>(s); s += xorv<4>(s); s += xorv<8>(s);
        const float rs = mul * __builtin_amdgcn_rsqf(s + EPS);
#pragma unroll
        for (int i = 0; i < 8; ++i) acc[tt][i] *= rs; }
}
__device__ __forceinline__ u32x4 pack8(const float (&v)[8]) { u32x4 w; w.x = pk2(v[0], v[1]); w.y = pk2(v[2], v[3]); w.z = pk2(v[4], v[5]); w.w = pk2(v[6], v[7]); return w; }

__device__ __forceinline__ void gates_wave(float* sm, const float* AB, long r0, int c0, int d, int h, float Aexp, float dtb, int lane) {
    const int t = d ? (c0 + 63 - lane) : (c0 + lane);
    const float araw = AB[(r0 + t) * 32 + d * 8 + h], braw = AB[(r0 + t) * 32 + 16 + d * 8 + h];
    float gc = -Aexp * softplus_f(araw + dtb); const float beta = sigmoid_f(braw);
#pragma unroll
    for (int o = 1; o < 64; o <<= 1) { const float u = __int_as_float(__builtin_amdgcn_ds_bpermute((lane - o) << 2, __float_as_int(gc))); if (lane >= o) gc += u; }
    const float g63 = __int_as_float(__builtin_amdgcn_readlane(__float_as_int(gc), 63)); const float eg = __expf(gc);
    sm[lane] = gc; sm[64 + lane] = beta; sm[128 + lane] = eg; sm[192 + lane] = __expf(g63 - gc); sm[260 + lane] = beta * eg;
    if (lane == 0) sm[256] = __expf(g63);
}

__device__ __forceinline__ void convt_unit(int cc, int h, unsigned short* QKV, const unsigned short* HALO, const float* AB, const float* conv_w, const float* a_log, const float* dt_bias,
                                           unsigned short* Tbuf, char* lds, int wv) {
    int tid_ = wv * 64 + lane_id(); asm volatile("" : "+v"(tid_));
    const int tid = tid_, lane = tid & 63, wid = wv, r32 = lane & 31, hi = lane >> 5;
    const int seg = cc < 256, b = seg ? cc >> 7 : (cc - 256) >> 2, cidx = seg ? cc & 127 : (cc - 256) & 3;
    const int Ls = seg ? SEQ : LCTX, nch = Ls / 64, c0 = cidx * 64; const long r0 = seg ? (long)b * SEQ : (long)MLAT + b * LCTX;
    char* Kn = lds; float* KK = (float*)(lds + 17408); float* Ap = (float*)(lds + 33792); float* sm = (float*)(lds + 66560);
    const int tensor = wid >> 1, tg = (tid >> 4) & 7, c8 = (tid & 15) * 8;
    v4u raw[12];
    if (tid < 384) {
        const int col = tensor * 1024 + h * 128 + c8;
#pragma unroll
        for (int rr = 0; rr < 12; ++rr) { const int t = c0 + tg * 8 - 2 + rr; const bool ok = (t >= 0) && (t < Ls); const int tc = ok ? t : c0; const long row = r0 + tc;
            const bool own = (tc >= c0) && (tc < c0 + 64);
            const unsigned short* p = own ? QKV + row * 3072 + col : HALO + ((row >> 6) * 4 + halo_slot((int)(row & 63))) * 3072 + col;
            raw[rr] = *(const v4u*)p; }
    } else if (wid >= 6) { const int d = wid - 6; gates_wave(sm + d * 328, AB, r0, c0, d, h, __expf(a_log[d * 8 + h]), dt_bias[d * 8 + h], lane); }
    __syncthreads();
    if (tid < 384) {
        float wv[5][8];
        { const float* w = conv_w + tensor * 1024 + h * 128 + c8;
#pragma unroll
          for (int j = 0; j < 5; ++j) { const f32x4 wa = *(const f32x4*)(w + j * 3072), wb = *(const f32x4*)(w + j * 3072 + 4);
              wv[j][0] = wa[0]; wv[j][1] = wa[1]; wv[j][2] = wa[2]; wv[j][3] = wa[3]; wv[j][4] = wb[0]; wv[j][5] = wb[1]; wv[j][6] = wb[2]; wv[j][7] = wb[3]; } }
        const float mul = tensor == 0 ? 0.08838834764831845f : 1.f;
#define CONV_HALF(HF) do { float acc[4][8]; conv_half<HF>(acc, raw, wv, c0 + tg * 8, Ls); if (tensor < 2) l2scale4(acc, mul); \
        _Pragma("unroll") for (int tt = 0; tt < 4; ++tt) { const u32x4 w = pack8(acc[tt]); const int tl = tg * 8 + 4 * HF + tt; \
            *(u32x4*)(QKV + (r0 + c0 + tl) * 3072 + tensor * 1024 + h * 128 + c8) = w; \
            if (tensor == 1) *(u32x4*)(Kn + (tl * LK + c8) * 2) = w; } } while (0)
        CONV_HALF(0); CONV_HALF(1);
#undef CONV_HALF
    }
    __syncthreads();
    if (wid < 4) {
        const int mt = wid >> 1, nt = wid & 1; f32x16 acc = {};
#pragma unroll
        for (int ks = 0; ks < 8; ++ks) acc = mma(GFRAG(Kn, LK, mt, ks), GFRAG(Kn, LK, nt, ks), acc);
#pragma unroll
        for (int r = 0; r < 16; ++r) KK[(32 * mt + crow(r, hi)) * 64 + 32 * nt + r32] = acc[r];
    }
    __syncthreads();
    for (int e = tid; e < 8192; e += 512) { const int d = e >> 12, i = (e >> 6) & 63, j = e & 63; const float* s = sm + d * 328;
        const int ti = d ? 63 - i : i, tj = d ? 63 - j : j;
        Ap[e] = (j < i) ? s[64 + i] * KK[ti * 64 + tj] * __expf(s[i] - s[j]) : 0.f; }
    __syncthreads();
    {
        unsigned short* T22s = (unsigned short*)(lds + 69632); unsigned short* Xt = (unsigned short*)(lds + 69632 + 5120);
        if (wid < 4) {
            const int d = wid >> 1, blk = wid & 1, c = lane & 31; const float* A = Ap + d * 4096 + (32 * blk) * 64 + 32 * blk;
            float T[32];
#pragma unroll
            for (int k = 0; k < 32; ++k) T[k] = 0.f;
#pragma unroll 1
            for (int i = 0; i < 32; ++i) { float acc = (c == i) ? 1.f : 0.f;
#pragma unroll
                for (int j4 = 0; j4 < 8; ++j4) { const f32x4 a = *(const f32x4*)(A + i * 64 + j4 * 4);
                    acc -= a[0] * T[j4 * 4]; acc -= a[1] * T[j4 * 4 + 1]; acc -= a[2] * T[j4 * 4 + 2]; acc -= a[3] * T[j4 * 4 + 3]; }
#pragma unroll
                for (int k = 0; k < 32; ++k) T[k] = (k == i) ? acc : T[k]; }
            const int sidx = seg ? 4 + (d ? nch - 1 - cidx : cidx) : (d ? nch - 1 - cidx : cidx);
            unsigned short* Tg = Tbuf + ((size_t)((b * 8 + h) * 2 + d) * NSTEP + sidx) * TUNIT;
            if (lane < 32) {
#pragma unroll
                for (int i = 0; i < 32; ++i) Tg[(blk ? 2048 : 0) + i * 32 + c] = (unsigned short)f2bf(T[i]);
            }
            if (blk == 1) {
                if (lane < 32) {
#pragma unroll
                    for (int i = 0; i < 32; ++i) T22s[d * 1280 + i * 40 + c] = (unsigned short)f2bf(T[i]);
                }
            } else {
                f32x16 X = {};
#pragma unroll
                for (int ks = 0; ks < 2; ++ks) {
                    const float* ap = Ap + d * 4096 + (32 + r32) * 64 + 16 * ks + 8 * hi;
                    const f32x4 a0 = *(const f32x4*)ap, a1 = *(const f32x4*)(ap + 4);
                    u32x4 aw; aw.x = pk2(a0[0], a0[1]); aw.y = pk2(a0[2], a0[3]); aw.z = pk2(a1[0], a1[1]); aw.w = pk2(a1[2], a1[3]);
                    u32x4 b0, b1, bw;
                    b0.x = pk2(T[16 * ks + 0], T[16 * ks + 1]); b0.y = pk2(T[16 * ks + 2], T[16 * ks + 3]); b0.z = pk2(T[16 * ks + 4], T[16 * ks + 5]); b0.w = pk2(T[16 * ks + 6], T[16 * ks + 7]);
                    b1.x = pk2(T[16 * ks + 8], T[16 * ks + 9]); b1.y = pk2(T[16 * ks + 10], T[16 * ks + 11]); b1.z = pk2(T[16 * ks + 12], T[16 * ks + 13]); b1.w = pk2(T[16 * ks + 14], T[16 * ks + 15]);
                    bw.x = hi ? b1.x : b0.x; bw.y = hi ? b1.y : b0.y; bw.z = hi ? b1.z : b0.z; bw.w = hi ? b1.w : b0.w;
                    X = mma(__builtin_bit_cast(bf16x8, aw), __builtin_bit_cast(bf16x8, bw), X);
                }
#pragma unroll
                for (int q4 = 0; q4 < 4; ++q4) { u32x2 w; w.x = pk2(X[4 * q4], X[4 * q4 + 1]); w.y = pk2(X[4 * q4 + 2], X[4 * q4 + 3]);
                    *(u32x2*)(Xt + d * 1280 + r32 * 40 + 8 * q4 + 4 * hi) = w; }
            }
        }
        __syncthreads();
        if (wid < 2) { const int d = wid; f32x16 Y = {};
#pragma unroll
            for (int ks = 0; ks < 2; ++ks) Y = mma(GFRAG((const char*)(T22s + d * 1280), 40, 0, ks), GFRAG((const char*)(Xt + d * 1280), 40, 0, ks), Y);
            const int sidx = seg ? 4 + (d ? nch - 1 - cidx : cidx) : (d ? nch - 1 - cidx : cidx);
            unsigned short* Tg = Tbuf + ((size_t)((b * 8 + h) * 2 + d) * NSTEP + sidx) * TUNIT;
#pragma unroll
            for (int r = 0; r < 16; ++r) Tg[1024 + crow(r, hi) * 32 + r32] = (unsigned short)f2bf(-Y[r]);
        }
    }
    __syncthreads();
}

__device__ __forceinline__ void chain(int b, int h, int d, const unsigned short* QKV, const float* AB, const float* a_log, const float* dt_bias,
                                      const unsigned short* Tbuf, float* o_a, char* lds, int wv, int dummy = 0) {
    int tid0_ = wv * 64 + lane_id(); asm volatile("" : "+v"(tid0_));
    const int tid0 = tid0_, wid = wv;
    const int nt = wid & 3, mh = wid >> 2;
    char* Kh = lds + L_KH; char* Qh = lds + L_QH; char* KdT = lds + L_KDT; char* QKb = lds + L_QK; char* Vh = lds + L_VH; char* Sbf = lds + L_SBF; char* Rbf = lds + L_RBF; char* VNbf = lds + L_VNBF;
    float* sm = (float*)(lds + L_SM);
    for (int e = tid0; e < 128 * LK / 2; e += 512) ((unsigned*)Sbf)[e] = 0u;
    f32x16 S0 = {}, S1 = {};
    const unsigned short* Tchain = Tbuf + (size_t)((b * 8 + h) * 2 + d) * NSTEP * TUNIT;
    v4u nxt[6];
#define TILE_LOAD(sidx_) do { const int s2_ = (sidx_), seg2_ = s2_ >= 4, n2_ = seg2_ ? s2_ - 4 : s2_, Ls2_ = seg2_ ? SEQ : LCTX, cidx2_ = d ? Ls2_ / 64 - 1 - n2_ : n2_; \
        const long rb_ = (seg2_ ? (long)b * SEQ : (long)MLAT + b * LCTX) + cidx2_ * 64; const int tid_l = wid * 64 + lane_id(); \
        _Pragma("unroll") for (int k_ = 0; k_ < 6; ++k_) { const int it_ = tid_l + 512 * k_; \
            nxt[k_] = *(const v4u*)(QKV + (rb_ + ((it_ >> 4) & 63)) * 3072 + (it_ >> 10) * 1024 + h * 128 + (it_ & 15) * 8); } } while (0)
    TILE_LOAD(0);
    __syncthreads();
    for (int sidx = 0; sidx < NSTEP; ++sidx) {
        int tid_ = wid * 64 + lane_id(); asm volatile("" : "+v"(tid_));
        const int tid = tid_, lane = tid & 63, r32 = lane & 31, hi = lane >> 5;
        const int seg = sidx >= 4, n = seg ? sidx - 4 : sidx, Ls = seg ? SEQ : LCTX, nch = Ls / 64, cidx = d ? nch - 1 - n : n, c0 = cidx * 64;
        const long r0 = seg ? (long)b * SEQ : (long)MLAT + b * LCTX;
        if (wid == 7) gates_wave(sm, AB, r0, c0, d, h, __expf(a_log[d * 8 + h]), dt_bias[d * 8 + h], lane);
#pragma unroll
        for (int k = 0; k < 6; ++k) { const int it = tid + 512 * k, row = (it >> 4) & 63, il = d ? 63 - row : row, ch = (it & 15) * 8; const int tensor = it >> 10;
            char* dst = tensor == 0 ? Qh : (tensor == 1 ? Kh : Vh);
            *(v4u*)(dst + (il * LK + ch) * 2) = nxt[k]; }
        __syncthreads();
        { const int dk = tid & 127, tq = tid >> 7; float v[16];
#pragma unroll
          for (int p = 0; p < 16; ++p) v[p] = bf2f(*(const unsigned short*)(Kh + ((16 * tq + p) * LK + dk) * 2)) * sm[192 + 16 * tq + p];
          u32x4 w0, w1; w0.x = pk2(v[0], v[1]); w0.y = pk2(v[2], v[3]); w0.z = pk2(v[4], v[5]); w0.w = pk2(v[6], v[7]); w1.x = pk2(v[8], v[9]); w1.y = pk2(v[10], v[11]); w1.z = pk2(v[12], v[13]); w1.w = pk2(v[14], v[15]);
          *(u32x4*)(KdT + (dk * LT + 16 * tq) * 2) = w0; *(u32x4*)(KdT + (dk * LT + 16 * tq + 8) * 2) = w1; }
        if (seg && wid < 3) {
            const int mt = wid > 0, ntq = wid > 1; f32x16 a = {};
#pragma unroll
            for (int ks = 0; ks < 8; ++ks) a = mma(GFRAG(Qh, LK, mt, ks), GFRAG(Kh, LK, ntq, ks), a);
            const int j = 32 * ntq + r32; const float gj = sm[j];
#pragma unroll
            for (int r = 0; r < 16; ++r) { const int i = 32 * mt + crow(r, hi); const float v = (i >= j) ? a[r] * __expf(sm[i] - gj) : 0.f;
                *(unsigned short*)(QKb + (i * LT + j) * 2) = (unsigned short)f2bf(v); }
        }
        bf16x8 Tf[4];
        { const unsigned short* Tg = Tchain + (size_t)sidx * TUNIT + r32 * 32 + 8 * hi;
          if (mh == 0) { Tf[0] = *(const bf16x8*)(Tg); Tf[1] = *(const bf16x8*)(Tg + 16); Tf[2] = Tf[0]; Tf[3] = Tf[1]; }
          else { Tf[0] = *(const bf16x8*)(Tg + 1024); Tf[1] = *(const bf16x8*)(Tg + 1024 + 16); Tf[2] = *(const bf16x8*)(Tg + 2048); Tf[3] = *(const bf16x8*)(Tg + 2048 + 16); } }
        if (sidx + 1 < NSTEP) TILE_LOAD(sidx + 1);
        __syncthreads();
        f32x16 rr = {}, oo = {};
#pragma unroll
        for (int ks = 0; ks < 8; ++ks) { const bf16x8 sb = GFRAG(Sbf, LK, nt, ks); rr = mma(GFRAG(Kh, LK, mh, ks), sb, rr); if (seg) oo = mma(GFRAG(Qh, LK, mh, ks), sb, oo); }
#pragma unroll
        for (int r = 0; r < 16; ++r) { const int il = 32 * mh + crow(r, hi); const float v = bf2f(*(const unsigned short*)(Vh + (il * LK + 32 * nt + r32) * 2));
            rr[r] = sm[64 + il] * v - sm[260 + il] * rr[r]; oo[r] *= sm[128 + il]; }
#pragma unroll
        for (int q4 = 0; q4 < 4; ++q4) { u32x2 w; w.x = pk2(rr[4 * q4], rr[4 * q4 + 1]); w.y = pk2(rr[4 * q4 + 2], rr[4 * q4 + 3]);
            *(u32x2*)(Rbf + ((32 * nt + r32) * LT + 32 * mh + 8 * q4 + 4 * hi) * 2) = w; }
        __syncthreads();
        f32x16 vn = {};
#pragma unroll
        for (int ks = 0; ks < 4; ++ks) if (mh == 1 || ks < 2) vn = mma(Tf[ks], GFRAG(Rbf, LT, nt, ks), vn);
#pragma unroll
        for (int q4 = 0; q4 < 4; ++q4) { u32x2 w; w.x = pk2(vn[4 * q4], vn[4 * q4 + 1]); w.y = pk2(vn[4 * q4 + 2], vn[4 * q4 + 3]);
            *(u32x2*)(VNbf + ((32 * nt + r32) * LT + 32 * mh + 8 * q4 + 4 * hi) * 2) = w; }
        __syncthreads();
        if (seg) {
#pragma unroll
            for (int ks = 0; ks < 4; ++ks) if (mh == 1 || ks < 2) oo = mma(GFRAG(QKb, LT, mh, ks), GFRAG(VNbf, LT, nt, ks), oo);
#pragma unroll
            for (int r = 0; r < 16; ++r) { const int il = 32 * mh + crow(r, hi); const int t = d ? c0 + 63 - il : c0 + il;
                atomicAdd(o_a + (dummy ? (size_t)il * 1024 : (size_t)(r0 + t) * 1024) + h * 128 + 32 * nt + r32, oo[r]); }
        }
        { const float gam = sm[256];
#pragma unroll
          for (int r = 0; r < 16; ++r) { S0[r] *= gam; S1[r] *= gam; }
#pragma unroll
          for (int ks = 0; ks < 4; ++ks) { const bf16x8 vb = GFRAG(VNbf, LT, nt, ks); S0 = mma(GFRAG(KdT, LT, 2 * mh, ks), vb, S0); S1 = mma(GFRAG(KdT, LT, 2 * mh + 1, ks), vb, S1); }
#pragma unroll
          for (int q4 = 0; q4 < 4; ++q4) { u32x2 w0, w1; w0.x = pk2(S0[4 * q4], S0[4 * q4 + 1]); w0.y = pk2(S0[4 * q4 + 2], S0[4 * q4 + 3]); w1.x = pk2(S1[4 * q4], S1[4 * q4 + 1]); w1.y = pk2(S1[4 * q4 + 2], S1[4 * q4 + 3]);
              *(u32x2*)(Sbf + ((32 * nt + r32) * LK + 64 * mh + 8 * q4 + 4 * hi) * 2) = w0; *(u32x2*)(Sbf + ((32 * nt + r32) * LK + 64 * mh + 32 + 8 * q4 + 4 * hi) * 2) = w1; } }
        __syncthreads();
    }
#undef TILE_LOAD
}
#undef GFRAG
}

__global__ void __launch_bounds__(512, 2) hybrid_fwd(Args a) {
    extern __shared__ __attribute__((aligned(16))) unsigned char lds[];
    const int tid0 = threadIdx.x, wave = __builtin_amdgcn_readfirstlane(tid0 >> 6);
#define PHASE_IDS() int tid = wave * 64 + lane_id(); asm volatile("" : "+v"(tid)); const int lane = tid & 63; (void)lane
    const int G = gridDim.x, bid = blockIdx.x;
    const int gw = bid * 8 + wave, NGW = G * 8;
    unsigned char* ws = a.ws;
    unsigned* ctl = (unsigned*)(ws + WS_CTL);
    volatile LAS unsigned* MISC = (volatile LAS unsigned*)((LAS unsigned char*)lds + MISC_OFF);
    for (int u = tid0; u < (LDS_BYTES - 131072) / 4; u += 512) ((LAS unsigned*)((LAS unsigned char*)lds + 131072))[u] = 0u;
    __syncthreads();
    (void)xcd_barrier_post(ctl + 4096, MISC + 8, wave);
#define GRID_BAR() do { XcdBarrier b_; b_.bar = (unsigned*)(a.ws + WS_CTL) + 4096; b_.x = xb_xcc_id(); b_.st = (volatile LAS unsigned*)((LAS unsigned char*)lds + MISC_OFF) + 8; b_.wv = wave; xcd_barrier(b_); } while (0)

#define MODP ((float*)(a.ws + WS_MODP))
#define MOD ((float*)(a.ws + WS_MOD))
#define W2T ((bf16*)(a.ws + WS_W2T))
#define AB ((float*)(a.ws + WS_AB))
#define QKV ((bf16*)(a.ws + WS_QKV))
#define QB ((bf16*)(a.ws + WS_QB))
#define KB ((bf16*)(a.ws + WS_KB))
#define VB ((bf16*)(a.ws + WS_VB))
#define MERGED ((bf16*)(a.ws + WS_MERGED))
#define H2 ((bf16*)(a.ws + WS_H2))
#define NA ((bf16*)(a.ws + WS_NA))
#define T1 ((bf16*)(a.ws + WS_T1))
#define GATES ((bf16*)(a.ws + WS_GATES))
#define H ((bf16*)((unsigned char*)a.out + DO_H))
#define W1T ((bf16*)((unsigned char*)a.out + DO_W1T))


#define THRASH() do { f32x4 _s = {0.f,0.f,0.f,0.f}; for (size_t _i = (size_t)bid * 512 + tid; _i < (size_t)MLAT * 1024 / 4; _i += (size_t)G * 512) { const f32x4 _v = ((const f32x4*)a.x)[_i]; _s += _v; } \
    ((f32x4*)(ws + WS_END))[(size_t)bid * 512 + tid] = _s; } while (0)
    {
        PHASE_IDS();
        for (int u = bid; u < 48; u += G) {
            const int ks = u / 6, nb = u % 6, n = nb * 512 + tid;
            float s0 = 0.f, s1 = 0.f, s2 = 0.f;
            for (int k = ks * 128; k < ks * 128 + 128; ++k) {
                const float w = a.w_ada[(size_t)k * 3072 + n];
                s0 += silu_f(a.c[k]) * w; s1 += silu_f(a.c[1024 + k]) * w; s2 += silu_f(a.c_ctx[k]) * w;
            }
            MODP[(ks * 3 + 0) * 3072 + n] = s0; MODP[(ks * 3 + 1) * 3072 + n] = s1; MODP[(ks * 3 + 2) * 3072 + n] = s2;
        }
        LAS float* scr = (LAS float*)((LAS unsigned char*)lds + wave * 16384);
        constexpr int NB1 = N1 / 32, NB2 = N2ALL / 32, NIT = 16 * (NB1 + NB2);
        for (int it = gw; it < NIT; it += NGW) {
            const int kb = it & 15, nbi = it >> 4;
            if (nbi < NB1) { const int n0 = nbi * 32; transpose_item(a.w_in, IN_COLS, w1_src(n0), W1T, n0, kb * 64, scr, lane); }
            else { const int n0 = (nbi - NB1) * 32;
                if (n0 < 4096) transpose_item(a.w_in, IN_COLS, w2_src(n0), W2T, n0, kb * 64, scr, lane);
                else if (n0 < 5120) transpose_item(a.w_oa, 1024, n0 - 4096, W2T, n0, kb * 64, scr, lane);
                else if (n0 < 6144) transpose_item(a.w_ob, 1024, n0 - 5120, W2T, n0, kb * 64, scr, lane);
                else transpose_item(a.w_out, 1024, n0 - 6144, W2T, n0, kb * 64, scr, lane); }
        }
    }
    GRID_BAR();

    {
        PHASE_IDS();
        float* modl = (float*)lds;
        for (int i = tid; i < 9216; i += 512) { const int n = i % 3072; float s = a.b_ada[n];
#pragma unroll
            for (int ks = 0; ks < 8; ++ks) s += MODP[ks * 9216 + i];
            modl[i] = s; if (bid == 0) MOD[i] = s; }
        __syncthreads();
        for (int r = gw; r < MTOT; r += NGW) {
            const float* xr; int v;
            if (r < MLAT) { xr = a.x + (size_t)r * 1024; v = r / SEQ; } else { xr = a.ctx + (size_t)(r - MLAT) * 1024; v = 2; }
            f32x4 xv[4]; float ss = 0.f;
#pragma unroll
            for (int j = 0; j < 4; ++j) { xv[j] = ((const f32x4*)xr)[64 * j + lane]; ss += (xv[j].x * xv[j].x + xv[j].y * xv[j].y) + (xv[j].z * xv[j].z + xv[j].w * xv[j].w); }
            const float rstd = 1.f / sqrtf(wave_sum(ss) * (1.f / 1024.f) + EPS);
            const float* sh = modl + v * 3072; const float* sc = sh + 1024;
#pragma unroll
            for (int j = 0; j < 4; ++j) { const int c0 = (64 * j + lane) * 4;
                const float h0 = xv[j].x * rstd * (1.f + sc[c0]) + sh[c0], h1 = xv[j].y * rstd * (1.f + sc[c0 + 1]) + sh[c0 + 1];
                const float h2 = xv[j].z * rstd * (1.f + sc[c0 + 2]) + sh[c0 + 2], h3 = xv[j].w * rstd * (1.f + sc[c0 + 3]) + sh[c0 + 3];
                v2u o; o.x = pk2(h0, h1); o.y = pk2(h2, h3); *(v2u*)(H + (size_t)r * 1024 + c0) = o; }
        }
    }
    GRID_BAR();


#if PG8_R1
    { pg8::Gemm g{H, W1T, MTOT, N1, 1024}; pg8::StaticOrder S; S.init(MTOT, N1, G, bid); pg8::EpiR1 e{QKV, QB, KB, VB, AB, MLAT / 256, (bf16*)(a.ws + WS_HALO)};
      pg8::gemm_phase<pg8::EpiR1, pg8::StaticOrder, true, true>((LAS unsigned char*)lds, g, S, e, wave); }
#else
    { EpiR1 e{QKV, QB, KB, VB, AB}; gemm_naive(lds, H, W1T, MTOT, N1, 1024, e); }
#endif

    GRID_BAR();

    {
        PHASE_IDS();
        for (size_t i = (size_t)bid * 512 + tid; i < (size_t)MLAT * 1024 / 4; i += (size_t)G * 512) ((f32x4*)a.out)[i] = (f32x4){0.f, 0.f, 0.f, 0.f};
        for (int it = gw; it < MLAT + MTOT; it += NGW) {
            const bool isq = it < MLAT; const int r = isq ? it : it - MLAT;
            bf16* p = (isq ? QB : KB) + (size_t)r * 1024 + lane * 16;
            const float* gw_ = isq ? a.q_norm_w : a.k_norm_w;
            const v4u w0 = *(const v4u*)p, w1 = *(const v4u*)(p + 8);
            float v[16] = {bflo(w0.x), bfhi(w0.x), bflo(w0.y), bfhi(w0.y), bflo(w0.z), bfhi(w0.z), bflo(w0.w), bfhi(w0.w),
                           bflo(w1.x), bfhi(w1.x), bflo(w1.y), bfhi(w1.y), bflo(w1.z), bfhi(w1.z), bflo(w1.w), bfhi(w1.w)};
            float ss = 0.f;
#pragma unroll
            for (int i = 0; i < 16; ++i) ss += v[i] * v[i];
            ss += xorv<1>(ss); ss += xorv<2>(ss);
            const float rstd = 1.f / sqrtf(ss * (1.f / 64.f) + EPS);
            const int sub = lane & 3;
#pragma unroll
            for (int i = 0; i < 16; ++i) v[i] = v[i] * rstd * gw_[sub * 16 + i];
            if (r < MLAT) {
                const int t = r % SEQ; const float pos = (float)((sub < 2) ? (t >> 6) : (t & 63));
#pragma unroll
                for (int i = 0; i < 16; ++i) {
                    const float other = xorv<1>(v[i]);
                    const float invf = exp2f(-(float)i * (13.287712379549449f / 16.f));
                    const float ang = pos * invf; const float cs = cosf(ang), sn = sinf(ang);
                    v[i] = (sub & 1) ? (v[i] * cs + other * sn) : (v[i] * cs - other * sn);
                }
            }
            const float sc = isq ? QSCALE : 1.f;
            v4u o0, o1; o0.x = pk2(v[0] * sc, v[1] * sc); o0.y = pk2(v[2] * sc, v[3] * sc); o0.z = pk2(v[4] * sc, v[5] * sc); o0.w = pk2(v[6] * sc, v[7] * sc);
            o1.x = pk2(v[8] * sc, v[9] * sc); o1.y = pk2(v[10] * sc, v[11] * sc); o1.z = pk2(v[12] * sc, v[13] * sc); o1.w = pk2(v[14] * sc, v[15] * sc);
            *(v4u*)p = o0; *(v4u*)(p + 8) = o1;
        }
            __syncthreads();
        for (int u = bid; u < 264 * 8; u += G)
            gdn::convt_unit(u >> 3, u & 7, QKV, (const unsigned short*)(a.ws + WS_HALO), AB, a.conv_w, a.a_log, a.dt_bias, (unsigned short*)(a.ws + WS_T), (char*)lds, wave);
    }
    GRID_BAR();

    {
        PHASE_IDS();
        if (bid < 32) gdn::chain(bid >> 4, (bid >> 1) & 7, bid & 1, QKV, AB, a.a_log, a.dt_bias, (const unsigned short*)(a.ws + WS_T), a.out, (char*)lds, wave);
        if (bid < 32 && TIME_CHAIN2) gdn::chain(bid >> 4, (bid >> 1) & 7, bid & 1, QKV, AB, a.a_log, a.dt_bias, (const unsigned short*)(a.ws + WS_T), (float*)(a.ws + WS_END), (char*)lds, wave, 1);
        __syncthreads();
        {
            float lam, negm;
            { float s1 = 0.f, s2 = 0.f, mq = 0.f, mk = 0.f; for (int i = 0; i < 64; ++i) { s1 += a.lq1[i] * a.lk1[i]; s2 += a.lq2[i] * a.lk2[i]; mq = fmaxf(mq, fabsf(a.q_norm_w[i])); mk = fmaxf(mk, fabsf(a.k_norm_w[i])); }
              lam = __expf(s1) - __expf(s2) + 0.2f; negm = -(8.f * mq * mk * 1.4426950408889634f);
              lam = __uint_as_float(__builtin_amdgcn_readfirstlane(__float_as_uint(lam))); negm = __uint_as_float(__builtin_amdgcn_readfirstlane(__float_as_uint(negm))); }
            volatile LAS unsigned* qslot = MISC + 16;
            for (int pass = TIME_ATT2 ? 0 : 1; pass < 2; ++pass)
            for (int qq = 0; qq < 8; ++qq) { const int q = (bid + qq) & 7;
                for (;;) {
                    __syncthreads();
                    if (tid == 0) qslot[0] = __hip_atomic_fetch_add(ctl + 12288 + 1024 * pass + 64 * q, 1u, __ATOMIC_RELAXED, __HIP_MEMORY_SCOPE_AGENT);
                    __syncthreads();
                    const unsigned idx = qslot[0];
                    if (idx >= 128u) break;
                    const int unit = q * 128 + (int)idx; const int pair = unit >> 6, qb = unit & 63;
                    att::attn_unit(pair >> 3, pair & 7, qb, QB, KB, VB, a.diff_norm_w, lam, negm, (char*)lds, wave, pass ? nullptr : (unsigned short*)(a.ws + WS_END));
                }
            }
        }
    }
    GRID_BAR();

    {
        PHASE_IDS();
        for (int r = gw; r < MLAT; r += NGW) {
            const float* xr = a.x + (size_t)r * 1024; const int v = r / SEQ;
            f32x4 xv[4]; float ss = 0.f;
#pragma unroll
            for (int j = 0; j < 4; ++j) { xv[j] = ((const f32x4*)xr)[64 * j + lane]; ss += (xv[j].x * xv[j].x + xv[j].y * xv[j].y) + (xv[j].z * xv[j].z + xv[j].w * xv[j].w); }
            const float rstd = 1.f / sqrtf(wave_sum(ss) * (1.f / 1024.f) + EPS);
            const float* sh = MOD + v * 3072; const float* sc = sh + 1024;
#pragma unroll
            for (int j = 0; j < 4; ++j) { const int c0 = (64 * j + lane) * 4;
                const float h0 = xv[j].x * rstd * (1.f + sc[c0]) + sh[c0], h1 = xv[j].y * rstd * (1.f + sc[c0 + 1]) + sh[c0 + 1];
                const float h2 = xv[j].z * rstd * (1.f + sc[c0 + 2]) + sh[c0 + 2], h3 = xv[j].w * rstd * (1.f + sc[c0 + 3]) + sh[c0 + 3];
                v2u o; o.x = pk2(h0, h1); o.y = pk2(h2, h3); *(v2u*)(H2 + (size_t)r * 1024 + c0) = o; }
            const float* orow = a.out + (size_t)r * 1024 + lane * 16;
            f32x4 ov[4]; float s2 = 0.f;
#pragma unroll
            for (int j = 0; j < 4; ++j) { ov[j] = ((const f32x4*)orow)[j]; s2 += (ov[j].x * ov[j].x + ov[j].y * ov[j].y) + (ov[j].z * ov[j].z + ov[j].w * ov[j].w); }
            s2 += xorv<1>(s2); s2 += xorv<2>(s2); s2 += xorv<4>(s2);
            const float r2 = 1.f / sqrtf(s2 * (1.f / 128.f) + EPS);
            const float* gwp = a.gdn_norm_w + (lane & 7) * 16;
            v4u o0, o1;
            o0.x = pk2(ov[0].x * r2 * gwp[0], ov[0].y * r2 * gwp[1]); o0.y = pk2(ov[0].z * r2 * gwp[2], ov[0].w * r2 * gwp[3]);
            o0.z = pk2(ov[1].x * r2 * gwp[4], ov[1].y * r2 * gwp[5]); o0.w = pk2(ov[1].z * r2 * gwp[6], ov[1].w * r2 * gwp[7]);
            o1.x = pk2(ov[2].x * r2 * gwp[8], ov[2].y * r2 * gwp[9]); o1.y = pk2(ov[2].z * r2 * gwp[10], ov[2].w * r2 * gwp[11]);
            o1.z = pk2(ov[3].x * r2 * gwp[12], ov[3].y * r2 * gwp[13]); o1.w = pk2(ov[3].z * r2 * gwp[14], ov[3].w * r2 * gwp[15]);
            *(v4u*)(NA + (size_t)r * 1024 + lane * 16) = o0; *(v4u*)(NA + (size_t)r * 1024 + lane * 16 + 8) = o1;
        }
    }
    GRID_BAR();


#if PG8_R2
    { pg8::Gemm g{H2, W2T, MLAT, 4096, 1024}; pg8::StaticOrder S; S.init(MLAT, 4096, G, bid); pg8::EpiR2 e{NA, QB, GATES, NA, QB};
      pg8::gemm_phase<pg8::EpiR2, pg8::StaticOrder, true, true>((LAS unsigned char*)lds, g, S, e, wave); }
#else
    { EpiR2 e{NA, QB, GATES}; gemm_naive(lds, H2, W2T, MLAT, 4096, 1024, e); }
#endif
    GRID_BAR();


#if PG8_F1
    { pg8::Gemm g{NA, W2T + (size_t)4096 * 1024, MLAT, 1024, 1024}; pg8::StaticOrder S; S.init(MLAT, 1024, G, bid); pg8::EpiF e{T1, T1, GATES, 0};
      pg8::gemm_phase<pg8::EpiF, pg8::StaticOrder, true, true>((LAS unsigned char*)lds, g, S, e, wave); }
#else
    { EpiF1 e{T1, GATES}; gemm_naive(lds, NA, W2T + (size_t)4096 * 1024, MLAT, 1024, 1024, e); }
#endif


#if PG8_F2
    { pg8::Gemm g{QB, W2T + (size_t)5120 * 1024, MLAT, 1024, 1024}; pg8::StaticOrder S; S.init(MLAT, 1024, G, bid); pg8::EpiF e{MERGED, T1, GATES, 1};
      pg8::gemm_phase<pg8::EpiF, pg8::StaticOrder, true, true>((LAS unsigned char*)lds, g, S, e, wave); }
#else
    { EpiF2 e{MERGED, T1, GATES}; gemm_naive(lds, QB, W2T + (size_t)5120 * 1024, MLAT, 1024, 1024, e); }
#endif

    GRID_BAR();


#if PG8_G
    { pg8::Gemm g{MERGED, W2T + (size_t)6144 * 1024, MLAT, 1024, 1024}; pg8::StaticOrder S; S.init(MLAT, 1024, G, bid); pg8::EpiG e{a.out, a.x, MOD, SEQ / 256};
      pg8::gemm_phase<pg8::EpiG, pg8::StaticOrder, true, true>((LAS unsigned char*)lds, g, S, e, wave); }
#else
    { EpiG e{a.out, a.x, MOD}; gemm_naive(lds, MERGED, W2T + (size_t)6144 * 1024, MLAT, 1024, 1024, e); }
#endif

}

extern "C" void kernel_launch(void* const* d_in, const int* in_sizes, int n_in, void* d_out, int out_size, void* d_ws, size_t ws_size, hipStream_t stream) {
    static int grid = 0;
    if (grid == 0) {
        if (n_in != 21 || in_sizes[0] != MLAT * DM || out_size != MLAT * DM || ws_size < WS_END) { fprintf(stderr, "kernel_launch: unexpected shapes n_in %d in0 %d out %d ws %zu\n", n_in, n_in > 0 ? in_sizes[0] : -1, out_size, ws_size); grid = -1; return; }
        int dev = 0, cus = 0, per_cu = 0;
        if (hipGetDevice(&dev) != hipSuccess || hipDeviceGetAttribute(&cus, hipDeviceAttributeMultiprocessorCount, dev) != hipSuccess) { grid = -1; return; }
        if (hipFuncSetAttribute((const void*)hybrid_fwd, hipFuncAttributeMaxDynamicSharedMemorySize, LDS_BYTES) != hipSuccess) { fprintf(stderr, "kernel_launch: hipFuncSetAttribute failed\n"); grid = -1; return; }
        if (hipOccupancyMaxActiveBlocksPerMultiprocessor(&per_cu, (const void*)hybrid_fwd, 512, LDS_BYTES) != hipSuccess || per_cu < 1) { fprintf(stderr, "kernel_launch: occupancy query says %d\n", per_cu); per_cu = 1; }
        (void)hipGetLastError();
        grid = cus;
    }
    if (grid < 0) return;
    (void)hipMemsetAsync((char*)d_ws + WS_CTL, 0, CTL_BYTES, stream);
    Args a{};
    a.x = (const float*)d_in[0]; a.c = (const float*)d_in[1]; a.ctx = (const float*)d_in[2]; a.c_ctx = (const float*)d_in[3]; a.w_ada = (const float*)d_in[4]; a.b_ada = (const float*)d_in[5];
    a.w_in = (const float*)d_in[6]; a.conv_w = (const float*)d_in[7]; a.a_log = (const float*)d_in[8]; a.dt_bias = (const float*)d_in[9]; a.gdn_norm_w = (const float*)d_in[10];
    a.q_norm_w = (const float*)d_in[11]; a.k_norm_w = (const float*)d_in[12]; a.lq1 = (const float*)d_in[13]; a.lk1 = (const float*)d_in[14]; a.lq2 = (const float*)d_in[15]; a.lk2 = (const float*)d_in[16];
    a.diff_norm_w = (const float*)d_in[17]; a.w_oa = (const float*)d_in[18]; a.w_ob = (const float*)d_in[19]; a.w_out = (const float*)d_in[20];
    a.out = (float*)d_out; a.ws = (unsigned char*)d_ws;
    hipLaunchKernelGGL(hybrid_fwd, dim3(grid), dim3(512), LDS_BYTES, stream, a);
    const hipError_t le = hipPeekAtLastError();
    if (le != hipSuccess) fprintf(stderr, "kernel_launch: launch failed: %s\n", hipGetErrorName(le));
}
```
